# Optimizing an MI355X kernel written in HIP

```python
import math
import jax, jax.numpy as jnp
from jax import lax
import numpy as np

D_MODEL = 2048
BATCH = 2
SEQ = 4096
DEPTH = 2
DEC_BATCH = 16
DEC_SEQ = 32
PAST_LEN = 2048

CHUNK = 64
Q_BLOCK = 128
MLA_HEADS = 16
Q_LORA = 512
KV_LORA = 512
NOPE_DIM = 128
ROPE_DIM = 64
V_DIM = 128
ROPE_THETA = 10000.0
MLA_SCALE = (NOPE_DIM + ROPE_DIM) ** -0.5
SB_HEADS = 8
SB_DIM = 128
SB_SCALE = SB_DIM ** -0.5
FF_DIM = -(-8 * D_MODEL // (3 * 256)) * 256
PLE_DIM = 256
ALPHA = (2 * DEPTH) ** 0.25
BETA = (8 * DEPTH) ** -0.25
LN_EPS = 1e-5
RMS_EPS = 1e-6
SB_WIDTH = SB_HEADS * SB_DIM
IN_SIZES = (Q_LORA, KV_LORA, ROPE_DIM, SB_WIDTH, SB_WIDTH, SB_WIDTH, 2 * D_MODEL)
IN_COLS = Q_LORA + KV_LORA + ROPE_DIM + 3 * SB_WIDTH + 2 * D_MODEL
IN_SPLITS = [Q_LORA, Q_LORA + KV_LORA, Q_LORA + KV_LORA + ROPE_DIM,
             Q_LORA + KV_LORA + ROPE_DIM + SB_WIDTH,
             Q_LORA + KV_LORA + ROPE_DIM + 2 * SB_WIDTH,
             Q_LORA + KV_LORA + ROPE_DIM + 3 * SB_WIDTH]

kernel_name = "hybrid_mla_stickbreaking_streaming_step"


def layer_norm(x, g, b):
    xf = x.astype(jnp.float32)
    mu = jnp.mean(xf, -1, keepdims=True)
    var = jnp.mean(jnp.square(xf - mu), -1, keepdims=True)
    return ((xf - mu) * lax.rsqrt(var + LN_EPS) * g + b).astype(x.dtype)


def rms_norm(x, g):
    xf = x.astype(jnp.float32)
    return (xf * lax.rsqrt(jnp.mean(jnp.square(xf), -1, keepdims=True) + RMS_EPS) * g).astype(x.dtype)


def rope(x, pos):
    half = ROPE_DIM // 2
    inv_freq = 1.0 / (ROPE_THETA ** (jnp.arange(half, dtype=jnp.float32) * (2.0 / ROPE_DIM)))
    ang = pos.astype(jnp.float32)[:, None] * inv_freq[None, :]
    ang = ang.reshape(ang.shape[0], *([1] * (x.ndim - 3)), half)
    cos, sin = jnp.cos(ang), jnp.sin(ang)
    x1, x2 = x[..., :half], x[..., half:]
    return jnp.concatenate([x1 * cos - x2 * sin, x2 * cos + x1 * sin], -1).astype(x.dtype)


def over_query_blocks(attend, qs, q_pos):
    n_q = q_pos.shape[0]
    if n_q <= Q_BLOCK:
        return attend(qs, q_pos)
    nb = n_q // Q_BLOCK

    def to_blocks(a):
        return jnp.moveaxis(a.reshape(a.shape[0], nb, Q_BLOCK, *a.shape[2:]), 1, 0)

    out = lax.map(lambda args: attend(args[0], args[1]),
                  (tuple(to_blocks(q) for q in qs), q_pos.reshape(nb, Q_BLOCK)))
    out = jnp.moveaxis(out, 0, 1)
    return out.reshape(out.shape[0], n_q, *out.shape[3:])


def mla_attend(q_lat, q_rope, q_pos, lat, k_rope, k_pos, w_uv):
    s = (jnp.einsum('bqhc,bkc->bhqk', q_lat, lat)
         + jnp.einsum('bqhr,bkr->bhqk', q_rope, k_rope)).astype(jnp.float32) * MLA_SCALE
    visible = (k_pos[None, :] // CHUNK) <= (q_pos[:, None] // CHUNK)
    s = jnp.where(visible, s, -jnp.inf)
    p = jax.nn.softmax(s, axis=-1).astype(lat.dtype)
    ctx = jnp.einsum('bhqk,bkc->bqhc', p, lat)
    return jnp.einsum('bqhc,chv->bqhv', ctx, w_uv)


def sb_attend(q, q_pos, k, v, k_pos):
    z = jnp.einsum('bqhd,bkhd->bhqk', q, k).astype(jnp.float32) * SB_SCALE
    before = k_pos[None, :] < q_pos[:, None]
    log_beta = jax.nn.log_sigmoid(z)
    log_rest = jnp.where(before, jax.nn.log_sigmoid(-z), 0.0)
    tail = lax.cumsum(log_rest, axis=log_rest.ndim - 1, reverse=True)
    tail = jnp.concatenate([tail[..., 1:], jnp.zeros_like(tail[..., :1])], -1)
    a = jnp.where(before, jnp.exp(log_beta + tail), 0.0).astype(v.dtype)
    return jnp.einsum('bhqk,bkhd->bqhd', a, v)


def trunk_layer(x, p, past_lat, past_kr, past_k, past_v,
                w_in, b_gate, q_a_norm_g, w_q_b, kv_a_norm_g, w_kv_b,
                w_branch_a, w_branch_b, w_out, ln1_g, ln1_b,
                w_ffn_gu, w_ffn_down, ln2_g, ln2_b,
                w_ple_gate, b_ple_gate, w_ple_proj, ln3_g, ln3_b):
    b, s, _ = x.shape
    n_past = past_lat.shape[1]
    q_pos = n_past + jnp.arange(s, dtype=jnp.int32)
    k_pos = jnp.arange(n_past + s, dtype=jnp.int32)

    h = x @ w_in
    q_a, kv_a, k_r, sb_q, sb_k, sb_v, gates = jnp.split(h, IN_SPLITS, axis=-1)

    q = (rms_norm(q_a, q_a_norm_g) @ w_q_b).reshape(b, s, MLA_HEADS, NOPE_DIM + ROPE_DIM)
    q_rope = rope(q[..., NOPE_DIM:], q_pos)
    w_kv = w_kv_b.reshape(KV_LORA, MLA_HEADS, NOPE_DIM + V_DIM)
    w_uk, w_uv = w_kv[..., :NOPE_DIM], w_kv[..., NOPE_DIM:]
    q_lat = jnp.einsum('bshn,chn->bshc', q[..., :NOPE_DIM], w_uk)
    new_lat = rms_norm(kv_a, kv_a_norm_g)
    new_kr = rope(k_r, q_pos)
    lat_all = jnp.concatenate([past_lat, new_lat], 1)
    kr_all = jnp.concatenate([past_kr, new_kr], 1)
    o_a = over_query_blocks(
        lambda qs, qp: mla_attend(qs[0], qs[1], qp, lat_all, kr_all, k_pos, w_uv),
        (q_lat, q_rope), q_pos)

    sbq = sb_q.reshape(b, s, SB_HEADS, SB_DIM)
    new_k = sb_k.reshape(b, s, SB_HEADS, SB_DIM)
    new_v = sb_v.reshape(b, s, SB_HEADS, SB_DIM)
    k_all = jnp.concatenate([past_k, new_k], 1)
    v_all = jnp.concatenate([past_v, new_v], 1)
    o_b = over_query_blocks(
        lambda qs, qp: sb_attend(qs[0], qp, k_all, v_all, k_pos), (sbq,), q_pos)

    g_a, g_b = jnp.split(jax.nn.sigmoid(gates + b_gate), 2, axis=-1)
    merged = (g_a * (o_a.reshape(b, s, -1) @ w_branch_a)
              + g_b * (o_b.reshape(b, s, -1) @ w_branch_b))
    x = layer_norm(ALPHA * x + merged @ w_out, ln1_g, ln1_b)

    f_g, f_u = jnp.split(x @ w_ffn_gu, 2, axis=-1)
    x = layer_norm(ALPHA * x + (jax.nn.silu(f_g) * f_u) @ w_ffn_down, ln2_g, ln2_b)

    ple = jax.nn.sigmoid(x @ w_ple_gate + b_ple_gate) * (p @ w_ple_proj)
    x = layer_norm(ALPHA * x + ple, ln3_g, ln3_b)
    return x, (new_lat, new_kr, new_k, new_v)


def setup_inputs(seed: int = 0) -> dict:
    key = jax.random.key(seed)
    ks = iter(jax.random.split(key, 40))

    def nrm(shape, scale=1.0):
        return jax.random.normal(next(ks), shape, jnp.float32) * scale

    def gain(shape):
        return 1.0 + nrm(shape, 0.02)

    L = DEPTH
    return {
        "x_prompt": nrm((BATCH, SEQ, D_MODEL)),
        "x_sample": nrm((DEC_BATCH, DEC_SEQ, D_MODEL)),
        "cache_mla_latent": nrm((L, DEC_BATCH, PAST_LEN, KV_LORA)),
        "cache_mla_krope": nrm((L, DEC_BATCH, PAST_LEN, ROPE_DIM)),
        "cache_sb_k": nrm((L, DEC_BATCH, PAST_LEN, SB_HEADS, SB_DIM)),
        "cache_sb_v": nrm((L, DEC_BATCH, PAST_LEN, SB_HEADS, SB_DIM)),
        "p_prompt": nrm((L, BATCH, SEQ, PLE_DIM)),
        "p_sample": nrm((L, DEC_BATCH, DEC_SEQ, PLE_DIM)),
        "ln_in_g": gain((D_MODEL,)),
        "ln_in_b": nrm((D_MODEL,), 0.02),
        "w_in": nrm((L, D_MODEL, IN_COLS), D_MODEL ** -0.5),
        "b_gate": nrm((L, 2 * D_MODEL), 0.02),
        "q_a_norm_g": gain((L, Q_LORA)),
        "w_q_b": nrm((L, Q_LORA, MLA_HEADS * (NOPE_DIM + ROPE_DIM)), Q_LORA ** -0.5),
        "kv_a_norm_g": gain((L, KV_LORA)),
        "w_kv_b": nrm((L, KV_LORA, MLA_HEADS * (NOPE_DIM + V_DIM)), KV_LORA ** -0.5),
        "w_branch_a": nrm((L, MLA_HEADS * V_DIM, D_MODEL), (MLA_HEADS * V_DIM) ** -0.5),
        "w_branch_b": nrm((L, SB_WIDTH, D_MODEL), SB_WIDTH ** -0.5),
        "w_out": nrm((L, D_MODEL, D_MODEL), BETA * D_MODEL ** -0.5),
        "ln1_g": gain((L, D_MODEL)),
        "ln1_b": nrm((L, D_MODEL), 0.02),
        "w_ffn_gu": nrm((L, D_MODEL, 2 * FF_DIM), D_MODEL ** -0.5),
        "w_ffn_down": nrm((L, FF_DIM, D_MODEL), BETA * FF_DIM ** -0.5),
        "ln2_g": gain((L, D_MODEL)),
        "ln2_b": nrm((L, D_MODEL), 0.02),
        "w_ple_gate": nrm((L, D_MODEL, D_MODEL), D_MODEL ** -0.5),
        "b_ple_gate": nrm((L, D_MODEL), 0.02),
        "w_ple_proj": nrm((L, PLE_DIM, D_MODEL), BETA * PLE_DIM ** -0.5),
        "ln3_g": gain((L, D_MODEL)),
        "ln3_b": nrm((L, D_MODEL), 0.02),
    }


def reference(x_prompt, x_sample, cache_mla_latent, cache_mla_krope, cache_sb_k, cache_sb_v,
              p_prompt, p_sample, ln_in_g, ln_in_b, w_in, b_gate, q_a_norm_g, w_q_b,
              kv_a_norm_g, w_kv_b, w_branch_a, w_branch_b, w_out, ln1_g, ln1_b,
              w_ffn_gu, w_ffn_down, ln2_g, ln2_b, w_ple_gate, b_ple_gate, w_ple_proj,
              ln3_g, ln3_b):
    def run(x, p, c_lat, c_kr, c_k, c_v):
        x = layer_norm(x, ln_in_g, ln_in_b)
        rows = []
        for i in range(DEPTH):
            x, r = trunk_layer(x, p[i], c_lat[i], c_kr[i], c_k[i], c_v[i],
                               w_in[i], b_gate[i], q_a_norm_g[i], w_q_b[i],
                               kv_a_norm_g[i], w_kv_b[i], w_branch_a[i], w_branch_b[i],
                               w_out[i], ln1_g[i], ln1_b[i], w_ffn_gu[i], w_ffn_down[i],
                               ln2_g[i], ln2_b[i], w_ple_gate[i], b_ple_gate[i],
                               w_ple_proj[i], ln3_g[i], ln3_b[i])
            rows.append(r)
        lat, kr, k, v = (jnp.stack(t) for t in zip(*rows))
        return x, lat, kr, k, v

    bp = x_prompt.shape[0]
    dt = x_prompt.dtype
    y_prompt, lat_p, kr_p, k_p, v_p = run(
        x_prompt, p_prompt,
        jnp.zeros((DEPTH, bp, 0, KV_LORA), dt), jnp.zeros((DEPTH, bp, 0, ROPE_DIM), dt),
        jnp.zeros((DEPTH, bp, 0, SB_HEADS, SB_DIM), dt), jnp.zeros((DEPTH, bp, 0, SB_HEADS, SB_DIM), dt))
    y_sample, lat_s, kr_s, k_s, v_s = run(
        x_sample, p_sample, cache_mla_latent, cache_mla_krope, cache_sb_k, cache_sb_v)
    return (y_prompt, y_sample, lat_p, kr_p, k_p, v_p, lat_s, kr_s, k_s, v_s)
```

```cpp
#include <hip/hip_runtime.h>
#include <cstdio>
#include <cstdint>
#include <cstring>

#ifndef MK_PER_PHASE
#define MK_PER_PHASE 0
#endif

#define LAS __attribute__((address_space(3)))
#define GAS __attribute__((address_space(1)))
typedef unsigned short bf16_t;
typedef short bf16x8 __attribute__((ext_vector_type(8)));
typedef short s16x4 __attribute__((ext_vector_type(4)));
typedef float f32x4 __attribute__((ext_vector_type(4)));
typedef float f32x16 __attribute__((ext_vector_type(16)));
typedef unsigned u32x4 __attribute__((ext_vector_type(4)));
typedef unsigned u32x2 __attribute__((ext_vector_type(2)));

constexpr int DM = 2048, TP = 8192, TS = 512, TT = 8704, SEQ = 4096, PAST = 2048, DSEQ = 32, NDB = 16, NLAYER = 2;
constexpr int NIN = 8448;
constexpr int FF = 5632, PLE = 256, SKEYS = PAST + DSEQ;
constexpr float ALPHA = 1.41421356237309515f;
constexpr float LN_EPS = 1e-5f, RMS_EPS = 1e-6f;
constexpr float LOG2E = 1.4426950408889634f, LN2 = 0.6931471805599453f;
constexpr float MLA_C = 0.07216878364870322f * LOG2E;
constexpr float SB_SCALE = 0.08838834764831845f;

constexpr size_t O_Y_P = 0, O_Y_S = 16777216, O_LAT_P = 17825792, O_KR_P = 26214400, O_K_P = 27262976, O_V_P = 44040192,
                 O_LAT_S = 60817408, O_KR_S = 61341696, O_K_S = 61407232, O_V_S = 62455808, O_END = 63504384;

constexpr size_t al256(size_t x) { return (x + 255) & ~(size_t)255; }
constexpr size_t WS_CTL = 0, CTL_BYTES = 1u << 20;
constexpr size_t W_IN = 0, W_QB = W_IN + (size_t)NIN * DM * 2, W_KVBT = W_QB + (size_t)3072 * 512 * 2, W_KVBN = W_KVBT + (size_t)4096 * 512 * 2,
                 W_UVBD = W_KVBN + (size_t)512 * 4096 * 2, W_BA = W_UVBD + (size_t)2048 * 1024 * 2, W_BB = W_BA + (size_t)DM * DM * 2,
                 W_OUT = W_BB + (size_t)DM * 1024 * 2, W_GU = W_OUT + (size_t)DM * DM * 2, W_DN = W_GU + (size_t)2 * FF * DM * 2,
                 W_PG = W_DN + (size_t)DM * FF * 2, W_PP = W_PG + (size_t)DM * DM * 2, W_LAYER = W_PP + (size_t)DM * PLE * 2;
constexpr size_t WS_W = CTL_BYTES;
constexpr size_t WS_LATS = WS_W + NLAYER * W_LAYER;
constexpr size_t WS_KRS = WS_LATS + (size_t)NLAYER * NDB * SKEYS * 512 * 2;
constexpr size_t WS_PB = WS_KRS + (size_t)NLAYER * NDB * SKEYS * 64 * 2;
constexpr size_t WS_X = WS_PB + (size_t)NLAYER * TT * PLE * 2;
constexpr size_t WS_Y = WS_X + (size_t)TT * DM * 4;
constexpr size_t WS_XB = WS_Y + (size_t)TT * DM * 4;
constexpr size_t WS_QA = WS_XB + (size_t)TT * DM * 2;
constexpr size_t WS_KVA = WS_QA + (size_t)TT * 512 * 4;
constexpr size_t WS_KRRAW = WS_KVA + (size_t)TT * 512 * 4;
constexpr size_t WS_SBQ = WS_KRRAW + (size_t)TT * 64 * 4;
constexpr size_t WS_GATE = WS_SBQ + (size_t)TT * 1024 * 2;
constexpr size_t WS_QN = WS_GATE + (size_t)TT * 4096 * 2;
constexpr size_t WS_LATB = WS_QN + (size_t)TT * 512 * 2;
constexpr size_t WS_KRB = WS_LATB + (size_t)TP * 512 * 2;
constexpr size_t WS_Q = WS_KRB + (size_t)TP * 64 * 2;
constexpr size_t WS_KVX = WS_Q + (size_t)TT * 3072 * 2 + 4096;
constexpr size_t WS_QLAT = WS_KVX + (size_t)TP * 4096 * 2;
constexpr size_t WS_CTX = WS_QLAT + (size_t)TS * 8192 * 2;
constexpr size_t WS_OA = WS_CTX + (size_t)TS * 8192 * 2;
constexpr size_t WS_OB = WS_OA + (size_t)TT * DM * 2;
constexpr size_t WS_T1 = WS_OB + (size_t)TT * 1024 * 2;
constexpr size_t WS_MRG = WS_T1 + (size_t)TT * DM * 4;
constexpr size_t WS_FFB = WS_MRG + (size_t)TT * DM * 2;
constexpr size_t WS_PP = WS_FFB + (size_t)TT * FF * 2;
constexpr size_t WS_ROPE = WS_PP + (size_t)TT * DM * 4;
constexpr size_t WS_END = WS_ROPE + (size_t)2 * SEQ * 32 * 4;

constexpr int CW_BAR = 4096, CW_Q = 16384;

constexpr int LDS_STAGE = 131072, LDS_MISC = LDS_STAGE, LDS_BYTES = 147456;

typedef __bf16 bf16x2_t __attribute__((ext_vector_type(2)));
typedef float f32x2_t __attribute__((ext_vector_type(2)));
__device__ __forceinline__ unsigned cvt_pk(float lo, float hi) { const f32x2_t v = {lo, hi}; const bf16x2_t b = __builtin_convertvector(v, bf16x2_t); return __builtin_bit_cast(unsigned, b); }
__device__ __forceinline__ float bflo(unsigned w) { return __uint_as_float(w << 16); }
__device__ __forceinline__ float bfhi(unsigned w) { return __uint_as_float(w & 0xffff0000u); }
__device__ __forceinline__ void st_bf16x8(bf16_t* p, f32x4 a, f32x4 b) { u32x4 w; w.x = cvt_pk(a[0], a[1]); w.y = cvt_pk(a[2], a[3]); w.z = cvt_pk(b[0], b[1]); w.w = cvt_pk(b[2], b[3]); *(u32x4*)p = w; }
__device__ __forceinline__ void st_f32x8(float* p, f32x4 a, f32x4 b) { *(f32x4*)p = a; *(f32x4*)(p + 4) = b; }
__device__ __forceinline__ void ld_bf16x8(const bf16_t* p, f32x4& a, f32x4& b) { const u32x4 w = *(const u32x4*)p; a = (f32x4){bflo(w.x), bfhi(w.x), bflo(w.y), bfhi(w.y)}; b = (f32x4){bflo(w.z), bfhi(w.z), bflo(w.w), bfhi(w.w)}; }
__device__ __forceinline__ float sigmoidf_(float x) { return __builtin_amdgcn_rcpf(1.f + __builtin_amdgcn_exp2f(-x * LOG2E)); }
__device__ __forceinline__ float wave_sum(float v) {
#pragma unroll
    for (int o = 1; o < 64; o <<= 1) v += __shfl_xor(v, o);
    return v;
}
__device__ __forceinline__ int tok_pos(int row) { return row < TP ? (row & (SEQ - 1)) : PAST + ((row - TP) & (DSEQ - 1)); }
__device__ __forceinline__ void rope_cs_slow(int pos, int i, float& c, float& s) {
    const float invf = __builtin_amdgcn_exp2f(-(float)i * 0.41524101186092029f);
    const float ang = (float)pos * invf;
    double a = (double)ang * 0.15915494309189535; a -= __builtin_floor(a);
    const float f = (float)a;
    c = __builtin_amdgcn_cosf(f); s = __builtin_amdgcn_sinf(f);
}

__device__ __forceinline__ int phase_tid(int wave_k) { int ln; asm volatile("v_mbcnt_lo_u32_b32 %0, -1, 0\n\tv_mbcnt_hi_u32_b32 %0, -1, %0" : "=v"(ln)); return (wave_k << 6) | ln; }
#define XB_TMO      128
#define XB_XCNT(j)  (256  + 64 * (j))
#define XB_XSUB(j)  (1280 + 64 * (j))
#define XB_XGEN(j)  (2304 + 64 * (j))
#define XB_TOP      3328
#define XB_TOPGEN   3392
#define XCD_BAR_WORDS 3456
#define XB_SPIN_CAP (1u << 22)
__device__ __forceinline__ unsigned xb_ld(unsigned* p)              { return __hip_atomic_load(p, __ATOMIC_RELAXED, __HIP_MEMORY_SCOPE_AGENT); }
__device__ __forceinline__ unsigned xb_add(unsigned* p, unsigned v) { return __hip_atomic_fetch_add(p, v, __ATOMIC_RELAXED, __HIP_MEMORY_SCOPE_AGENT); }
__device__ __forceinline__ unsigned xb_xcc_id() { return (unsigned)__builtin_amdgcn_s_getreg((3 << 11) | 20) & 0xFu; }
#define XB_SPIN(cond, bar) do { unsigned _sp = 0; while (cond) { __builtin_amdgcn_s_sleep(1); \
    if ((++_sp & 255u) == 0u) { if (xb_ld(&(bar)[XB_TMO])) break; if (_sp > XB_SPIN_CAP) { atomicAdd(&(bar)[XB_TMO], 1u); break; } } } } while (0)
struct XcdBarrier { unsigned* bar; unsigned x; volatile LAS unsigned* st; };
__device__ __forceinline__ XcdBarrier xcd_barrier_post(unsigned* bar, volatile LAS unsigned* st) {
    XcdBarrier b; b.bar = bar; b.x = xb_xcc_id(); b.st = st;
    if (threadIdx.x == 0) (void)xb_add(&bar[XB_XCNT(b.x)], 1u);
    return b;
}
__device__ __forceinline__ void xcd_barrier_complete(unsigned* bar, unsigned x, unsigned& nloc, unsigned& nx) {
    const unsigned G = gridDim.x * gridDim.y * gridDim.z;
    unsigned sum, cnt, mine, sp = 0u;
    for (;;) {
        sum = 0u; cnt = 0u; mine = 0u;
#pragma unroll
        for (unsigned j = 0; j < 16; ++j) { const unsigned c = xb_ld(&bar[XB_XCNT(j)]); sum += c; cnt += (c > 0u) ? 1u : 0u; mine = (j == x) ? c : mine; }
        if (sum == G) break;
        __builtin_amdgcn_s_sleep(1);
        if ((++sp & 255u) == 0u) { if (xb_ld(&bar[XB_TMO])) break; if (sp > XB_SPIN_CAP) { atomicAdd(&bar[XB_TMO], 1u); break; } }
    }
    nloc = mine > 0u ? mine : 1u; nx = cnt > 0u ? cnt : 1u;
}
__device__ __forceinline__ void xcd_barrier(const XcdBarrier& b, int wave_k) {
    asm volatile("s_waitcnt vmcnt(0)" ::: "memory");
    __syncthreads();
    if (phase_tid(wave_k) == 0) {
        unsigned* bar = b.bar;
        __builtin_amdgcn_s_waitcnt(0);
        unsigned nloc = b.st[0], nx = b.st[1];
        if (nloc == 0u) { xcd_barrier_complete(bar, b.x, nloc, nx); b.st[0] = nloc; b.st[1] = nx; }
        const unsigned old = xb_add(&bar[XB_XSUB(b.x)], 1u);
        const unsigned gen = old / nloc;
        if (old + 1u == (gen + 1u) * nloc) {
            __builtin_amdgcn_fence(__ATOMIC_RELEASE, "agent");
            asm volatile("s_waitcnt vmcnt(0)" ::: "memory");
            const unsigned og = xb_add(&bar[XB_TOP], 1u);
            const unsigned tg = og / nx;
            if (og + 1u == (tg + 1u) * nx) xb_add(&bar[XB_TOPGEN], 1u);
            else XB_SPIN(xb_ld(&bar[XB_TOPGEN]) == tg, bar);
            __builtin_amdgcn_fence(__ATOMIC_ACQUIRE, "agent");
            xb_add(&bar[XB_XGEN(b.x)], 1u);
            asm volatile("s_waitcnt vmcnt(0)" ::: "memory");
        } else {
            XB_SPIN(xb_ld(&bar[XB_XGEN(b.x)]) == gen, bar);
            __builtin_amdgcn_fence(__ATOMIC_ACQUIRE, "agent");
            asm volatile("s_waitcnt vmcnt(0)" ::: "memory");
        }
    }
    __syncthreads();
}

namespace pg8 {
constexpr int BM = 256, BK = 64, HALF = 128, HTB = HALF * BK * 2, NXCD = 8, WGM = 8;
__host__ __device__ __forceinline__ int lds_byte(int r, int c) { const int st = (r >> 4) * 2 + (c >> 5), rr = r & 15, cc = c & 31, ob = rr * 64 + cc * 2; return st * 1024 + (ob ^ (((ob >> 9) & 1) << 5)); }
__host__ __device__ __forceinline__ void stage_rc(int b, int& R, int& C) { const int st = b / 1024, sb = b % 1024, swz = sb ^ (((sb >> 9) & 1) << 5); R = (st >> 1) * 16 + swz / 64; C = (st & 1) * 32 + (swz % 64) / 2; }
__host__ __device__ __forceinline__ int perm32(int rho) { const int n = rho >> 4, i = rho & 15; return 8 * (i >> 2) + 4 * n + (i & 3); }

struct Unit { int pm, pn, z; };
template <int K_, int LDA_, int LDB_, int SAZ_ = 0, int SBZ_ = 0, int APN_ = 0> struct Shape { static constexpr int K = K_, lda = LDA_, ldb = LDB_, sAz = SAZ_, sBz = SBZ_, a_pn = APN_; };

struct Order {
    int nM, nN, per, total, G, c;
    __device__ void init(int M, int N, int nz, int G_, int c_) { nM = M / BM; nN = N / BM; per = nM * nN; total = per * nz; G = G_; c = c_; }
    __device__ bool next(int i, Unit& u) const {
        const long L = (long)i * G + c; if (L >= total) return false;
        const int z = (int)(L / per); int wgid = (int)(L % per);
        { const int q = per / NXCD, r = per % NXCD, xcd = wgid % NXCD, off = wgid / NXCD; wgid = (xcd < r ? xcd * (q + 1) : r * (q + 1) + (xcd - r) * q) + off; }
        const int nig = WGM * nN, gid = wgid / nig, fm = gid * WGM, gsz = (nM - fm) < WGM ? (nM - fm) : WGM;
        u.pm = fm + ((wgid % nig) % gsz); u.pn = (wgid % nig) / gsz; u.z = z; return true;
    }
};

#define EPI_LOOP(...) \
    _Pragma("unroll") for (int ai = 0; ai < 2; ++ai) _Pragma("unroll") for (int m = 0; m < 4; ++m) { const int row = u.pm * 256 + ai * 128 + wr * 64 + m * 16 + fr; \
    _Pragma("unroll") for (int bj = 0; bj < 2; ++bj) { const int col = u.pn * 256 + bj * 128 + wc * 32 + fq * 8; f32x4 v0 = acc[ai][bj][m][0], v1 = acc[ai][bj][m][1]; __VA_ARGS__ } asm volatile("" ::: "memory"); }

template <class g, class Epi>
__device__ __forceinline__ void gemm_phase(LAS unsigned char* lds, int wave_k, const bf16_t* gA, const bf16_t* gBt, const Order& S, const Epi& E) {
    const int tid = phase_tid(wave_k);
    const int wid = __builtin_amdgcn_readfirstlane(tid >> 6), lane = tid & 63, wr = wid >> 2, wc = wid & 3, fr = lane & 15, fq = lane >> 4;
    constexpr int K = g::K, nt = K / BK;
    unsigned voffA[2], voffB[2];
#pragma unroll
    for (int i = 0; i < 2; ++i) { int R, C; stage_rc(tid * 16 + i * 8192, R, C); const int Rb = (R & ~31) + perm32(R & 31);
        voffA[i] = (unsigned)(R * g::lda + C) * 2u; voffB[i] = (unsigned)(Rb * g::ldb + C) * 2u; }
    const size_t kstep = (size_t)(BK * 2);
    constexpr size_t hstepA = (size_t)HALF * g::lda * 2, hstepB = (size_t)HALF * g::ldb * 2;
    constexpr size_t tstepA = 2 * hstepA, tstepB = 2 * hstepB;
    const unsigned ldsw = (unsigned)wid * 1024u;
    const int aoff = lds_byte(wr * 64 + fr, fq * 8), boff = lds_byte(wc * 32 + fr, fq * 8);
#define PG8_UA(u_) ((const char*)gA + ((size_t)(u_).z * g::sAz + (size_t)(u_).pn * (size_t)g::a_pn) * 2 + (size_t)(u_).pm * tstepA)
#define PG8_UB(u_) ((const char*)gBt + (size_t)(u_).z * g::sBz * 2 + (size_t)(u_).pn * tstepB)
#define PG8_SA(b, h) (((b) * 2 + (h)) * HTB)
#define PG8_SB(b, h) ((4 + (b) * 2 + (h)) * HTB)
#define PG8_STAGE(bufoff, gbase, voff) do { _Pragma("unroll") for (int _i = 0; _i < 2; ++_i) \
        __builtin_amdgcn_global_load_lds((const unsigned*)((const char*)(gbase) + (voff)[_i]), (LAS unsigned*)(lds + (bufoff) + ldsw + _i * 8192), 16, 0, 0); } while (0)
#define PG8_LDA(dst, b, h) do { _Pragma("unroll") for (int m = 0; m < 4; ++m) _Pragma("unroll") for (int k = 0; k < 2; ++k) dst[m][k] = *(const LAS bf16x8*)(lds + PG8_SA(b, h) + aoff + m * 2048 + k * 1024); } while (0)
#define PG8_LDB(dst, b, h) do { _Pragma("unroll") for (int n = 0; n < 2; ++n) _Pragma("unroll") for (int k = 0; k < 2; ++k) dst[n][k] = *(const LAS bf16x8*)(lds + PG8_SB(b, h) + boff + n * 2048 + k * 1024); } while (0)
#define PG8_MMA(ai, bj, At, Bt) do { __builtin_amdgcn_s_setprio(1); _Pragma("unroll") for (int m = 0; m < 4; ++m) _Pragma("unroll") for (int n = 0; n < 2; ++n) _Pragma("unroll") for (int k = 0; k < 2; ++k) \
        acc[ai][bj][m][n] = __builtin_amdgcn_mfma_f32_16x16x32_bf16(Bt[n][k], At[m][k], acc[ai][bj][m][n], 0, 0, 0); __builtin_amdgcn_s_setprio(0); } while (0)
#define PG8_WAIT_V(n) asm volatile("s_waitcnt vmcnt(" #n ")" ::: "memory")
#define PG8_WAIT_L(n) asm volatile("s_waitcnt lgkmcnt(" #n ")" ::: "memory")
#define PG8_BAR __builtin_amdgcn_s_barrier()
#define PG8_SCHED __builtin_amdgcn_sched_barrier(0)
    Unit cur, nxt; int ui = 0;
    if (!S.next(0, cur)) return;
    f32x4 acc[2][2][4][2];
#pragma unroll
    for (int a = 0; a < 2; ++a)
#pragma unroll
        for (int b = 0; b < 2; ++b)
#pragma unroll
            for (int m = 0; m < 4; ++m)
#pragma unroll
                for (int n = 0; n < 2; ++n) acc[a][b][m][n] = (f32x4){0.f, 0.f, 0.f, 0.f};
    bf16x8 At[4][2], B0[2][2], B1[2][2];
    const char* cA = PG8_UA(cur); const char* cB = PG8_UB(cur);
    PG8_STAGE(PG8_SB(0, 0), cB, voffB); PG8_STAGE(PG8_SB(0, 1), cB + hstepB, voffB); PG8_STAGE(PG8_SA(0, 0), cA, voffA); PG8_STAGE(PG8_SA(0, 1), cA + hstepA, voffA);
    if (wr == 1) PG8_BAR;
    PG8_WAIT_V(2); PG8_BAR;
    PG8_STAGE(PG8_SB(1, 0), cB + kstep, voffB); PG8_STAGE(PG8_SA(1, 0), cA + kstep, voffA); PG8_STAGE(PG8_SB(1, 1), cB + hstepB + kstep, voffB);
    PG8_WAIT_V(6); PG8_BAR;
    for (;;) {
        const bool has_next = S.next(ui + 1, nxt);
        const char* nA = has_next ? PG8_UA(nxt) : cA; const char* nB = has_next ? PG8_UB(nxt) : cB;
#pragma unroll 1
        for (int t = 0; t < nt; t += 2) {
            const bool last = (t == nt - 2);
            const char* a1 = cA + (size_t)(t + 1) * kstep;
            const char* a2 = last ? nA : cA + (size_t)(t + 2) * kstep; const char* b2 = last ? nB : cB + (size_t)(t + 2) * kstep;
            const char* a3 = a2 + kstep; const char* b3 = b2 + kstep;
            PG8_LDB(B0, 0, 0); PG8_LDB(B1, 0, 1); PG8_SCHED; PG8_LDA(At, 0, 0); PG8_STAGE(PG8_SA(1, 1), a1 + hstepA, voffA);
            PG8_WAIT_V(8); PG8_WAIT_L(0); PG8_BAR; PG8_MMA(0, 0, At, B0); PG8_MMA(0, 1, At, B1); PG8_BAR; PG8_SCHED;
            PG8_LDA(At, 0, 1); PG8_STAGE(PG8_SB(0, 0), b2, voffB); PG8_STAGE(PG8_SB(0, 1), b2 + hstepB, voffB); PG8_STAGE(PG8_SA(0, 0), a2, voffA);
            PG8_WAIT_V(8); PG8_WAIT_L(0); PG8_BAR; PG8_MMA(1, 0, At, B0); PG8_MMA(1, 1, At, B1); PG8_BAR; PG8_SCHED;
            PG8_LDB(B0, 1, 0); PG8_LDB(B1, 1, 1); PG8_SCHED; PG8_LDA(At, 1, 0); PG8_STAGE(PG8_SA(0, 1), a2 + hstepA, voffA);
            PG8_WAIT_V(8); PG8_WAIT_L(0); PG8_BAR; PG8_MMA(0, 0, At, B0); PG8_MMA(0, 1, At, B1); PG8_BAR; PG8_SCHED;
            PG8_LDA(At, 1, 1); PG8_STAGE(PG8_SB(1, 0), b3, voffB); PG8_STAGE(PG8_SB(1, 1), b3 + hstepB, voffB); PG8_STAGE(PG8_SA(1, 0), a3, voffA);
            PG8_WAIT_V(8); PG8_WAIT_L(0); PG8_BAR; PG8_MMA(1, 0, At, B0); PG8_MMA(1, 1, At, B1); PG8_BAR; PG8_SCHED;
        }
        if (wr == 0) PG8_BAR;
        { const Unit& u = cur; EPI_LOOP( E.apply(row, col, u.z, v0, v1); ) }
        if (!has_next) break;
#pragma unroll
        for (int a = 0; a < 2; ++a)
#pragma unroll
            for (int b = 0; b < 2; ++b)
#pragma unroll
                for (int m = 0; m < 4; ++m)
#pragma unroll
                    for (int n = 0; n < 2; ++n) acc[a][b][m][n] = (f32x4){0.f, 0.f, 0.f, 0.f};
        cur = nxt; cA = nA; cB = nB; ++ui;
        if (wr == 1) PG8_BAR;
    }
    PG8_WAIT_V(0);
    PG8_BAR;
#undef PG8_UA
#undef PG8_UB
#undef PG8_SA
#undef PG8_SB
#undef PG8_STAGE
#undef PG8_LDA
#undef PG8_LDB
#undef PG8_MMA
#undef PG8_WAIT_V
#undef PG8_WAIT_L
#undef PG8_BAR
#undef PG8_SCHED
}

struct EpiIn {
    float* QA; float* KVA; float* KRRAW; bf16_t* SBQ; bf16_t* GATE; float* k_p; float* k_s; float* v_p; float* v_s; const float* bgate;
    __device__ __forceinline__ void apply(int row, int col, int z, f32x4 v0, f32x4 v1) const {
        const int pn = col >> 8;
        if (pn < 2) st_f32x8(QA + (unsigned)(row * 512 + col), v0, v1);
        else if (pn < 4) st_f32x8(KVA + (unsigned)(row * 512 + col - 512), v0, v1);
        else if (pn < 8) st_bf16x8(SBQ + (unsigned)(row * 1024 + col - 1024), v0, v1);
        else if (pn < 12) { float* d = row < TP ? k_p : k_s - (size_t)TP * 1024; st_f32x8(d + (unsigned)(row * 1024 + col - 2048), v0, v1); }
        else if (pn < 16) { float* d = row < TP ? v_p : v_s - (size_t)TP * 1024; st_f32x8(d + (unsigned)(row * 1024 + col - 3072), v0, v1); }
        else if (pn < 32) { const unsigned c = (unsigned)(col - 4096); const f32x4 b0 = *(const f32x4*)(bgate + c), b1 = *(const f32x4*)(bgate + c + 4); f32x4 g0, g1;
#pragma unroll
            for (int j = 0; j < 4; ++j) { g0[j] = sigmoidf_(v0[j] + b0[j]); g1[j] = sigmoidf_(v1[j] + b1[j]); }
            st_bf16x8(GATE + ((unsigned)(row * 4096) + c), g0, g1); }
        else { const int c = col - 8192; if (c < 64) st_f32x8(KRRAW + (unsigned)(row * 64 + c), v0, v1); }
    }
};
struct EpiQ {
    bf16_t* Q; const float* ROPE;
    __device__ __forceinline__ void apply(int row, int col, int z, f32x4 v0, f32x4 v1) const {
        const int h = col / 192, w = col - h * 192;
        if (w >= 128) { const int pos = tok_pos(row), i0 = (w - 128) >> 1; const f32x4 c = *(const f32x4*)(ROPE + pos * 32 + i0), s = *(const f32x4*)(ROPE + SEQ * 32 + pos * 32 + i0);
            { const float a = v0[0], b = v0[1]; v0[0] = a * c[0] - b * s[0]; v0[1] = b * c[0] + a * s[0]; }
            { const float a = v0[2], b = v0[3]; v0[2] = a * c[1] - b * s[1]; v0[3] = b * c[1] + a * s[1]; }
            { const float a = v1[0], b = v1[1]; v1[0] = a * c[2] - b * s[2]; v1[1] = b * c[2] + a * s[2]; }
            { const float a = v1[2], b = v1[3]; v1[2] = a * c[3] - b * s[3]; v1[3] = b * c[3] + a * s[3]; } }
        st_bf16x8(Q + (unsigned)(row * 3072 + col), v0, v1);
    }
};
struct EpiBf16 {
    bf16_t* O; int ldc; int zoff;
    __device__ __forceinline__ void apply(int row, int col, int z, f32x4 v0, f32x4 v1) const { st_bf16x8(O + (unsigned)(row * ldc + z * zoff + col), v0, v1); }
};
struct EpiF32 {
    float* O; int ldc;
    __device__ __forceinline__ void apply(int row, int col, int z, f32x4 v0, f32x4 v1) const { st_f32x8(O + (unsigned)(row * ldc + col), v0, v1); }
};
struct EpiBrB {
    float* T1; const bf16_t* GATE;
    __device__ __forceinline__ void apply(int row, int col, int z, f32x4 v0, f32x4 v1) const {
        f32x4 g0, g1; ld_bf16x8(GATE + (unsigned)(row * 4096 + 2048 + col), g0, g1); st_f32x8(T1 + (unsigned)(row * DM + col), v0 * g0, v1 * g1); }
};
struct EpiBrA {
    bf16_t* MRG; const float* T1; const bf16_t* GATE;
    __device__ __forceinline__ void apply(int row, int col, int z, f32x4 v0, f32x4 v1) const {
        f32x4 g0, g1; ld_bf16x8(GATE + (unsigned)(row * 4096 + col), g0, g1); const float* t = T1 + (unsigned)(row * DM + col);
        const f32x4 t0 = *(const f32x4*)t, t1 = *(const f32x4*)(t + 4); st_bf16x8(MRG + (unsigned)(row * DM + col), t0 + v0 * g0, t1 + v1 * g1); }
};
struct EpiRes {
    float* Y; const float* X;
    __device__ __forceinline__ void apply(int row, int col, int z, f32x4 v0, f32x4 v1) const {
        const float* x = X + (unsigned)(row * DM + col); const f32x4 x0 = *(const f32x4*)x, x1 = *(const f32x4*)(x + 4);
        st_f32x8(Y + (unsigned)(row * DM + col), x0 * ALPHA + v0, x1 * ALPHA + v1); }
};
struct EpiGU {
    bf16_t* FFB;
    __device__ __forceinline__ void apply(int row, int col, int z, f32x4 v0, f32x4 v1) const {
        f32x4 r;
#pragma unroll
        for (int j = 0; j < 4; ++j) r[j] = v0[j] * sigmoidf_(v0[j]) * v1[j];
        u32x2 w; w.x = cvt_pk(r[0], r[1]); w.y = cvt_pk(r[2], r[3]); *(u32x2*)(FFB + (unsigned)(row * FF + (col >> 1))) = w; }
};
struct EpiPle {
    float* Y; const float* X; const float* PP; const float* bias;
    __device__ __forceinline__ void apply(int row, int col, int z, f32x4 v0, f32x4 v1) const {
        const unsigned o = (unsigned)(row * DM + col); const f32x4 x0 = *(const f32x4*)(X + o), x1 = *(const f32x4*)(X + o + 4), p0 = *(const f32x4*)(PP + o), p1 = *(const f32x4*)(PP + o + 4);
        const f32x4 b0 = *(const f32x4*)(bias + (unsigned)col), b1 = *(const f32x4*)(bias + (unsigned)col + 4); f32x4 r0, r1;
#pragma unroll
        for (int j = 0; j < 4; ++j) { r0[j] = x0[j] * ALPHA + sigmoidf_(v0[j] + b0[j]) * p0[j]; r1[j] = x1[j] * ALPHA + sigmoidf_(v1[j] + b1[j]) * p1[j]; }
        st_f32x8(Y + o, r0, r1); }
};

template <int K, int LDA, int LDB, int APN, class Epi>
__device__ __forceinline__ void gemm_small(LAS unsigned char* lds, int wave_k, const bf16_t* gA, const bf16_t* gBt, int row0, int n_rt, int n_ct, int G, int c, const Epi& E) {
    const int tid = phase_tid(wave_k);
    const int wid = __builtin_amdgcn_readfirstlane(tid >> 6), lane = tid & 63, wc = wid & 1, wm = wid >> 1, fr = lane & 15, fq = lane >> 4;
    constexpr int nt = K / 64;
    int R, C; stage_rc(tid * 16, R, C);
    const int Rb = (R & ~31) + perm32(R & 31);
    const unsigned voffA = (unsigned)(R * LDA + C) * 2u, voffB = (unsigned)(Rb * LDB + C) * 2u;
    const unsigned ldsw = (unsigned)wid * 1024u;
    const int aoff = lds_byte(wm * 16 + fr, fq * 8), boff = lds_byte(wc * 32 + fr, fq * 8);
#define SM_STAGE(slot, pa, pb) do { \
        __builtin_amdgcn_global_load_lds((const unsigned*)((pa) + voffA), (LAS unsigned*)(lds + (slot) * 16384 + ldsw), 16, 0, 0); \
        __builtin_amdgcn_global_load_lds((const unsigned*)((pb) + voffB), (LAS unsigned*)(lds + (slot) * 16384 + 8192 + ldsw), 16, 0, 0); } while (0)
    for (int u = c; u < n_rt * n_ct; u += G) {
        const int xcd = u & 7, idx = u >> 3, rt = idx % n_rt, ct = xcd * (n_ct >> 3) + idx / n_rt;
        const char* pa = (const char*)gA + ((size_t)(row0 + rt * 64) * LDA + (size_t)(ct >> 2) * APN) * 2;
        const char* pb = (const char*)gBt + (size_t)(ct * 64) * LDB * 2;
        f32x4 acc0 = (f32x4){0.f, 0.f, 0.f, 0.f}, acc1 = acc0;
        SM_STAGE(0, pa, pb); SM_STAGE(1, pa + 128, pb + 128); SM_STAGE(2, pa + 256, pb + 256);
#pragma unroll 1
        for (int t = 0; t < nt; ++t) {
            asm volatile("s_waitcnt vmcnt(4)" ::: "memory");
            __builtin_amdgcn_s_barrier();
            { const int tn = (t + 3 < nt) ? t + 3 : nt - 1;
              SM_STAGE((t + 3) & 3, pa + (size_t)tn * 128, pb + (size_t)tn * 128); }
            const LAS unsigned char* sl = lds + (t & 3) * 16384;
            const bf16x8 a0 = *(const LAS bf16x8*)(sl + aoff), a1 = *(const LAS bf16x8*)(sl + aoff + 1024);
            const bf16x8 b00 = *(const LAS bf16x8*)(sl + 8192 + boff), b01 = *(const LAS bf16x8*)(sl + 8192 + boff + 1024);
            const bf16x8 b10 = *(const LAS bf16x8*)(sl + 8192 + boff + 2048), b11 = *(const LAS bf16x8*)(sl + 8192 + boff + 2048 + 1024);
            acc0 = __builtin_amdgcn_mfma_f32_16x16x32_bf16(b00, a0, acc0, 0, 0, 0); acc1 = __builtin_amdgcn_mfma_f32_16x16x32_bf16(b10, a0, acc1, 0, 0, 0);
            acc0 = __builtin_amdgcn_mfma_f32_16x16x32_bf16(b01, a1, acc0, 0, 0, 0); acc1 = __builtin_amdgcn_mfma_f32_16x16x32_bf16(b11, a1, acc1, 0, 0, 0);
        }
        asm volatile("s_waitcnt vmcnt(0)" ::: "memory");
        __builtin_amdgcn_s_barrier();
        E.apply(row0 + rt * 64 + wm * 16 + fr, ct * 64 + wc * 32 + fq * 8, 0, acc0, acc1);
    }
#undef SM_STAGE
}
}

template <int OFF> __device__ __forceinline__ s16x4 tr_read(unsigned addr) {
    s16x4 r; asm volatile("ds_read_b64_tr_b16 %0, %1 offset:%2" : "=&v"(r) : "v"(addr), "i"(OFF) : "memory"); return r;
}
#define PKTR(L, H) ((bf16x8){L[0], L[1], L[2], L[3], H[0], H[1], H[2], H[3]})
__device__ __forceinline__ bf16x8 pack8(float a0, float a1, float a2, float a3, float a4, float a5, float a6, float a7) {
    u32x4 w; w.x = cvt_pk(a0, a1); w.y = cvt_pk(a2, a3); w.z = cvt_pk(a4, a5); w.w = cvt_pk(a6, a7); return __builtin_bit_cast(bf16x8, w);
}
constexpr int AV_ROW = 320;
template <int DBLK> __device__ __forceinline__ void pv_block(f32x16& od, unsigned vaddr, const bf16x8 (&pb)[4]) {
    const s16x4 l0 = tr_read<(0 * 16 + 0) * AV_ROW + DBLK * 64>(vaddr), h0 = tr_read<(0 * 16 + 8) * AV_ROW + DBLK * 64>(vaddr);
    const s16x4 l1 = tr_read<(1 * 16 + 0) * AV_ROW + DBLK * 64>(vaddr), h1 = tr_read<(1 * 16 + 8) * AV_ROW + DBLK * 64>(vaddr);
    const s16x4 l2 = tr_read<(2 * 16 + 0) * AV_ROW + DBLK * 64>(vaddr), h2 = tr_read<(2 * 16 + 8) * AV_ROW + DBLK * 64>(vaddr);
    const s16x4 l3 = tr_read<(3 * 16 + 0) * AV_ROW + DBLK * 64>(vaddr), h3 = tr_read<(3 * 16 + 8) * AV_ROW + DBLK * 64>(vaddr);
    asm volatile("s_waitcnt lgkmcnt(0)" ::: "memory"); __builtin_amdgcn_sched_barrier(0);
    od = __builtin_amdgcn_mfma_f32_32x32x16_bf16(PKTR(l0, h0), pb[0], od, 0, 0, 0);
    od = __builtin_amdgcn_mfma_f32_32x32x16_bf16(PKTR(l1, h1), pb[1], od, 0, 0, 0);
    od = __builtin_amdgcn_mfma_f32_32x32x16_bf16(PKTR(l2, h2), pb[2], od, 0, 0, 0);
    od = __builtin_amdgcn_mfma_f32_32x32x16_bf16(PKTR(l3, h3), pb[3], od, 0, 0, 0);
}

constexpr int AK_ROW = 400, AK_TILE = 64 * AK_ROW, AV_TILE = 64 * AV_ROW;
__device__ __forceinline__ void attn_mla_prompt(LAS unsigned char* lds, int wave_k, const bf16_t* __restrict__ Q, const bf16_t* __restrict__ KVX, const bf16_t* __restrict__ KRB,
                                                bf16_t* __restrict__ OA, int b, int h, int qb) {
    const int tid = phase_tid(wave_k);
    const int wid = __builtin_amdgcn_readfirstlane(tid >> 6), lane = tid & 63, r32 = lane & 31, hi = lane >> 5;
    const int NT = 4 * qb + 4, my_last = 4 * qb + (wid >> 1);
    const int tok = b * SEQ + qb * 256 + wid * 32 + r32;
    bf16x8 qr[12];
    { const bf16_t* qp = Q + (size_t)tok * 3072 + h * 192 + hi * 8;
#pragma unroll
      for (int s = 0; s < 12; ++s) qr[s] = *(const bf16x8*)(qp + 16 * s); }
    f32x16 o[4];
#pragma unroll
    for (int d = 0; d < 4; ++d)
#pragma unroll
        for (int r = 0; r < 16; ++r) o[d][r] = 0.f;
    float m_run = -INFINITY, l_run = 0.f;
    const bf16_t* kbase = KVX + (size_t)(b * SEQ) * 4096 + h * 256;
    const bf16_t* rbase = KRB + (size_t)(b * SEQ) * 64;
    const int r0 = tid >> 4, c0 = tid & 15, rr = tid >> 3, rc = tid & 7;
    u32x4 sk0, sk1, sr, sv0, sv1;
#define A_LOAD(kt) do { const bf16_t* kp = kbase + (size_t)((kt) * 64 + r0) * 4096 + c0 * 8; \
        sk0 = *(const u32x4*)kp; sk1 = *(const u32x4*)(kp + (size_t)32 * 4096); sv0 = *(const u32x4*)(kp + 128); sv1 = *(const u32x4*)(kp + (size_t)32 * 4096 + 128); \
        sr = *(const u32x4*)(rbase + (size_t)((kt) * 64 + rr) * 64 + rc * 8); } while (0)
#define A_WRITE(buf) do { LAS unsigned char* Kb = lds + (buf) * AK_TILE; LAS unsigned char* Vb = lds + 2 * AK_TILE + (buf) * AV_TILE; \
        *(LAS u32x4*)(Kb + r0 * AK_ROW + c0 * 16) = sk0; *(LAS u32x4*)(Kb + (r0 + 32) * AK_ROW + c0 * 16) = sk1; *(LAS u32x4*)(Kb + rr * AK_ROW + 256 + rc * 16) = sr; \
        *(LAS u32x4*)(Vb + r0 * AV_ROW + c0 * 16) = sv0; *(LAS u32x4*)(Vb + (r0 + 32) * AV_ROW + c0 * 16) = sv1; } while (0)
    const unsigned ldsb = (unsigned)(uintptr_t)lds;
    const unsigned vaddr0 = ldsb + 2 * AK_TILE + (4 * hi + ((lane & 15) >> 2)) * AV_ROW + (16 * ((lane >> 4) & 1) + 4 * (lane & 3)) * 2;
    __syncthreads();
    A_LOAD(0); A_WRITE(0);
    for (int kt = 0; kt < NT; ++kt) {
        __syncthreads();
        if (kt + 1 < NT) A_LOAD(kt + 1);
        if (kt <= my_last) {
            const int buf = kt & 1;
            const LAS unsigned char* Kl = lds + buf * AK_TILE + r32 * AK_ROW + hi * 16;
            f32x16 p0, p1;
#ifdef PROBE_A_QK
            int qreps = 2; asm volatile("" : "+s"(qreps));
            for (int qq = 0; qq < qreps; ++qq) {
#else
            {
#endif
#pragma unroll
            for (int r = 0; r < 16; ++r) { p0[r] = 0.f; p1[r] = 0.f; }
#pragma unroll
            for (int s = 0; s < 12; s += 2) {
                const bf16x8 a0 = *(const LAS bf16x8*)(Kl + s * 32), a1 = *(const LAS bf16x8*)(Kl + 32 * AK_ROW + s * 32);
                const bf16x8 c0 = *(const LAS bf16x8*)(Kl + s * 32 + 32), c1 = *(const LAS bf16x8*)(Kl + 32 * AK_ROW + s * 32 + 32);
                p0 = __builtin_amdgcn_mfma_f32_32x32x16_bf16(a0, qr[s], p0, 0, 0, 0);
                p1 = __builtin_amdgcn_mfma_f32_32x32x16_bf16(a1, qr[s], p1, 0, 0, 0);
                p0 = __builtin_amdgcn_mfma_f32_32x32x16_bf16(c0, qr[s + 1], p0, 0, 0, 0);
                p1 = __builtin_amdgcn_mfma_f32_32x32x16_bf16(c1, qr[s + 1], p1, 0, 0, 0);
                if ((s % 4) == 2) asm volatile("" ::: "memory");
            }
            }
            float tmax = p0[0];
#pragma unroll
            for (int r = 1; r < 16; ++r) tmax = fmaxf(tmax, p0[r]);
#pragma unroll
            for (int r = 0; r < 16; ++r) tmax = fmaxf(tmax, p1[r]);
            tmax = fmaxf(tmax, __shfl_xor(tmax, 32));
            const float mn = fmaxf(m_run, tmax), alpha = __builtin_amdgcn_exp2f((m_run - mn) * MLA_C), mc = mn * MLA_C;
            m_run = mn;
            float ls = 0.f;
#pragma unroll
            for (int r = 0; r < 16; ++r) { p0[r] = __builtin_amdgcn_exp2f(p0[r] * MLA_C - mc); p1[r] = __builtin_amdgcn_exp2f(p1[r] * MLA_C - mc); ls += p0[r] + p1[r]; }
            l_run = l_run * alpha + ls;
#pragma unroll
            for (int d = 0; d < 4; ++d)
#pragma unroll
                for (int r = 0; r < 16; ++r) o[d][r] *= alpha;
            bf16x8 pb[4];
            pb[0] = pack8(p0[0], p0[1], p0[2], p0[3], p0[4], p0[5], p0[6], p0[7]);
            pb[1] = pack8(p0[8], p0[9], p0[10], p0[11], p0[12], p0[13], p0[14], p0[15]);
            pb[2] = pack8(p1[0], p1[1], p1[2], p1[3], p1[4], p1[5], p1[6], p1[7]);
            pb[3] = pack8(p1[8], p1[9], p1[10], p1[11], p1[12], p1[13], p1[14], p1[15]);
            const unsigned va = vaddr0 + buf * AV_TILE;
            pv_block<0>(o[0], va, pb); pv_block<1>(o[1], va, pb); pv_block<2>(o[2], va, pb); pv_block<3>(o[3], va, pb);
#ifdef PROBE_A_PV
            { bf16x8 pz[4]; int zz = 0; asm volatile("" : "+v"(zz));
              _Pragma("unroll") for (int i = 0; i < 4; ++i) pz[i] = (bf16x8){(short)zz, (short)zz, (short)zz, (short)zz, (short)zz, (short)zz, (short)zz, (short)zz};
              pv_block<0>(o[0], va, pz); pv_block<1>(o[1], va, pz); pv_block<2>(o[2], va, pz); pv_block<3>(o[3], va, pz); }
#endif
        }
        if (kt + 1 < NT) A_WRITE((kt + 1) & 1);
    }
#undef A_LOAD
#undef A_WRITE
    const float inv = 1.f / (l_run + __shfl_xor(l_run, 32));
    bf16_t* op = OA + (size_t)tok * DM + h * 128 + 4 * hi;
#pragma unroll
    for (int d = 0; d < 4; ++d)
#pragma unroll
        for (int g = 0; g < 4; ++g) { u32x2 w; w.x = cvt_pk(o[d][4 * g] * inv, o[d][4 * g + 1] * inv); w.y = cvt_pk(o[d][4 * g + 2] * inv, o[d][4 * g + 3] * inv);
            *(u32x2*)(op + 32 * d + 8 * g) = w; }
}

constexpr int BK_ROW = 272, BK_TILE = 64 * BK_ROW;
constexpr int SB_FLAG_OFF = 2 * BK_TILE + 2 * AV_TILE;
__device__ __forceinline__ void sb_half(f32x16& p, int kbase, int qpos, float& run, int hi) {
    f32x16 L;
#pragma unroll
    for (int r = 0; r < 16; ++r) {
        const int kk = kbase + (r & 3) + 8 * (r >> 2);
        const float z = p[r] * SB_SCALE; const float e = __builtin_amdgcn_exp2f(-fabsf(z) * LOG2E); const float sp = __builtin_amdgcn_logf(1.f + e) * LN2;
        const bool bef = kk < qpos; const float madd = bef ? 0.f : -1e30f, mmul = bef ? 1.f : 0.f;
        p[r] = (fminf(z, 0.f) - sp) + madd; L[r] = (fminf(-z, 0.f) - sp) * mmul;
    }
    float qs[4], pq[4];
#pragma unroll
    for (int g = 0; g < 4; ++g) { qs[g] = (L[4 * g] + L[4 * g + 1]) + (L[4 * g + 2] + L[4 * g + 3]); pq[g] = __shfl_xor(qs[g], 32); }
#pragma unroll
    for (int g = 3; g >= 0; --g) {
        const float t3 = run + (hi == 0 ? pq[g] : 0.f), t2 = t3 + L[4 * g + 3], t1 = t2 + L[4 * g + 2], t0 = t1 + L[4 * g + 1];
        p[4 * g + 3] = __builtin_amdgcn_exp2f((p[4 * g + 3] + t3) * LOG2E); p[4 * g + 2] = __builtin_amdgcn_exp2f((p[4 * g + 2] + t2) * LOG2E);
        p[4 * g + 1] = __builtin_amdgcn_exp2f((p[4 * g + 1] + t1) * LOG2E); p[4 * g + 0] = __builtin_amdgcn_exp2f((p[4 * g + 0] + t0) * LOG2E);
        run += qs[g] + pq[g];
    }
}
struct SbSrc { const float* k_main; const float* v_main; const float* k_new; const float* v_new; int new_tile; };
__device__ __forceinline__ void attn_sb(LAS unsigned char* lds, int wave_k, const bf16_t* __restrict__ Qrow0  , const SbSrc src, bf16_t* __restrict__ Orow0  ,
                                        int kt_top, int nwact  , int qpos0  , int top_shift  ) {
    const int tid = phase_tid(wave_k);
    const int wid = __builtin_amdgcn_readfirstlane(tid >> 6), lane = tid & 63, r32 = lane & 31, hi = lane >> 5;
    const bool wact = wid < nwact;
    const int my_top = top_shift ? kt_top - ((7 - wid) >> 1) : kt_top;
    const int qpos = qpos0 + wid * 32 + r32;
    bf16x8 qr[8];
    if (wact) { const bf16_t* qp = Qrow0 + (size_t)(wid * 32 + r32) * 1024 + hi * 8;
#pragma unroll
        for (int s = 0; s < 8; ++s) qr[s] = *(const bf16x8*)(qp + 16 * s); }
    else {
#pragma unroll
        for (int s = 0; s < 8; ++s) qr[s] = (bf16x8){0, 0, 0, 0, 0, 0, 0, 0}; }
    f32x16 o[4];
#pragma unroll
    for (int d = 0; d < 4; ++d)
#pragma unroll
        for (int r = 0; r < 16; ++r) o[d][r] = 0.f;
    float carry = 0.f;
    const int srow = tid >> 3, scol = (tid & 7) * 16;
    f32x4 fk[4], fv[4];
#define B_LOADK(kt) do { const bool isnew = ((kt) == src.new_tile); const bool valid = !isnew || srow < 32; \
        const float* kp = (isnew ? src.k_new : src.k_main + (size_t)(kt) * 64 * 1024) + (size_t)srow * 1024 + scol; \
        if (valid) { _Pragma("unroll") for (int j = 0; j < 4; ++j) fk[j] = *(const f32x4*)(kp + 4 * j); } \
        else { _Pragma("unroll") for (int j = 0; j < 4; ++j) fk[j] = (f32x4){0.f, 0.f, 0.f, 0.f}; } } while (0)
#define B_LOADV(kt) do { const bool isnew = ((kt) == src.new_tile); const bool valid = !isnew || srow < 32; \
        const float* vp = (isnew ? src.v_new : src.v_main + (size_t)(kt) * 64 * 1024) + (size_t)srow * 1024 + scol; \
        if (valid) { _Pragma("unroll") for (int j = 0; j < 4; ++j) fv[j] = *(const f32x4*)(vp + 4 * j); } \
        else { _Pragma("unroll") for (int j = 0; j < 4; ++j) fv[j] = (f32x4){0.f, 0.f, 0.f, 0.f}; } } while (0)
#define B_WRITE(buf) do { LAS unsigned char* Kb = lds + (buf) * BK_TILE + srow * BK_ROW + scol * 2; LAS unsigned char* Vb = lds + 2 * BK_TILE + (buf) * AV_TILE + srow * AV_ROW + scol * 2; \
        u32x4 w; w.x = cvt_pk(fk[0][0], fk[0][1]); w.y = cvt_pk(fk[0][2], fk[0][3]); w.z = cvt_pk(fk[1][0], fk[1][1]); w.w = cvt_pk(fk[1][2], fk[1][3]); *(LAS u32x4*)Kb = w; \
        w.x = cvt_pk(fk[2][0], fk[2][1]); w.y = cvt_pk(fk[2][2], fk[2][3]); w.z = cvt_pk(fk[3][0], fk[3][1]); w.w = cvt_pk(fk[3][2], fk[3][3]); *(LAS u32x4*)(Kb + 16) = w; \
        w.x = cvt_pk(fv[0][0], fv[0][1]); w.y = cvt_pk(fv[0][2], fv[0][3]); w.z = cvt_pk(fv[1][0], fv[1][1]); w.w = cvt_pk(fv[1][2], fv[1][3]); *(LAS u32x4*)Vb = w; \
        w.x = cvt_pk(fv[2][0], fv[2][1]); w.y = cvt_pk(fv[2][2], fv[2][3]); w.z = cvt_pk(fv[3][0], fv[3][1]); w.w = cvt_pk(fv[3][2], fv[3][3]); *(LAS u32x4*)(Vb + 16) = w; } while (0)
    const unsigned ldsb = (unsigned)(uintptr_t)lds;
    const unsigned vaddr0 = ldsb + 2 * BK_TILE + (4 * hi + ((lane & 15) >> 2)) * AV_ROW + (16 * ((lane >> 4) & 1) + 4 * (lane & 3)) * 2;
    volatile LAS unsigned* flags = (volatile LAS unsigned*)(lds + SB_FLAG_OFF);
    __syncthreads();
    if (tid < 16) flags[tid] = 0u;
    B_LOADK(kt_top); B_LOADV(kt_top); B_WRITE(kt_top & 1);
    for (int kt = kt_top; kt >= 0; --kt) {
        __syncthreads();
        if (kt != kt_top) {
            unsigned alld = 1u;
#pragma unroll
            for (int w = 0; w < 8; ++w) alld &= flags[((kt + 1) & 1) * 8 + w];
#ifndef DBG_NO_EXIT
            if (alld) break;
        }
        unsigned mydone = wact ? 0u : 1u;
        const bool act = wact && kt <= my_top;
        const int buf = kt & 1;
        f32x16 p0, p1;
#pragma unroll
        for (int r = 0; r < 16; ++r) { p0[r] = 0.f; p1[r] = 0.f; }
        if (act) {
            const LAS unsigned char* Kl = lds + buf * BK_TILE + r32 * BK_ROW + hi * 16;
#pragma unroll
            for (int s = 0; s < 8; s += 2) {
                const bf16x8 a0 = *(const LAS bf16x8*)(Kl + s * 32), a1 = *(const LAS bf16x8*)(Kl + 32 * BK_ROW + s * 32);
                const bf16x8 c0 = *(const LAS bf16x8*)(Kl + s * 32 + 32), c1 = *(const LAS bf16x8*)(Kl + 32 * BK_ROW + s * 32 + 32);
                p0 = __builtin_amdgcn_mfma_f32_32x32x16_bf16(a0, qr[s], p0, 0, 0, 0);
                p1 = __builtin_amdgcn_mfma_f32_32x32x16_bf16(a1, qr[s], p1, 0, 0, 0);
                p0 = __builtin_amdgcn_mfma_f32_32x32x16_bf16(c0, qr[s + 1], p0, 0, 0, 0);
                p1 = __builtin_amdgcn_mfma_f32_32x32x16_bf16(c1, qr[s + 1], p1, 0, 0, 0);
                if ((s & 3) == 2) asm volatile("" ::: "memory");
            }
            float run = carry;
            sb_half(p1, kt * 64 + 32 + 4 * hi, qpos, run, hi);
            __builtin_amdgcn_sched_barrier(0);
            sb_half(p0, kt * 64 + 4 * hi, qpos, run, hi);
            carry = run;
        }
        asm volatile("" ::: "memory");
        if (kt > 0) { B_LOADK(kt - 1); B_LOADV(kt - 1); }
        if (act) {
            bf16x8 pb[4];
            pb[0] = pack8(p0[0], p0[1], p0[2], p0[3], p0[4], p0[5], p0[6], p0[7]);
            pb[1] = pack8(p0[8], p0[9], p0[10], p0[11], p0[12], p0[13], p0[14], p0[15]);
            pb[2] = pack8(p1[0], p1[1], p1[2], p1[3], p1[4], p1[5], p1[6], p1[7]);
            pb[3] = pack8(p1[8], p1[9], p1[10], p1[11], p1[12], p1[13], p1[14], p1[15]);
            const unsigned va = vaddr0 + buf * AV_TILE;
            pv_block<0>(o[0], va, pb); pv_block<1>(o[1], va, pb); pv_block<2>(o[2], va, pb); pv_block<3>(o[3], va, pb);
            mydone = __all(carry < -110.f) ? 1u : 0u;
        }
        if (lane == 0) flags[(kt & 1) * 8 + wid] = mydone;
        if (kt > 0) B_WRITE((kt - 1) & 1);
    }
#endif
#undef B_LOADK
#undef B_LOADV
#undef B_WRITE
    if (wact) {
        bf16_t* op = Orow0 + (size_t)(wid * 32 + r32) * 1024 + 4 * hi;
#pragma unroll
        for (int d = 0; d < 4; ++d)
#pragma unroll
            for (int g = 0; g < 4; ++g) { u32x2 w; w.x = cvt_pk(o[d][4 * g], o[d][4 * g + 1]); w.y = cvt_pk(o[d][4 * g + 2], o[d][4 * g + 3]); *(u32x2*)(op + 32 * d + 8 * g) = w; }
    }
}

constexpr int C_ROW = 1184, C_TILE = 32 * C_ROW, C_XOFF = 3 * C_TILE, C_XPB = 0, C_XAL = 8 * 1024;
template <int DT0> __device__ __forceinline__ void pvc8(f32x4 (&o)[32], unsigned vaddr, bf16x8 pb) {
#define PVC1(j) { const s16x4 lo = tr_read<(DT0 + j) * 32>(vaddr), hi_ = tr_read<16 * C_ROW + (DT0 + j) * 32>(vaddr); asm volatile("s_waitcnt lgkmcnt(0)" ::: "memory"); __builtin_amdgcn_sched_barrier(0); \
        o[DT0 + j] = __builtin_amdgcn_mfma_f32_16x16x32_bf16(PKTR(lo, hi_), pb, o[DT0 + j], 0, 0, 0); }
    PVC1(0) PVC1(1) PVC1(2) PVC1(3) PVC1(4) PVC1(5) PVC1(6) PVC1(7)
#undef PVC1
}
__device__ __forceinline__ void attn_mla_sample(LAS unsigned char* lds, int wave_k, const bf16_t* __restrict__ QLAT, const bf16_t* __restrict__ Q, const bf16_t* __restrict__ LATS  ,
                                                const bf16_t* __restrict__ KRS  , bf16_t* __restrict__ CTX, int b, int rg) {
    const int tid = phase_tid(wave_k);
    const int wid = __builtin_amdgcn_readfirstlane(tid >> 6), lane = tid & 63, c16 = lane & 15, g = lane >> 4;
    const bool pvw = wid >= 4; const int j4 = wid & 3;
    const int R = rg * 4 + j4, h = R >> 1, q = (R & 1) * 16 + c16;
    const int srow = b * DSEQ + q;
    f32x4 o[32];
#pragma unroll
    for (int d = 0; d < 32; ++d) o[d] = (f32x4){0.f, 0.f, 0.f, 0.f};
    if (!pvw) { const bf16_t* qp = QLAT + (size_t)srow * 8192 + h * 512 + g * 8;
#pragma unroll
      for (int s = 0; s < 16; ++s) o[s] = *(const f32x4*)(qp + 32 * s);
      const bf16_t* qr_ = Q + (size_t)(TP + srow) * 3072 + h * 192 + 128 + g * 8;
      o[16] = *(const f32x4*)qr_; o[17] = *(const f32x4*)(qr_ + 32); }
    float m_run = -INFINITY, l_run = 0.f;
    u32x4 st[5];
#define C_LOAD(kt) do { _Pragma("unroll") for (int j = 0; j < 4; ++j) { const int ch = tid + 512 * j, r = ch >> 6, c = ch & 63; st[j] = *(const u32x4*)(LATS + (size_t)((kt) * 32 + r) * 512 + c * 8); } \
        if (tid < 256) st[4] = *(const u32x4*)(KRS + (size_t)((kt) * 32 + (tid >> 3)) * 64 + (tid & 7) * 8); } while (0)
#define C_WRITE(buf) do { LAS unsigned char* Tb = lds + (buf) * C_TILE; _Pragma("unroll") for (int j = 0; j < 4; ++j) { const int ch = tid + 512 * j, r = ch >> 6, c = ch & 63; *(LAS u32x4*)(Tb + r * C_ROW + c * 16) = st[j]; } \
        if (tid < 256) *(LAS u32x4*)(Tb + (tid >> 3) * C_ROW + 1024 + (tid & 7) * 16) = st[4]; } while (0)
    const unsigned ldsb = (unsigned)(uintptr_t)lds;
    const unsigned vaddr0 = ldsb + (4 * g + (c16 >> 2)) * C_ROW + (c16 & 3) * 8;
    LAS unsigned char* xpb = lds + C_XOFF + C_XPB + j4 * 1024 + lane * 16;
    LAS unsigned char* xal = lds + C_XOFF + C_XAL + j4 * 256 + lane * 4;
    constexpr int NT = SKEYS / 32;
    __syncthreads();
    C_LOAD(0); C_WRITE(0);
    int tcur = 0, tprev = 2;
    for (int kt = 0; kt <= NT; ++kt) {
        __syncthreads();
        if (kt + 1 < NT) C_LOAD(kt + 1);
        if (!pvw) {
            if (kt < NT) {
                const LAS unsigned char* Kl = lds + tcur * C_TILE + c16 * C_ROW + g * 16;
                f32x4 s0 = (f32x4){0.f, 0.f, 0.f, 0.f}, s1 = s0;
#pragma unroll
                for (int s = 0; s < 18; s += 2) {
                    const bf16x8 a0 = *(const LAS bf16x8*)(Kl + s * 64), a1 = *(const LAS bf16x8*)(Kl + 16 * C_ROW + s * 64);
                    const bf16x8 e0 = *(const LAS bf16x8*)(Kl + s * 64 + 64), e1 = *(const LAS bf16x8*)(Kl + 16 * C_ROW + s * 64 + 64);
                    const bf16x8 qa = __builtin_bit_cast(bf16x8, o[s]), qb = __builtin_bit_cast(bf16x8, o[s + 1]);
                    s0 = __builtin_amdgcn_mfma_f32_16x16x32_bf16(a0, qa, s0, 0, 0, 0);
                    s1 = __builtin_amdgcn_mfma_f32_16x16x32_bf16(a1, qa, s1, 0, 0, 0);
                    s0 = __builtin_amdgcn_mfma_f32_16x16x32_bf16(e0, qb, s0, 0, 0, 0);
                    s1 = __builtin_amdgcn_mfma_f32_16x16x32_bf16(e1, qb, s1, 0, 0, 0);
                    if ((s % 6) == 4) asm volatile("" ::: "memory");
                }
                float tmax = fmaxf(fmaxf(fmaxf(s0[0], s0[1]), fmaxf(s0[2], s0[3])), fmaxf(fmaxf(s1[0], s1[1]), fmaxf(s1[2], s1[3])));
                tmax = fmaxf(tmax, __shfl_xor(tmax, 16)); tmax = fmaxf(tmax, __shfl_xor(tmax, 32));
                const float mn = fmaxf(m_run, tmax), alpha = __builtin_amdgcn_exp2f((m_run - mn) * MLA_C), mc = mn * MLA_C;
                m_run = mn;
                float ls = 0.f;
#pragma unroll
                for (int j = 0; j < 4; ++j) { s0[j] = __builtin_amdgcn_exp2f(s0[j] * MLA_C - mc); s1[j] = __builtin_amdgcn_exp2f(s1[j] * MLA_C - mc); ls += s0[j] + s1[j]; }
                l_run = l_run * alpha + ls;
                const bf16x8 pb = pack8(s0[0], s0[1], s0[2], s0[3], s1[0], s1[1], s1[2], s1[3]);
                *(LAS bf16x8*)(xpb + (kt & 1) * 4096) = pb; *(LAS float*)(xal + (kt & 1) * 1024) = alpha;
            }
        } else if (kt >= 1) {
            const bf16x8 pb = *(const LAS bf16x8*)(xpb + ((kt - 1) & 1) * 4096); const float alpha = *(const LAS float*)(xal + ((kt - 1) & 1) * 1024);
            if (__any(alpha != 1.f)) {
#pragma unroll
                for (int d = 0; d < 32; ++d) o[d] *= alpha;
            }
            const unsigned va = vaddr0 + tprev * C_TILE;
            pvc8<0>(o, va, pb); pvc8<8>(o, va, pb); pvc8<16>(o, va, pb); pvc8<24>(o, va, pb);
        }
        const int tnext = (tcur == 2) ? 0 : tcur + 1;
        if (kt + 1 < NT) C_WRITE(tnext);
        tprev = tcur; tcur = tnext;
    }
#undef C_LOAD
#undef C_WRITE
    if (!pvw) { float lt = l_run; lt += __shfl_xor(lt, 16); lt += __shfl_xor(lt, 32); *(LAS float*)(xal + 1024) = 1.f / lt; }
    __syncthreads();
    if (pvw) {
        const float inv = *(const LAS float*)(xal + 1024);
        bf16_t* op = CTX + (size_t)srow * 8192 + h * 512 + 4 * g;
#pragma unroll
        for (int d = 0; d < 32; ++d) { u32x2 w; w.x = cvt_pk(o[d][0] * inv, o[d][1] * inv); w.y = cvt_pk(o[d][2] * inv, o[d][3] * inv); *(u32x2*)(op + 16 * d) = w; }
    }
}

struct Args { const float* in[30]; float* out; unsigned char* ws; int ph_lo, ph_hi; };
constexpr int NWAVES = 8, NPH_LAYER = 14, NPHASES = 1 + NLAYER * NPH_LAYER;

template <class Map>
__device__ __forceinline__ void transpose_item(const float* W, int K, int Nsrc, bf16_t* WT, int ldt, LAS float* scr, int item, int lane, const Map& map) {
    const int nblk = Nsrc / 32, kb = item / nblk, nb = item % nblk, k0 = 64 * kb, n0 = 32 * nb;
#pragma unroll 8
    for (int i = 0; i < 32; ++i) { const int kk = 2 * i + (lane >> 5); scr[kk * 33 + (lane & 31)] = W[(size_t)(k0 + kk) * Nsrc + n0 + (lane & 31)]; }
    asm volatile("s_waitcnt lgkmcnt(0)" ::: "memory");
    const int c = lane & 7;
#pragma unroll
    for (int j = 0; j < 4; ++j) { const int n = (lane >> 3) + 8 * j; const LAS float* s = scr + (8 * c) * 33 + n;
        u32x4 o; o.x = cvt_pk(s[0 * 33], s[1 * 33]); o.y = cvt_pk(s[2 * 33], s[3 * 33]); o.z = cvt_pk(s[4 * 33], s[5 * 33]); o.w = cvt_pk(s[6 * 33], s[7 * 33]);
        *(u32x4*)(WT + (size_t)map(n0 + n) * ldt + k0 + 8 * c) = o; }
    asm volatile("s_waitcnt lgkmcnt(0)" ::: "memory");
}
struct MapId { __device__ __forceinline__ int operator()(int n) const { return n; } };
struct MapIn { __device__ __forceinline__ int operator()(int c) const { return c < 1024 ? c : (c < 1088 ? 8192 + (c - 1024) : c - 64); } };
struct MapQ { __device__ __forceinline__ int operator()(int c) const { const int h = c / 192, w = c - h * 192; if (w < 128) return c; const int j = w - 128; return h * 192 + 128 + 2 * (j & 31) + (j >> 5); } };
struct MapGU { __device__ __forceinline__ int operator()(int c) const { return c < FF ? (c >> 2) * 8 + (c & 3) : ((c - FF) >> 2) * 8 + 4 + ((c - FF) & 3); } };

__device__ __forceinline__ void ln_row(const float* __restrict__ xin, const float* __restrict__ gam, const float* __restrict__ bet, float* __restrict__ xo, bf16_t* __restrict__ xb, int lane) {
    const f32x4* xr = (const f32x4*)xin + lane;
    f32x4 v[8]; float s = 0.f;
#pragma unroll
    for (int j = 0; j < 8; ++j) { v[j] = xr[64 * j]; s += (v[j][0] + v[j][1]) + (v[j][2] + v[j][3]); }
    const float mean = wave_sum(s) * (1.f / DM); float s2 = 0.f;
#pragma unroll
    for (int j = 0; j < 8; ++j) { v[j] = v[j] - mean; s2 += (v[j][0] * v[j][0] + v[j][1] * v[j][1]) + (v[j][2] * v[j][2] + v[j][3] * v[j][3]); }
    const float rstd = 1.f / sqrtf(wave_sum(s2) * (1.f / DM) + LN_EPS);
#pragma unroll
    for (int j = 0; j < 8; ++j) { const f32x4 gg = ((const f32x4*)gam)[64 * j + lane], bb = ((const f32x4*)bet)[64 * j + lane]; const f32x4 y = v[j] * rstd * gg + bb;
        if (xo) ((f32x4*)xo)[64 * j + lane] = y;
        if (xb) { u32x2 w; w.x = cvt_pk(y[0], y[1]); w.y = cvt_pk(y[2], y[3]); ((u32x2*)xb)[64 * j + lane] = w; } }
}

#define P_X     ((float*)(ws + WS_X))
#define P_Y     ((float*)(ws + WS_Y))
#define P_XB    ((bf16_t*)(ws + WS_XB))
#define P_QA    ((float*)(ws + WS_QA))
#define P_KVA   ((float*)(ws + WS_KVA))
#define P_KRRAW ((float*)(ws + WS_KRRAW))
#define P_SBQ   ((bf16_t*)(ws + WS_SBQ))
#define P_GATE  ((bf16_t*)(ws + WS_GATE))
#define P_QN    ((bf16_t*)(ws + WS_QN))
#define P_LATB  ((bf16_t*)(ws + WS_LATB))
#define P_KRB   ((bf16_t*)(ws + WS_KRB))
#define P_Q     ((bf16_t*)(ws + WS_Q))
#define P_KVX   ((bf16_t*)(ws + WS_KVX))
#define P_QLAT  ((bf16_t*)(ws + WS_QLAT))
#define P_CTX   ((bf16_t*)(ws + WS_CTX))
#define P_OA    ((bf16_t*)(ws + WS_OA))
#define P_OB    ((bf16_t*)(ws + WS_OB))
#define P_T1    ((float*)(ws + WS_T1))
#define P_MRG   ((bf16_t*)(ws + WS_MRG))
#define P_FFB   ((bf16_t*)(ws + WS_FFB))
#define P_PP    ((float*)(ws + WS_PP))
#define P_LATS  ((bf16_t*)(ws + WS_LATS))
#define P_KRS   ((bf16_t*)(ws + WS_KRS))
#define P_PB    ((bf16_t*)(ws + WS_PB))
#define P_ROPE  ((float*)(ws + WS_ROPE))
#define P_WL(off) ((const bf16_t*)(ws + WS_W + (size_t)l * W_LAYER + (off)))

#ifndef PROBE_MASK
#define PROBE_MASK 0
#endif
#define REP0 (1 + (PROBE_MASK & 1))
#define REP(j) (1 + ((PROBE_MASK >> (1 + (j))) & 1))
#ifndef PHMASK
#define PHMASK 0xffff
#endif

__global__ void __launch_bounds__(512, 2) fwd_kernel(Args args) {
    extern __shared__ __attribute__((aligned(16))) unsigned char lds_raw[];
    LAS unsigned char* lds = (LAS unsigned char*)lds_raw;
    volatile LAS unsigned* MISC = (volatile LAS unsigned*)(lds + LDS_MISC);
    const int G_k = gridDim.x, bx_k = blockIdx.x, wave_k = __builtin_amdgcn_readfirstlane(threadIdx.x >> 6);
    unsigned char* const ws_k = args.ws;
    float* const out_k = args.out;
    for (int u = threadIdx.x; u < (LDS_BYTES - LDS_MISC) / 4; u += 512) MISC[u] = 0u;
    __syncthreads();
#if !MK_PER_PHASE
    const XcdBarrier bar = xcd_barrier_post((unsigned*)(ws_k + WS_CTL) + CW_BAR, MISC + 8);
#define GRID_BAR() xcd_barrier(bar, wave_k)
#else
#define GRID_BAR() do {} while (0)
#endif
    const int lo = args.ph_lo, hi = args.ph_hi;
#define IN(k) (lo <= (k) && (k) < hi)
#define LIN(j) (((PHMASK >> (1 + (j))) & 1) && IN(P0 + (j)))
#define SEAM(k) do { if (IN(k) && IN((k) + 1)) GRID_BAR(); } while (0)
#define PHASE_PTRS() unsigned zoff_ = 0u; int G = G_k, bx = bx_k; asm volatile("" : "+s"(zoff_), "+s"(G), "+s"(bx)); unsigned char* ws = ws_k + zoff_; float* out = out_k + zoff_; (void)out; (void)G; (void)bx
#define PHASE_IDS() PHASE_PTRS(); const int tid = phase_tid(wave_k); const int lane = tid & 63, wave = wave_k, gw = bx * NWAVES + wave, NGW = G * NWAVES; (void)lane; (void)gw; (void)NGW

    if ((PHMASK & 1) && IN(0)) for (int rep = 0; rep < REP0; ++rep) {
        PHASE_IDS();
        const size_t gtid = (size_t)bx * 512 + tid, gthreads = (size_t)G * 512;
        LAS float* scr = (LAS float*)(lds + wave * 16384);
        for (int l = 0; l < NLAYER; ++l) {
            unsigned char* wl = ws + WS_W + (size_t)l * W_LAYER;
            { const float* W = args.in[10] + (size_t)l * DM * 8256; bf16_t* WT = (bf16_t*)(wl + W_IN); const int nit = (DM / 64) * (8256 / 32);
              for (int it = gw; it < nit; it += NGW) transpose_item(W, DM, 8256, WT, DM, scr, it, lane, MapIn());
              for (size_t i = gtid; i < (size_t)192 * DM / 8; i += gthreads) ((u32x4*)(WT + (size_t)8256 * DM))[i] = (u32x4){0u, 0u, 0u, 0u}; }
            { const float* W = args.in[13] + (size_t)l * 512 * 3072; bf16_t* WT = (bf16_t*)(wl + W_QB); const int nit = (512 / 64) * (3072 / 32);
              for (int it = gw; it < nit; it += NGW) transpose_item(W, 512, 3072, WT, 512, scr, it, lane, MapQ()); }
            { const float* W = args.in[15] + (size_t)l * 512 * 4096; bf16_t* WT = (bf16_t*)(wl + W_KVBT); const int nit = (512 / 64) * (4096 / 32);
              for (int it = gw; it < nit; it += NGW) transpose_item(W, 512, 4096, WT, 512, scr, it, lane, MapId());
              bf16_t* WN = (bf16_t*)(wl + W_KVBN);
              for (size_t i = gtid; i < (size_t)16 * 512 * 256 / 8; i += gthreads) { const int k8 = (int)(i & 31) * 8, c = (int)(i >> 5) & 511, hh = (int)(i >> 14);
                  f32x4 a = (f32x4){0.f, 0.f, 0.f, 0.f}, b = a;
                  if (k8 < 128) { const float* src = W + (size_t)c * 4096 + hh * 256 + k8; a = *(const f32x4*)src; b = *(const f32x4*)(src + 4); }
                  st_bf16x8(WN + 8 * i, a, b); }
              bf16_t* BD = (bf16_t*)(wl + W_UVBD);
              for (size_t i = gtid; i < (size_t)2048 * 1024 / 2; i += gthreads) { const int n = (int)(i / 512), k2 = (int)(i % 512) * 2, hh = n >> 7, v = n & 127; unsigned w = 0u;
                  if ((k2 >> 9) == (hh & 1)) { const int c = k2 & 511; w = cvt_pk(W[(size_t)c * 4096 + hh * 256 + 128 + v], W[(size_t)(c + 1) * 4096 + hh * 256 + 128 + v]); }
                  ((unsigned*)BD)[i] = w; } }
            { const float* W = args.in[16] + (size_t)l * DM * DM; bf16_t* WT = (bf16_t*)(wl + W_BA); const int nit = (DM / 64) * (DM / 32);
              for (int it = gw; it < nit; it += NGW) transpose_item(W, DM, DM, WT, DM, scr, it, lane, MapId()); }
            { const float* W = args.in[17] + (size_t)l * 1024 * DM; bf16_t* WT = (bf16_t*)(wl + W_BB); const int nit = (1024 / 64) * (DM / 32);
              for (int it = gw; it < nit; it += NGW) transpose_item(W, 1024, DM, WT, 1024, scr, it, lane, MapId()); }
            { const float* W = args.in[18] + (size_t)l * DM * DM; bf16_t* WT = (bf16_t*)(wl + W_OUT); const int nit = (DM / 64) * (DM / 32);
              for (int it = gw; it < nit; it += NGW) transpose_item(W, DM, DM, WT, DM, scr, it, lane, MapId()); }
            { const float* W = args.in[21] + (size_t)l * DM * 2 * FF; bf16_t* WT = (bf16_t*)(wl + W_GU); const int nit = (DM / 64) * (2 * FF / 32);
              for (int it = gw; it < nit; it += NGW) transpose_item(W, DM, 2 * FF, WT, DM, scr, it, lane, MapGU()); }
            { const float* W = args.in[22] + (size_t)l * FF * DM; bf16_t* WT = (bf16_t*)(wl + W_DN); const int nit = (FF / 64) * (DM / 32);
              for (int it = gw; it < nit; it += NGW) transpose_item(W, FF, DM, WT, FF, scr, it, lane, MapId()); }
            { const float* W = args.in[25] + (size_t)l * DM * DM; bf16_t* WT = (bf16_t*)(wl + W_PG); const int nit = (DM / 64) * (DM / 32);
              for (int it = gw; it < nit; it += NGW) transpose_item(W, DM, DM, WT, DM, scr, it, lane, MapId()); }
            { const float* W = args.in[27] + (size_t)l * PLE * DM; bf16_t* WT = (bf16_t*)(wl + W_PP); const int nit = (PLE / 64) * (DM / 32);
              for (int it = gw; it < nit; it += NGW) transpose_item(W, PLE, DM, WT, PLE, scr, it, lane, MapId()); }
        }
        for (size_t i = gtid; i < (size_t)SEQ * 32; i += gthreads) { float c, s; rope_cs_slow((int)(i >> 5), (int)(i & 31), c, s); P_ROPE[i] = c; P_ROPE[(size_t)SEQ * 32 + i] = s; }
        { const float* cl = args.in[2];
          for (size_t i = gtid; i < (size_t)NLAYER * NDB * PAST * 512 / 8; i += gthreads) { const size_t e = i * 8, lb_ = e / ((size_t)PAST * 512), rem = e % ((size_t)PAST * 512);
              const f32x4 a = *(const f32x4*)(cl + e), b = *(const f32x4*)(cl + e + 4); st_bf16x8(P_LATS + lb_ * (size_t)SKEYS * 512 + rem, a, b); }
          const float* ck = args.in[3];
          for (size_t i = gtid; i < (size_t)NLAYER * NDB * PAST * 32; i += gthreads) { const size_t rowi = i / 32; const int p = (int)(i % 32); const size_t lb_ = rowi / PAST, rr = rowi % PAST;
              ((unsigned*)(P_KRS + (lb_ * SKEYS + rr) * 64))[p] = cvt_pk(ck[rowi * 64 + p], ck[rowi * 64 + 32 + p]); } }
        { const float* pp = args.in[6]; const float* ps = args.in[7];
          for (size_t i = gtid; i < (size_t)NLAYER * TT * PLE / 8; i += gthreads) { const size_t e = i * 8, l = e / ((size_t)TT * PLE), rem = e % ((size_t)TT * PLE);
              const float* src = rem < (size_t)TP * PLE ? pp + l * (size_t)TP * PLE + rem : ps + l * (size_t)TS * PLE + (rem - (size_t)TP * PLE);
              st_bf16x8(P_PB + e, *(const f32x4*)src, *(const f32x4*)(src + 4)); } }
        for (int m = gw; m < TT; m += NGW) { const float* xin = m < TP ? args.in[0] + (size_t)m * DM : args.in[1] + (size_t)(m - TP) * DM;
            ln_row(xin, args.in[8], args.in[9], P_X + (size_t)m * DM, P_XB + (size_t)m * DM, lane); }
    }
    SEAM(0);

    for (int l = 0; l < NLAYER; ++l) {
        const int P0 = 1 + l * NPH_LAYER;
        if (LIN(0)) for (int rep = 0; rep < REP(0); ++rep) {
            PHASE_PTRS();
            pg8::Order S; S.init(TT, NIN, 1, G, bx);
            pg8::EpiIn E{P_QA, P_KVA, P_KRRAW, P_SBQ, P_GATE, out + O_K_P + (size_t)l * TP * 1024, out + O_K_S + (size_t)l * TS * 1024,
                         out + O_V_P + (size_t)l * TP * 1024, out + O_V_S + (size_t)l * TS * 1024, args.in[11] + (size_t)l * 4096};
            pg8::gemm_phase<pg8::Shape<DM, DM, DM>>(lds, wave_k, P_XB, P_WL(W_IN), S, E);
        }
        SEAM(P0 + 0);
        if (LIN(1)) for (int rep = 0; rep < REP(1); ++rep) {
            PHASE_IDS();
            const float* gq = args.in[12] + (size_t)l * 512; const float* gkv = args.in[14] + (size_t)l * 512;
            bf16_t* LATS_l = P_LATS + (size_t)l * NDB * SKEYS * 512; bf16_t* KRS_l = P_KRS + (size_t)l * NDB * SKEYS * 64;
            for (int m = gw; m < TT; m += NGW) {
                { const f32x4 a = ((const f32x4*)(P_QA + (size_t)m * 512))[2 * lane], b = ((const f32x4*)(P_QA + (size_t)m * 512))[2 * lane + 1];
                  const float ss = wave_sum((a[0] * a[0] + a[1] * a[1]) + (a[2] * a[2] + a[3] * a[3]) + (b[0] * b[0] + b[1] * b[1]) + (b[2] * b[2] + b[3] * b[3]));
                  const float r = 1.f / sqrtf(ss * (1.f / 512.f) + RMS_EPS); const f32x4 g0 = ((const f32x4*)gq)[2 * lane], g1 = ((const f32x4*)gq)[2 * lane + 1];
                  st_bf16x8(P_QN + (size_t)m * 512 + 8 * lane, a * r * g0, b * r * g1); }
                { const f32x4 a = ((const f32x4*)(P_KVA + (size_t)m * 512))[2 * lane], b = ((const f32x4*)(P_KVA + (size_t)m * 512))[2 * lane + 1];
                  const float ss = wave_sum((a[0] * a[0] + a[1] * a[1]) + (a[2] * a[2] + a[3] * a[3]) + (b[0] * b[0] + b[1] * b[1]) + (b[2] * b[2] + b[3] * b[3]));
                  const float r = 1.f / sqrtf(ss * (1.f / 512.f) + RMS_EPS); const f32x4 g0 = ((const f32x4*)gkv)[2 * lane], g1 = ((const f32x4*)gkv)[2 * lane + 1];
                  const f32x4 y0 = a * r * g0, y1 = b * r * g1;
                  float* od; bf16_t* ob;
                  if (m < TP) { od = out + O_LAT_P + ((size_t)l * TP + m) * 512; ob = P_LATB + (size_t)m * 512; }
                  else { const int sm = m - TP, bb = sm >> 5, qq = sm & 31; od = out + O_LAT_S + ((size_t)l * TS + sm) * 512; ob = LATS_l + ((size_t)bb * SKEYS + PAST + qq) * 512; }
                  st_f32x8(od + 8 * lane, y0, y1); st_bf16x8(ob + 8 * lane, y0, y1); }
                if (lane < 32) { const float x1 = P_KRRAW[(size_t)m * 64 + lane], x2 = P_KRRAW[(size_t)m * 64 + 32 + lane];
                  const int pos = tok_pos(m); const float c = P_ROPE[pos * 32 + lane], s = P_ROPE[SEQ * 32 + pos * 32 + lane];
                  const float y1 = x1 * c - x2 * s, y2 = x2 * c + x1 * s;
                  float* od; bf16_t* ob;
                  if (m < TP) { od = out + O_KR_P + ((size_t)l * TP + m) * 64; ob = P_KRB + (size_t)m * 64; }
                  else { const int sm = m - TP, bb = sm >> 5, qq = sm & 31; od = out + O_KR_S + ((size_t)l * TS + sm) * 64; ob = KRS_l + ((size_t)bb * SKEYS + PAST + qq) * 64; }
                  od[lane] = y1; od[32 + lane] = y2; ((unsigned*)ob)[lane] = cvt_pk(y1, y2); }
            }
        }
        SEAM(P0 + 1);
        if (LIN(2)) for (int rep = 0; rep < REP(2); ++rep) {
            PHASE_PTRS();
            { pg8::Order S; S.init(TT, 3072, 1, G, bx); pg8::EpiQ E{P_Q, P_ROPE}; pg8::gemm_phase<pg8::Shape<512, 512, 512>>(lds, wave_k, P_QN, P_WL(W_QB), S, E); }
            { pg8::Order S; S.init(TP, 4096, 1, G, bx); pg8::EpiBf16 E{P_KVX, 4096, 0}; pg8::gemm_phase<pg8::Shape<512, 512, 512>>(lds, wave_k, P_LATB, P_WL(W_KVBT), S, E); }
            { pg8::Order S; S.init(TP, DM, 1, G, bx); pg8::EpiF32 E{P_PP, DM}; pg8::gemm_phase<pg8::Shape<PLE, PLE, PLE>>(lds, wave_k, P_PB + (size_t)l * TT * PLE, P_WL(W_PP), S, E);
              pg8::gemm_small<PLE, PLE, PLE, 0>(lds, wave_k, P_PB + (size_t)l * TT * PLE, P_WL(W_PP), TP, 8, 32, G, bx, E); }
        }
        SEAM(P0 + 2);
        if (LIN(3)) for (int rep = 0; rep < REP(3); ++rep) {
            PHASE_PTRS();
            pg8::Order S; S.init(TS, 512, 16, G, bx); pg8::EpiBf16 E{P_QLAT, 8192, 512};
            pg8::gemm_phase<pg8::Shape<256, 3072, 256, 192, 512 * 256, 0>>(lds, wave_k, P_Q + (size_t)TP * 3072, P_WL(W_KVBN), S, E);
        }
        SEAM(P0 + 3);
        if (LIN(4)) for (int rep = 0; rep < REP(4); ++rep) {
            PHASE_IDS();
            volatile LAS int* qslot = (volatile LAS int*)(MISC + 16);
            unsigned* qc = (unsigned*)(ws + WS_CTL) + CW_Q + (size_t)(l * 2 + rep) * 4 * 64;
#ifndef PROBE_ATT
#define PROBE_ATT 0
#endif
#ifndef NO_C
            for (int r2 = 0; r2 < 1 + (PROBE_ATT & 1); ++r2)
            for (;;) {
                __syncthreads(); if (tid == 0) qslot[0] = (int)atomicAdd(qc + (r2 ? 3 : 0) * 64, 1u); __syncthreads();
                const int it = qslot[0]; if (it >= 128) break;
                const int b = it >> 3, rg = it & 7;
                attn_mla_sample(lds, wave_k, P_QLAT, P_Q, P_LATS + ((size_t)l * NDB + b) * SKEYS * 512, P_KRS + ((size_t)l * NDB + b) * SKEYS * 64, P_CTX, b, rg);
            }
#endif
#ifndef NO_A
            for (int r2 = 0; r2 < 1 + ((PROBE_ATT >> 1) & 1); ++r2)
            for (;;) {
                __syncthreads(); if (tid == 0) qslot[0] = (int)atomicAdd(qc + (r2 ? 3 : 1) * 64, 1u); __syncthreads();
                const int it = qslot[0]; if (it >= 512) break;
                const int qb = 15 - (it >> 5), bh = it & 31, b = bh >> 4, h = bh & 15;
                attn_mla_prompt(lds, wave_k, P_Q, P_KVX, P_KRB, P_OA, b, h, qb);
            }
#endif
#ifndef NO_B
            for (int r2 = 0; r2 < 1 + ((PROBE_ATT >> 2) & 1); ++r2)
            for (;;) {
                __syncthreads(); if (tid == 0) qslot[0] = (int)atomicAdd(qc + (r2 ? 3 : 2) * 64, 1u); __syncthreads();
                const int it = qslot[0]; if (it >= 256 + 128) break;
#ifdef DBG_ONLY_D
                if (it < 256) continue;
#endif
#ifdef DBG_ONLY_B
                if (it >= 256) continue;
#endif
                SbSrc src; size_t row0; int kt_top, nwact, qpos0, top_shift, h;
                if (it < 256) {
                    const int qb = 15 - (it >> 4), bh = it & 15, b = bh >> 3; h = bh & 7;
                    src.k_main = out + O_K_P + ((size_t)l * TP + (size_t)b * SEQ) * 1024 + h * 128; src.v_main = out + O_V_P + ((size_t)l * TP + (size_t)b * SEQ) * 1024 + h * 128;
                    src.k_new = src.k_main; src.v_new = src.v_main; src.new_tile = -1;
                    row0 = (size_t)b * SEQ + qb * 256; kt_top = 4 * qb + 3; nwact = 8; qpos0 = qb * 256; top_shift = 1;
                } else {
                    const int u = it - 256, b = u >> 3; h = u & 7;
                    src.k_main = args.in[4] + ((size_t)(l * NDB + b) * PAST) * 1024 + h * 128; src.v_main = args.in[5] + ((size_t)(l * NDB + b) * PAST) * 1024 + h * 128;
                    src.k_new = out + O_K_S + ((size_t)l * TS + (size_t)b * DSEQ) * 1024 + h * 128; src.v_new = out + O_V_S + ((size_t)l * TS + (size_t)b * DSEQ) * 1024 + h * 128; src.new_tile = 32;
                    row0 = (size_t)TP + b * DSEQ; kt_top = 32; nwact = 1; qpos0 = PAST; top_shift = 0;
                }
                attn_sb(lds, wave_k, P_SBQ + row0 * 1024 + h * 128, src, P_OB + row0 * 1024 + h * 128, kt_top, nwact, qpos0, top_shift);
            }
#endif
            __syncthreads();
        }
        SEAM(P0 + 4);
        if (LIN(5)) for (int rep = 0; rep < REP(5); ++rep) {
            PHASE_PTRS();
            { pg8::EpiBf16 E{P_OA + (size_t)TP * DM, DM, 0}; pg8::gemm_small<1024, 8192, 1024, 1024>(lds, wave_k, P_CTX, P_WL(W_UVBD), 0, 8, 32, G, bx, E); }
            { pg8::Order S; S.init(TP, DM, 1, G, bx); pg8::EpiBrB E{P_T1, P_GATE}; pg8::gemm_phase<pg8::Shape<1024, 1024, 1024>>(lds, wave_k, P_OB, P_WL(W_BB), S, E);
              pg8::gemm_small<1024, 1024, 1024, 0>(lds, wave_k, P_OB, P_WL(W_BB), TP, 8, 32, G, bx, E); }
        }
        SEAM(P0 + 5);
        if (LIN(6)) for (int rep = 0; rep < REP(6); ++rep) { PHASE_PTRS(); pg8::Order S; S.init(TP, DM, 1, G, bx); pg8::EpiBrA E{P_MRG, P_T1, P_GATE}; pg8::gemm_phase<pg8::Shape<DM, DM, DM>>(lds, wave_k, P_OA, P_WL(W_BA), S, E);
            pg8::gemm_small<DM, DM, DM, 0>(lds, wave_k, P_OA, P_WL(W_BA), TP, 8, 32, G, bx, E); }
        SEAM(P0 + 6);
        if (LIN(7)) for (int rep = 0; rep < REP(7); ++rep) { PHASE_PTRS(); pg8::Order S; S.init(TP, DM, 1, G, bx); pg8::EpiRes E{P_Y, P_X}; pg8::gemm_phase<pg8::Shape<DM, DM, DM>>(lds, wave_k, P_MRG, P_WL(W_OUT), S, E);
            pg8::gemm_small<DM, DM, DM, 0>(lds, wave_k, P_MRG, P_WL(W_OUT), TP, 8, 32, G, bx, E); }
        SEAM(P0 + 7);
        if (LIN(8)) for (int rep = 0; rep < REP(8); ++rep) { PHASE_IDS(); for (int m = gw; m < TT; m += NGW) ln_row(P_Y + (size_t)m * DM, args.in[19] + (size_t)l * DM, args.in[20] + (size_t)l * DM, P_X + (size_t)m * DM, P_XB + (size_t)m * DM, lane); }
        SEAM(P0 + 8);
        if (LIN(9)) for (int rep = 0; rep < REP(9); ++rep) { PHASE_PTRS(); pg8::Order S; S.init(TT, 2 * FF, 1, G, bx); pg8::EpiGU E{P_FFB}; pg8::gemm_phase<pg8::Shape<DM, DM, DM>>(lds, wave_k, P_XB, P_WL(W_GU), S, E); }
        SEAM(P0 + 9);
        if (LIN(10)) for (int rep = 0; rep < REP(10); ++rep) { PHASE_PTRS(); pg8::Order S; S.init(TP, DM, 1, G, bx); pg8::EpiRes E{P_Y, P_X}; pg8::gemm_phase<pg8::Shape<FF, FF, FF>>(lds, wave_k, P_FFB, P_WL(W_DN), S, E);
            pg8::gemm_small<FF, FF, FF, 0>(lds, wave_k, P_FFB, P_WL(W_DN), TP, 8, 32, G, bx, E); }
        SEAM(P0 + 10);
        if (LIN(11)) for (int rep = 0; rep < REP(11); ++rep) { PHASE_IDS(); for (int m = gw; m < TT; m += NGW) ln_row(P_Y + (size_t)m * DM, args.in[23] + (size_t)l * DM, args.in[24] + (size_t)l * DM, P_X + (size_t)m * DM, P_XB + (size_t)m * DM, lane); }
        SEAM(P0 + 11);
        if (LIN(12)) for (int rep = 0; rep < REP(12); ++rep) { PHASE_PTRS(); pg8::Order S; S.init(TP, DM, 1, G, bx); pg8::EpiPle E{P_Y, P_X, P_PP, args.in[26] + (size_t)l * DM}; pg8::gemm_phase<pg8::Shape<DM, DM, DM>>(lds, wave_k, P_XB, P_WL(W_PG), S, E);
            pg8::gemm_small<DM, DM, DM, 0>(lds, wave_k, P_XB, P_WL(W_PG), TP, 8, 32, G, bx, E); }
        SEAM(P0 + 12);
        if (LIN(13)) for (int rep = 0; rep < REP(13); ++rep) {
            PHASE_IDS();
            const float* gam = args.in[28] + (size_t)l * DM; const float* bet = args.in[29] + (size_t)l * DM;
            if (l + 1 < NLAYER) { for (int m = gw; m < TT; m += NGW) ln_row(P_Y + (size_t)m * DM, gam, bet, P_X + (size_t)m * DM, P_XB + (size_t)m * DM, lane); }
            else { for (int m = gw; m < TT; m += NGW) ln_row(P_Y + (size_t)m * DM, gam, bet, out + O_Y_P + (size_t)m * DM, nullptr, lane); }
        }
        SEAM(P0 + 13);
    }
#undef IN
#undef LIN
#undef SEAM
}

extern "C" void kernel_launch(void* const* d_in, const int* in_sizes, int n_in, void* d_out, int out_size, void* d_ws, size_t ws_size, hipStream_t stream) {
    static int grid = 0;
    if (grid == 0) {
        if (n_in != 30 || out_size != (int)O_END || ws_size < WS_END) {
            fprintf(stderr, "kernel_launch: shape mismatch n_in %d out %d ws %zu (need %zu)\n", n_in, out_size, ws_size, (size_t)WS_END); grid = -1; return; }
        int dev = 0, cus = 0, per_cu = 0;
        if (hipGetDevice(&dev) != hipSuccess || hipDeviceGetAttribute(&cus, hipDeviceAttributeMultiprocessorCount, dev) != hipSuccess) { grid = -1; return; }
        if (hipFuncSetAttribute((const void*)fwd_kernel, hipFuncAttributeMaxDynamicSharedMemorySize, LDS_BYTES) != hipSuccess) { fprintf(stderr, "kernel_launch: hipFuncSetAttribute failed\n"); grid = -1; return; }
        if (hipOccupancyMaxActiveBlocksPerMultiprocessor(&per_cu, (const void*)fwd_kernel, 512, LDS_BYTES) != hipSuccess || per_cu < 1)
            fprintf(stderr, "kernel_launch: occupancy query reports %d blocks per CU\n", per_cu);
        (void)hipGetLastError();
        grid = cus;
    }
    if (grid <= 0) return;
#ifdef DBG_ZERO_ALL
    (void)hipMemsetAsync(d_ws, 0, WS_END, stream); (void)hipMemsetAsync(d_out, 0, (size_t)O_END * 4, stream);
#else
    (void)hipMemsetAsync(d_ws, 0, CTL_BYTES, stream);
#endif
    Args a;
    memset(&a, 0, sizeof(a));
    for (int i = 0; i < 30; ++i) a.in[i] = (const float*)d_in[i];
    a.out = (float*)d_out; a.ws = (unsigned char*)d_ws;
#if MK_PER_PHASE
#ifndef DBG_PH_MAX
#define DBG_PH_MAX NPHASES
#endif
    for (int p = 0; p < DBG_PH_MAX; ++p) { a.ph_lo = p; a.ph_hi = p + 1; hipLaunchKernelGGL(fwd_kernel, dim3(grid), dim3(512), LDS_BYTES, stream, a); }
#else
    a.ph_lo = 0; a.ph_hi = NPHASES;
    hipLaunchKernelGGL(fwd_kernel, dim3(grid), dim3(512), LDS_BYTES, stream, a);
#endif
#ifdef DBG_COPY_OFF
    (void)hipMemcpyAsync(d_out, (const char*)d_ws + DBG_COPY_OFF, DBG_COPY_BYTES, hipMemcpyDeviceToDevice, stream);
#endif
    const hipError_t le = hipPeekAtLastError();
    if (le != hipSuccess) fprintf(stderr, "kernel_launch: launch failed: %s\n", hipGetErrorName(le));
}
```

```cpp
#include <hip/hip_runtime.h>
#include <cstdio>
#include <cstdint>
#include <cstring>

#ifndef MK_PER_PHASE
#define MK_PER_PHASE 0
#endif

#define LAS __attribute__((address_space(3)))
#define GAS __attribute__((address_space(1)))
typedef unsigned short bf16_t;
typedef short bf16x8 __attribute__((ext_vector_type(8)));
typedef short s16x4 __attribute__((ext_vector_type(4)));
typedef float f32x4 __attribute__((ext_vector_type(4)));
typedef float f32x16 __attribute__((ext_vector_type(16)));
typedef unsigned u32x4 __attribute__((ext_vector_type(4)));
typedef unsigned u32x2 __attribute__((ext_vector_type(2)));

constexpr int DM = 2048, TP = 8192, TS = 512, TT = 8704, SEQ = 4096, PAST = 2048, DSEQ = 32, NDB = 16, NLAYER = 2;
constexpr int NIN = 8448;
constexpr int FF = 5632, PLE = 256, SKEYS = PAST + DSEQ;
constexpr float ALPHA = 1.41421356237309515f;
constexpr float LN_EPS = 1e-5f, RMS_EPS = 1e-6f;
constexpr float LOG2E = 1.4426950408889634f, LN2 = 0.6931471805599453f;
constexpr float MLA_C = 0.07216878364870322f * LOG2E;
constexpr float SB_SCALE = 0.08838834764831845f;

constexpr size_t O_Y_P = 0, O_Y_S = 16777216, O_LAT_P = 17825792, O_KR_P = 26214400, O_K_P = 27262976, O_V_P = 44040192,
                 O_LAT_S = 60817408, O_KR_S = 61341696, O_K_S = 61407232, O_V_S = 62455808, O_END = 63504384;

constexpr size_t al256(size_t x) { return (x + 255) & ~(size_t)255; }
constexpr size_t WS_CTL = 0, CTL_BYTES = 1u << 20;
constexpr size_t W_IN = 0, W_QB = W_IN + (size_t)NIN * DM * 2, W_KVBT = W_QB + (size_t)3072 * 512 * 2, W_KVBN = W_KVBT + (size_t)4096 * 512 * 2,
                 W_UVBD = W_KVBN + (size_t)512 * 4096 * 2, W_BA = W_UVBD + (size_t)2048 * 1024 * 2, W_BB = W_BA + (size_t)DM * DM * 2,
                 W_OUT = W_BB + (size_t)DM * 1024 * 2, W_GU = W_OUT + (size_t)DM * DM * 2, W_DN = W_GU + (size_t)2 * FF * DM * 2,
                 W_PG = W_DN + (size_t)DM * FF * 2, W_PP = W_PG + (size_t)DM * DM * 2, W_LAYER = W_PP + (size_t)DM * PLE * 2;
constexpr size_t WS_W = CTL_BYTES;
constexpr size_t WS_LATS = WS_W + NLAYER * W_LAYER;
constexpr size_t WS_KRS = WS_LATS + (size_t)NLAYER * NDB * SKEYS * 512 * 2;
constexpr size_t WS_PB = WS_KRS + (size_t)NLAYER * NDB * SKEYS * 64 * 2;
constexpr size_t WS_X = WS_PB + (size_t)NLAYER * TT * PLE * 2;
constexpr size_t WS_Y = WS_X + (size_t)TT * DM * 4;
constexpr size_t WS_XB = WS_Y + (size_t)TT * DM * 4;
constexpr size_t WS_QA = WS_XB + (size_t)TT * DM * 2;
constexpr size_t WS_KVA = WS_QA + (size_t)TT * 512 * 4;
constexpr size_t WS_KRRAW = WS_KVA + (size_t)TT * 512 * 4;
constexpr size_t WS_SBQ = WS_KRRAW + (size_t)TT * 64 * 4;
constexpr size_t WS_GATE = WS_SBQ + (size_t)TT * 1024 * 2;
constexpr size_t WS_QN = WS_GATE + (size_t)TT * 4096 * 2;
constexpr size_t WS_LATB = WS_QN + (size_t)TT * 512 * 2;
constexpr size_t WS_KRB = WS_LATB + (size_t)TP * 512 * 2;
constexpr size_t WS_Q = WS_KRB + (size_t)TP * 64 * 2;
constexpr size_t WS_KVX = WS_Q + (size_t)TT * 3072 * 2 + 4096;
constexpr size_t WS_QLAT = WS_KVX + (size_t)TP * 4096 * 2;
constexpr size_t WS_CTX = WS_QLAT + (size_t)TS * 8192 * 2;
constexpr size_t WS_OA = WS_CTX + (size_t)TS * 8192 * 2;
constexpr size_t WS_OB = WS_OA + (size_t)TT * DM * 2;
constexpr size_t WS_T1 = WS_OB + (size_t)TT * 1024 * 2;
constexpr size_t WS_MRG = WS_T1 + (size_t)TT * DM * 4;
constexpr size_t WS_FFB = WS_MRG + (size_t)TT * DM * 2;
constexpr size_t WS_PP = WS_FFB + (size_t)TT * FF * 2;
constexpr size_t WS_ROPE = WS_PP + (size_t)TT * DM * 4;
constexpr size_t WS_END = WS_ROPE + (size_t)2 * SEQ * 32 * 4;

constexpr int CW_BAR = 4096, CW_Q = 16384;

constexpr int LDS_STAGE = 131072, LDS_MISC = LDS_STAGE, LDS_BYTES = 147456;

typedef __bf16 bf16x2_t __attribute__((ext_vector_type(2)));
typedef float f32x2_t __attribute__((ext_vector_type(2)));
__device__ __forceinline__ unsigned cvt_pk(float lo, float hi) { const f32x2_t v = {lo, hi}; const bf16x2_t b = __builtin_convertvector(v, bf16x2_t); return __builtin_bit_cast(unsigned, b); }
__device__ __forceinline__ float bflo(unsigned w) { return __uint_as_float(w << 16); }
__device__ __forceinline__ float bfhi(unsigned w) { return __uint_as_float(w & 0xffff0000u); }
__device__ __forceinline__ void st_bf16x8(bf16_t* p, f32x4 a, f32x4 b) { u32x4 w; w.x = cvt_pk(a[0], a[1]); w.y = cvt_pk(a[2], a[3]); w.z = cvt_pk(b[0], b[1]); w.w = cvt_pk(b[2], b[3]); *(u32x4*)p = w; }
__device__ __forceinline__ void st_f32x8(float* p, f32x4 a, f32x4 b) { *(f32x4*)p = a; *(f32x4*)(p + 4) = b; }
__device__ __forceinline__ void ld_bf16x8(const bf16_t* p, f32x4& a, f32x4& b) { const u32x4 w = *(const u32x4*)p; a = (f32x4){bflo(w.x), bfhi(w.x), bflo(w.y), bfhi(w.y)}; b = (f32x4){bflo(w.z), bfhi(w.z), bflo(w.w), bfhi(w.w)}; }
__device__ __forceinline__ float sigmoidf_(float x) { return __builtin_amdgcn_rcpf(1.f + __builtin_amdgcn_exp2f(-x * LOG2E)); }
__device__ __forceinline__ float wave_sum(float v) {
#pragma unroll
    for (int o = 1; o < 64; o <<= 1) v += __shfl_xor(v, o);
    return v;
}
__device__ __forceinline__ int tok_pos(int row) { return row < TP ? (row & (SEQ - 1)) : PAST + ((row - TP) & (DSEQ - 1)); }
__device__ __forceinline__ void rope_cs_slow(int pos, int i, float& c, float& s) {
    const float invf = __builtin_amdgcn_exp2f(-(float)i * 0.41524101186092029f);
    const float ang = (float)pos * invf;
    double a = (double)ang * 0.15915494309189535; a -= __builtin_floor(a);
    const float f = (float)a;
    c = __builtin_amdgcn_cosf(f); s = __builtin_amdgcn_sinf(f);
}

__device__ __forceinline__ int phase_tid(int wave_k) { int ln; asm volatile("v_mbcnt_lo_u32_b32 %0, -1, 0\n\tv_mbcnt_hi_u32_b32 %0, -1, %0" : "=v"(ln)); return (wave_k << 6) | ln; }
#define XB_TMO      128
#define XB_XCNT(j)  (256  + 64 * (j))
#define XB_XSUB(j)  (1280 + 64 * (j))
#define XB_XGEN(j)  (2304 + 64 * (j))
#define XB_TOP      3328
#define XB_TOPGEN   3392
#define XCD_BAR_WORDS 3456
#define XB_SPIN_CAP (1u << 22)
__device__ __forceinline__ unsigned xb_ld(unsigned* p)              { return __hip_atomic_load(p, __ATOMIC_RELAXED, __HIP_MEMORY_SCOPE_AGENT); }
__device__ __forceinline__ unsigned xb_add(unsigned* p, unsigned v) { return __hip_atomic_fetch_add(p, v, __ATOMIC_RELAXED, __HIP_MEMORY_SCOPE_AGENT); }
__device__ __forceinline__ unsigned xb_xcc_id() { return (unsigned)__builtin_amdgcn_s_getreg((3 << 11) | 20) & 0xFu; }
#define XB_SPIN(cond, bar) do { unsigned _sp = 0; while (cond) { __builtin_amdgcn_s_sleep(1); \
    if ((++_sp & 255u) == 0u) { if (xb_ld(&(bar)[XB_TMO])) break; if (_sp > XB_SPIN_CAP) { atomicAdd(&(bar)[XB_TMO], 1u); break; } } } } while (0)
struct XcdBarrier { unsigned* bar; unsigned x; volatile LAS unsigned* st; };
__device__ __forceinline__ XcdBarrier xcd_barrier_post(unsigned* bar, volatile LAS unsigned* st) {
    XcdBarrier b; b.bar = bar; b.x = xb_xcc_id(); b.st = st;
    if (threadIdx.x == 0) (void)xb_add(&bar[XB_XCNT(b.x)], 1u);
    return b;
}
__device__ __forceinline__ void xcd_barrier_complete(unsigned* bar, unsigned x, unsigned& nloc, unsigned& nx) {
    const unsigned G = gridDim.x * gridDim.y * gridDim.z;
    unsigned sum, cnt, mine, sp = 0u;
    for (;;) {
        sum = 0u; cnt = 0u; mine = 0u;
#pragma unroll
        for (unsigned j = 0; j < 16; ++j) { const unsigned c = xb_ld(&bar[XB_XCNT(j)]); sum += c; cnt += (c > 0u) ? 1u : 0u; mine = (j == x) ? c : mine; }
        if (sum == G) break;
        __builtin_amdgcn_s_sleep(1);
        if ((++sp & 255u) == 0u) { if (xb_ld(&bar[XB_TMO])) break; if (sp > XB_SPIN_CAP) { atomicAdd(&bar[XB_TMO], 1u); break; } }
    }
    nloc = mine > 0u ? mine : 1u; nx = cnt > 0u ? cnt : 1u;
}
__device__ __forceinline__ void xcd_barrier(const XcdBarrier& b, int wave_k) {
    asm volatile("s_waitcnt vmcnt(0)" ::: "memory");
    __syncthreads();
    if (phase_tid(wave_k) == 0) {
        unsigned* bar = b.bar;
        __builtin_amdgcn_s_waitcnt(0);
        unsigned nloc = b.st[0], nx = b.st[1];
        if (nloc == 0u) { xcd_barrier_complete(bar, b.x, nloc, nx); b.st[0] = nloc; b.st[1] = nx; }
        const unsigned old = xb_add(&bar[XB_XSUB(b.x)], 1u);
        const unsigned gen = old / nloc;
        if (old + 1u == (gen + 1u) * nloc) {
            __builtin_amdgcn_fence(__ATOMIC_RELEASE, "agent");
            asm volatile("s_waitcnt vmcnt(0)" ::: "memory");
            const unsigned og = xb_add(&bar[XB_TOP], 1u);
            const unsigned tg = og / nx;
            if (og + 1u == (tg + 1u) * nx) xb_add(&bar[XB_TOPGEN], 1u);
            else XB_SPIN(xb_ld(&bar[XB_TOPGEN]) == tg, bar);
            __builtin_amdgcn_fence(__ATOMIC_ACQUIRE, "agent");
            xb_add(&bar[XB_XGEN(b.x)], 1u);
            asm volatile("s_waitcnt vmcnt(0)" ::: "memory");
        } else {
            XB_SPIN(xb_ld(&bar[XB_XGEN(b.x)]) == gen, bar);
            __builtin_amdgcn_fence(__ATOMIC_ACQUIRE, "agent");
            asm volatile("s_waitcnt vmcnt(0)" ::: "memory");
        }
    }
    __syncthreads();
}

namespace pg8 {
constexpr int BM = 256, BK = 64, HALF = 128, HTB = HALF * BK * 2, NXCD = 8, WGM = 8;
__host__ __device__ __forceinline__ int lds_byte(int r, int c) { const int st = (r >> 4) * 2 + (c >> 5), rr = r & 15, cc = c & 31, ob = rr * 64 + cc * 2; return st * 1024 + (ob ^ (((ob >> 9) & 1) << 5)); }
__host__ __device__ __forceinline__ void stage_rc(int b, int& R, int& C) { const int st = b / 1024, sb = b % 1024, swz = sb ^ (((sb >> 9) & 1) << 5); R = (st >> 1) * 16 + swz / 64; C = (st & 1) * 32 + (swz % 64) / 2; }
__host__ __device__ __forceinline__ int perm32(int rho) { const int n = rho >> 4, i = rho & 15; return 8 * (i >> 2) + 4 * n + (i & 3); }

struct Unit { int pm, pn, z; };
template <int K_, int LDA_, int LDB_, int SAZ_ = 0, int SBZ_ = 0, int APN_ = 0> struct Shape { static constexpr int K = K_, lda = LDA_, ldb = LDB_, sAz = SAZ_, sBz = SBZ_, a_pn = APN_; };

struct Order {
    int nM, nN, per, total, G, c, mode;
    __device__ void init(int M, int N, int nz, int G_, int c_, int mode_ = 0) { nM = M / BM; nN = N / BM; per = nM * nN; total = per * nz; G = G_; c = c_; mode = mode_; }
    __device__ bool next(int i, Unit& u) const {
        const long L = (long)i * G + c; if (L >= total) return false;
        const int z = (int)(L / per); int wgid = (int)(L % per);
        { const int q = per / NXCD, r = per % NXCD, xcd = wgid % NXCD, off = wgid / NXCD; wgid = (xcd < r ? xcd * (q + 1) : r * (q + 1) + (xcd - r) * q) + off; }
        const int nig = WGM * nN, gid = wgid / nig, fm = gid * WGM, gsz = (nM - fm) < WGM ? (nM - fm) : WGM;
        u.pm = fm + ((wgid % nig) % gsz); int pn = (wgid % nig) / gsz;
        if (mode == 1) pn = pn < 4 ? pn : (pn == 4 ? 32 : pn - 1); else if (mode == 2) pn += 29;
        u.pn = pn; u.z = z; return true;
    }
};

#define EPI_LOOP(...) \
    _Pragma("unroll") for (int ai = 0; ai < 2; ++ai) _Pragma("unroll") for (int m = 0; m < 4; ++m) { const int row = u.pm * 256 + ai * 128 + wr * 64 + m * 16 + fr; \
    _Pragma("unroll") for (int bj = 0; bj < 2; ++bj) { const int col = u.pn * 256 + bj * 128 + wc * 32 + fq * 8; f32x4 v0 = acc[ai][bj][m][0], v1 = acc[ai][bj][m][1]; __VA_ARGS__ } asm volatile("" ::: "memory"); }

template <class g, class Epi>
__device__ __forceinline__ void gemm_phase(LAS unsigned char* lds, int wave_k, const bf16_t* gA, const bf16_t* gBt, const Order& S, const Epi& E) {
    const int tid = phase_tid(wave_k);
    const int wid = __builtin_amdgcn_readfirstlane(tid >> 6), lane = tid & 63, wr = wid >> 2, wc = wid & 3, fr = lane & 15, fq = lane >> 4;
    constexpr int K = g::K, nt = K / BK;
    unsigned voffA[2], voffB[2];
#pragma unroll
    for (int i = 0; i < 2; ++i) { int R, C; stage_rc(tid * 16 + i * 8192, R, C); const int Rb = (R & ~31) + perm32(R & 31);
        voffA[i] = (unsigned)(R * g::lda + C) * 2u; voffB[i] = (unsigned)(Rb * g::ldb + C) * 2u; }
    const size_t kstep = (size_t)(BK * 2);
    constexpr size_t hstepA = (size_t)HALF * g::lda * 2, hstepB = (size_t)HALF * g::ldb * 2;
    constexpr size_t tstepA = 2 * hstepA, tstepB = 2 * hstepB;
    const unsigned ldsw = (unsigned)wid * 1024u;
    const int aoff = lds_byte(wr * 64 + fr, fq * 8), boff = lds_byte(wc * 32 + fr, fq * 8);
#define PG8_UA(u_) ((const char*)gA + ((size_t)(u_).z * g::sAz + (size_t)(u_).pn * (size_t)g::a_pn) * 2 + (size_t)(u_).pm * tstepA)
#define PG8_UB(u_) ((const char*)gBt + (size_t)(u_).z * g::sBz * 2 + (size_t)(u_).pn * tstepB)
#define PG8_SA(b, h) (((b) * 2 + (h)) * HTB)
#define PG8_SB(b, h) ((4 + (b) * 2 + (h)) * HTB)
#define PG8_STAGE(bufoff, gbase, voff) do { _Pragma("unroll") for (int _i = 0; _i < 2; ++_i) \
        __builtin_amdgcn_global_load_lds((const unsigned*)((const char*)(gbase) + (voff)[_i]), (LAS unsigned*)(lds + (bufoff) + ldsw + _i * 8192), 16, 0, 0); } while (0)
#define PG8_LDA(dst, b, h) do { _Pragma("unroll") for (int m = 0; m < 4; ++m) _Pragma("unroll") for (int k = 0; k < 2; ++k) dst[m][k] = *(const LAS bf16x8*)(lds + PG8_SA(b, h) + aoff + m * 2048 + k * 1024); } while (0)
#define PG8_LDB(dst, b, h) do { _Pragma("unroll") for (int n = 0; n < 2; ++n) _Pragma("unroll") for (int k = 0; k < 2; ++k) dst[n][k] = *(const LAS bf16x8*)(lds + PG8_SB(b, h) + boff + n * 2048 + k * 1024); } while (0)
#define PG8_MMA(ai, bj, At, Bt) do { __builtin_amdgcn_s_setprio(1); _Pragma("unroll") for (int m = 0; m < 4; ++m) _Pragma("unroll") for (int n = 0; n < 2; ++n) _Pragma("unroll") for (int k = 0; k < 2; ++k) \
        acc[ai][bj][m][n] = __builtin_amdgcn_mfma_f32_16x16x32_bf16(Bt[n][k], At[m][k], acc[ai][bj][m][n], 0, 0, 0); __builtin_amdgcn_s_setprio(0); } while (0)
#define PG8_WAIT_V(n) asm volatile("s_waitcnt vmcnt(" #n ")" ::: "memory")
#define PG8_WAIT_L(n) asm volatile("s_waitcnt lgkmcnt(" #n ")" ::: "memory")
#define PG8_BAR __builtin_amdgcn_s_barrier()
#define PG8_SCHED __builtin_amdgcn_sched_barrier(0)
    Unit cur, nxt; int ui = 0;
    if (!S.next(0, cur)) return;
    f32x4 acc[2][2][4][2];
#pragma unroll
    for (int a = 0; a < 2; ++a)
#pragma unroll
        for (int b = 0; b < 2; ++b)
#pragma unroll
            for (int m = 0; m < 4; ++m)
#pragma unroll
                for (int n = 0; n < 2; ++n) acc[a][b][m][n] = (f32x4){0.f, 0.f, 0.f, 0.f};
    bf16x8 At[4][2], B0[2][2], B1[2][2];
    const char* cA = PG8_UA(cur); const char* cB = PG8_UB(cur);
    PG8_STAGE(PG8_SB(0, 0), cB, voffB); PG8_STAGE(PG8_SB(0, 1), cB + hstepB, voffB); PG8_STAGE(PG8_SA(0, 0), cA, voffA); PG8_STAGE(PG8_SA(0, 1), cA + hstepA, voffA);
    if (wr == 1) PG8_BAR;
    PG8_WAIT_V(2); PG8_BAR;
    PG8_STAGE(PG8_SB(1, 0), cB + kstep, voffB); PG8_STAGE(PG8_SA(1, 0), cA + kstep, voffA); PG8_STAGE(PG8_SB(1, 1), cB + hstepB + kstep, voffB);
    PG8_WAIT_V(6); PG8_BAR;
    for (;;) {
        const bool has_next = S.next(ui + 1, nxt);
        const char* nA = has_next ? PG8_UA(nxt) : cA; const char* nB = has_next ? PG8_UB(nxt) : cB;
#pragma unroll 1
        for (int t = 0; t < nt; t += 2) {
            const bool last = (t == nt - 2);
            const char* a1 = cA + (size_t)(t + 1) * kstep;
            const char* a2 = last ? nA : cA + (size_t)(t + 2) * kstep; const char* b2 = last ? nB : cB + (size_t)(t + 2) * kstep;
            const char* a3 = a2 + kstep; const char* b3 = b2 + kstep;
            PG8_LDB(B0, 0, 0); PG8_LDB(B1, 0, 1); PG8_SCHED; PG8_LDA(At, 0, 0); PG8_STAGE(PG8_SA(1, 1), a1 + hstepA, voffA);
            PG8_WAIT_V(8); PG8_WAIT_L(0); PG8_BAR; PG8_MMA(0, 0, At, B0); PG8_MMA(0, 1, At, B1); PG8_BAR; PG8_SCHED;
            PG8_LDA(At, 0, 1); PG8_STAGE(PG8_SB(0, 0), b2, voffB); PG8_STAGE(PG8_SB(0, 1), b2 + hstepB, voffB); PG8_STAGE(PG8_SA(0, 0), a2, voffA);
            PG8_WAIT_V(8); PG8_WAIT_L(0); PG8_BAR; PG8_MMA(1, 0, At, B0); PG8_MMA(1, 1, At, B1); PG8_BAR; PG8_SCHED;
            PG8_LDB(B0, 1, 0); PG8_LDB(B1, 1, 1); PG8_SCHED; PG8_LDA(At, 1, 0); PG8_STAGE(PG8_SA(0, 1), a2 + hstepA, voffA);
            PG8_WAIT_V(8); PG8_WAIT_L(0); PG8_BAR; PG8_MMA(0, 0, At, B0); PG8_MMA(0, 1, At, B1); PG8_BAR; PG8_SCHED;
            PG8_LDA(At, 1, 1); PG8_STAGE(PG8_SB(1, 0), b3, voffB); PG8_STAGE(PG8_SB(1, 1), b3 + hstepB, voffB); PG8_STAGE(PG8_SA(1, 0), a3, voffA);
            PG8_WAIT_V(8); PG8_WAIT_L(0); PG8_BAR; PG8_MMA(1, 0, At, B0); PG8_MMA(1, 1, At, B1); PG8_BAR; PG8_SCHED;
        }
        if (wr == 0) PG8_BAR;
        { const Unit& u = cur; EPI_LOOP( E.apply(row, col, u.z, v0, v1); ) }
        if (!has_next) break;
#pragma unroll
        for (int a = 0; a < 2; ++a)
#pragma unroll
            for (int b = 0; b < 2; ++b)
#pragma unroll
                for (int m = 0; m < 4; ++m)
#pragma unroll
                    for (int n = 0; n < 2; ++n) acc[a][b][m][n] = (f32x4){0.f, 0.f, 0.f, 0.f};
        cur = nxt; cA = nA; cB = nB; ++ui;
        if (wr == 1) PG8_BAR;
    }
    PG8_WAIT_V(0);
    PG8_BAR;
#undef PG8_UA
#undef PG8_UB
#undef PG8_SA
#undef PG8_SB
#undef PG8_STAGE
#undef PG8_LDA
#undef PG8_LDB
#undef PG8_MMA
#undef PG8_WAIT_V
#undef PG8_WAIT_L
#undef PG8_BAR
#undef PG8_SCHED
}

struct EpiIn {
    float* QA; float* KVA; float* KRRAW; bf16_t* SBQ; bf16_t* GATE; float* k_p; float* k_s; float* v_p; float* v_s; const float* bgate;
    __device__ __forceinline__ void apply(int row, int col, int z, f32x4 v0, f32x4 v1) const {
        const int pn = col >> 8;
        if (pn < 2) st_f32x8(QA + (unsigned)(row * 512 + col), v0, v1);
        else if (pn < 4) st_f32x8(KVA + (unsigned)(row * 512 + col - 512), v0, v1);
        else if (pn < 8) st_bf16x8(SBQ + (unsigned)(row * 1024 + col - 1024), v0, v1);
        else if (pn < 12) { float* d = row < TP ? k_p : k_s - (size_t)TP * 1024; st_f32x8(d + (unsigned)(row * 1024 + col - 2048), v0, v1); }
        else if (pn < 16) { float* d = row < TP ? v_p : v_s - (size_t)TP * 1024; st_f32x8(d + (unsigned)(row * 1024 + col - 3072), v0, v1); }
        else if (pn < 32) { const unsigned c = (unsigned)(col - 4096); const f32x4 b0 = *(const f32x4*)(bgate + c), b1 = *(const f32x4*)(bgate + c + 4); f32x4 g0, g1;
#pragma unroll
            for (int j = 0; j < 4; ++j) { g0[j] = sigmoidf_(v0[j] + b0[j]); g1[j] = sigmoidf_(v1[j] + b1[j]); }
            st_bf16x8(GATE + ((unsigned)(row * 4096) + c), g0, g1); }
        else { const int c = col - 8192; if (c < 64) st_f32x8(KRRAW + (unsigned)(row * 64 + c), v0, v1); }
    }
};
struct EpiQ {
    bf16_t* Q; const float* ROPE;
    __device__ __forceinline__ void apply(int row, int col, int z, f32x4 v0, f32x4 v1) const {
        const int h = col / 192, w = col - h * 192;
        if (w >= 128) { const int pos = tok_pos(row), i0 = (w - 128) >> 1; const f32x4 c = *(const f32x4*)(ROPE + pos * 32 + i0), s = *(const f32x4*)(ROPE + SEQ * 32 + pos * 32 + i0);
            { const float a = v0[0], b = v0[1]; v0[0] = a * c[0] - b * s[0]; v0[1] = b * c[0] + a * s[0]; }
            { const float a = v0[2], b = v0[3]; v0[2] = a * c[1] - b * s[1]; v0[3] = b * c[1] + a * s[1]; }
            { const float a = v1[0], b = v1[1]; v1[0] = a * c[2] - b * s[2]; v1[1] = b * c[2] + a * s[2]; }
            { const float a = v1[2], b = v1[3]; v1[2] = a * c[3] - b * s[3]; v1[3] = b * c[3] + a * s[3]; } }
        st_bf16x8(Q + (unsigned)(row * 3072 + col), v0, v1);
    }
};
struct EpiBf16 {
    bf16_t* O; int ldc; int zoff;
    __device__ __forceinline__ void apply(int row, int col, int z, f32x4 v0, f32x4 v1) const { st_bf16x8(O + (unsigned)(row * ldc + z * zoff + col), v0, v1); }
};
struct EpiF32 {
    float* O; int ldc;
    __device__ __forceinline__ void apply(int row, int col, int z, f32x4 v0, f32x4 v1) const { st_f32x8(O + (unsigned)(row * ldc + col), v0, v1); }
};
struct EpiBrB {
    float* T1; const bf16_t* GATE;
    __device__ __forceinline__ void apply(int row, int col, int z, f32x4 v0, f32x4 v1) const {
        f32x4 g0, g1; ld_bf16x8(GATE + (unsigned)(row * 4096 + 2048 + col), g0, g1); st_f32x8(T1 + (unsigned)(row * DM + col), v0 * g0, v1 * g1); }
};
struct EpiBrA {
    bf16_t* MRG; const float* T1; const bf16_t* GATE;
    __device__ __forceinline__ void apply(int row, int col, int z, f32x4 v0, f32x4 v1) const {
        f32x4 g0, g1; ld_bf16x8(GATE + (unsigned)(row * 4096 + col), g0, g1); const float* t = T1 + (unsigned)(row * DM + col);
        const f32x4 t0 = *(const f32x4*)t, t1 = *(const f32x4*)(t + 4); st_bf16x8(MRG + (unsigned)(row * DM + col), t0 + v0 * g0, t1 + v1 * g1); }
};
struct EpiRes {
    float* Y; const float* X;
    __device__ __forceinline__ void apply(int row, int col, int z, f32x4 v0, f32x4 v1) const {
        const float* x = X + (unsigned)(row * DM + col); const f32x4 x0 = *(const f32x4*)x, x1 = *(const f32x4*)(x + 4);
        st_f32x8(Y + (unsigned)(row * DM + col), x0 * ALPHA + v0, x1 * ALPHA + v1); }
};
struct EpiGU {
    bf16_t* FFB;
    __device__ __forceinline__ void apply(int row, int col, int z, f32x4 v0, f32x4 v1) const {
        f32x4 r;
#pragma unroll
        for (int j = 0; j < 4; ++j) r[j] = v0[j] * sigmoidf_(v0[j]) * v1[j];
        u32x2 w; w.x = cvt_pk(r[0], r[1]); w.y = cvt_pk(r[2], r[3]); *(u32x2*)(FFB + (unsigned)(row * FF + (col >> 1))) = w; }
};
struct EpiPle {
    float* Y; const float* X; const float* PP; const float* bias;
    __device__ __forceinline__ void apply(int row, int col, int z, f32x4 v0, f32x4 v1) const {
        const unsigned o = (unsigned)(row * DM + col); const f32x4 x0 = *(const f32x4*)(X + o), x1 = *(const f32x4*)(X + o + 4), p0 = *(const f32x4*)(PP + o), p1 = *(const f32x4*)(PP + o + 4);
        const f32x4 b0 = *(const f32x4*)(bias + (unsigned)col), b1 = *(const f32x4*)(bias + (unsigned)col + 4); f32x4 r0, r1;
#pragma unroll
        for (int j = 0; j < 4; ++j) { r0[j] = x0[j] * ALPHA + sigmoidf_(v0[j] + b0[j]) * p0[j]; r1[j] = x1[j] * ALPHA + sigmoidf_(v1[j] + b1[j]) * p1[j]; }
        st_f32x8(Y + o, r0, r1); }
};

template <int K, int LDA, int LDB, int APN, class Epi>
__device__ __forceinline__ void gemm_small(LAS unsigned char* lds, int wave_k, const bf16_t* gA, const bf16_t* gBt, int row0, int n_rt, int n_ct, int G, int c, const Epi& E) {
    const int tid = phase_tid(wave_k);
    const int wid = __builtin_amdgcn_readfirstlane(tid >> 6), lane = tid & 63, wc = wid & 1, wm = wid >> 1, fr = lane & 15, fq = lane >> 4;
    constexpr int nt = K / 64;
    int R, C; stage_rc(tid * 16, R, C);
    const int Rb = (R & ~31) + perm32(R & 31);
    const unsigned voffA = (unsigned)(R * LDA + C) * 2u, voffB = (unsigned)(Rb * LDB + C) * 2u;
    const unsigned ldsw = (unsigned)wid * 1024u;
    const int aoff = lds_byte(wm * 16 + fr, fq * 8), boff = lds_byte(wc * 32 + fr, fq * 8);
#define SM_STAGE(slot, pa, pb) do { \
        __builtin_amdgcn_global_load_lds((const unsigned*)((pa) + voffA), (LAS unsigned*)(lds + (slot) * 16384 + ldsw), 16, 0, 0); \
        __builtin_amdgcn_global_load_lds((const unsigned*)((pb) + voffB), (LAS unsigned*)(lds + (slot) * 16384 + 8192 + ldsw), 16, 0, 0); } while (0)
    for (int u = c; u < n_rt * n_ct; u += G) {
        const int xcd = u & 7, idx = u >> 3, rt = idx % n_rt, ct = xcd * (n_ct >> 3) + idx / n_rt;
        const char* pa = (const char*)gA + ((size_t)(row0 + rt * 64) * LDA + (size_t)(ct >> 2) * APN) * 2;
        const char* pb = (const char*)gBt + (size_t)(ct * 64) * LDB * 2;
        f32x4 acc0 = (f32x4){0.f, 0.f, 0.f, 0.f}, acc1 = acc0;
        SM_STAGE(0, pa, pb); SM_STAGE(1, pa + 128, pb + 128); SM_STAGE(2, pa + 256, pb + 256);
#pragma unroll 1
        for (int t = 0; t < nt; ++t) {
            asm volatile("s_waitcnt vmcnt(4)" ::: "memory");
            __builtin_amdgcn_s_barrier();
            { const int tn = (t + 3 < nt) ? t + 3 : nt - 1;
              SM_STAGE((t + 3) & 3, pa + (size_t)tn * 128, pb + (size_t)tn * 128); }
            const LAS unsigned char* sl = lds + (t & 3) * 16384;
            const bf16x8 a0 = *(const LAS bf16x8*)(sl + aoff), a1 = *(const LAS bf16x8*)(sl + aoff + 1024);
            const bf16x8 b00 = *(const LAS bf16x8*)(sl + 8192 + boff), b01 = *(const LAS bf16x8*)(sl + 8192 + boff + 1024);
            const bf16x8 b10 = *(const LAS bf16x8*)(sl + 8192 + boff + 2048), b11 = *(const LAS bf16x8*)(sl + 8192 + boff + 2048 + 1024);
            acc0 = __builtin_amdgcn_mfma_f32_16x16x32_bf16(b00, a0, acc0, 0, 0, 0); acc1 = __builtin_amdgcn_mfma_f32_16x16x32_bf16(b10, a0, acc1, 0, 0, 0);
            acc0 = __builtin_amdgcn_mfma_f32_16x16x32_bf16(b01, a1, acc0, 0, 0, 0); acc1 = __builtin_amdgcn_mfma_f32_16x16x32_bf16(b11, a1, acc1, 0, 0, 0);
        }
        asm volatile("s_waitcnt vmcnt(0)" ::: "memory");
        __builtin_amdgcn_s_barrier();
        E.apply(row0 + rt * 64 + wm * 16 + fr, ct * 64 + wc * 32 + fq * 8, 0, acc0, acc1);
    }
#undef SM_STAGE
}
}

template <int OFF> __device__ __forceinline__ s16x4 tr_read(unsigned addr) {
    s16x4 r; asm volatile("ds_read_b64_tr_b16 %0, %1 offset:%2" : "=&v"(r) : "v"(addr), "i"(OFF) : "memory"); return r;
}
#define PKTR(L, H) ((bf16x8){L[0], L[1], L[2], L[3], H[0], H[1], H[2], H[3]})
__device__ __forceinline__ bf16x8 pack8(float a0, float a1, float a2, float a3, float a4, float a5, float a6, float a7) {
    u32x4 w; w.x = cvt_pk(a0, a1); w.y = cvt_pk(a2, a3); w.z = cvt_pk(a4, a5); w.w = cvt_pk(a6, a7); return __builtin_bit_cast(bf16x8, w);
}
constexpr int AV_ROW = 320;
template <int DBLK> __device__ __forceinline__ void pv_block(f32x16& od, unsigned vaddr, const bf16x8 (&pb)[4]) {
    const s16x4 l0 = tr_read<(0 * 16 + 0) * AV_ROW + DBLK * 64>(vaddr), h0 = tr_read<(0 * 16 + 8) * AV_ROW + DBLK * 64>(vaddr);
    const s16x4 l1 = tr_read<(1 * 16 + 0) * AV_ROW + DBLK * 64>(vaddr), h1 = tr_read<(1 * 16 + 8) * AV_ROW + DBLK * 64>(vaddr);
    const s16x4 l2 = tr_read<(2 * 16 + 0) * AV_ROW + DBLK * 64>(vaddr), h2 = tr_read<(2 * 16 + 8) * AV_ROW + DBLK * 64>(vaddr);
    const s16x4 l3 = tr_read<(3 * 16 + 0) * AV_ROW + DBLK * 64>(vaddr), h3 = tr_read<(3 * 16 + 8) * AV_ROW + DBLK * 64>(vaddr);
    asm volatile("s_waitcnt lgkmcnt(0)" ::: "memory"); __builtin_amdgcn_sched_barrier(0);
    od = __builtin_amdgcn_mfma_f32_32x32x16_bf16(PKTR(l0, h0), pb[0], od, 0, 0, 0);
    od = __builtin_amdgcn_mfma_f32_32x32x16_bf16(PKTR(l1, h1), pb[1], od, 0, 0, 0);
    od = __builtin_amdgcn_mfma_f32_32x32x16_bf16(PKTR(l2, h2), pb[2], od, 0, 0, 0);
    od = __builtin_amdgcn_mfma_f32_32x32x16_bf16(PKTR(l3, h3), pb[3], od, 0, 0, 0);
}

constexpr int AK_ROW = 400, AK_TILE = 64 * AK_ROW, AV_TILE = 64 * AV_ROW;
__device__ __forceinline__ void attn_mla_prompt(LAS unsigned char* lds, int wave_k, const bf16_t* __restrict__ Q, const bf16_t* __restrict__ KVX, const bf16_t* __restrict__ KRB,
                                                bf16_t* __restrict__ OA, int b, int h, int qb) {
    const int tid = phase_tid(wave_k);
    const int wid = __builtin_amdgcn_readfirstlane(tid >> 6), lane = tid & 63, r32 = lane & 31, hi = lane >> 5;
    const int NT = 4 * qb + 4, my_last = 4 * qb + (wid >> 1);
    const int tok = b * SEQ + qb * 256 + wid * 32 + r32;
    bf16x8 qr[12];
    { const bf16_t* qp = Q + (size_t)tok * 3072 + h * 192 + hi * 8;
#pragma unroll
      for (int s = 0; s < 12; ++s) qr[s] = *(const bf16x8*)(qp + 16 * s); }
    f32x16 o[4];
#pragma unroll
    for (int d = 0; d < 4; ++d)
#pragma unroll
        for (int r = 0; r < 16; ++r) o[d][r] = 0.f;
    float m_run = -INFINITY, l_run = 0.f;
    const bf16_t* kbase = KVX + (size_t)(b * SEQ) * 4096 + h * 256;
    const bf16_t* rbase = KRB + (size_t)(b * SEQ) * 64;
    const int r0 = tid >> 4, c0 = tid & 15, rr = tid >> 3, rc = tid & 7;
    u32x4 sk0, sk1, sr, sv0, sv1;
#define A_LOAD(kt) do { const bf16_t* kp = kbase + (size_t)((kt) * 64 + r0) * 4096 + c0 * 8; \
        sk0 = *(const u32x4*)kp; sk1 = *(const u32x4*)(kp + (size_t)32 * 4096); sv0 = *(const u32x4*)(kp + 128); sv1 = *(const u32x4*)(kp + (size_t)32 * 4096 + 128); \
        sr = *(const u32x4*)(rbase + (size_t)((kt) * 64 + rr) * 64 + rc * 8); } while (0)
#define A_WRITE(buf) do { LAS unsigned char* Kb = lds + (buf) * AK_TILE; LAS unsigned char* Vb = lds + 2 * AK_TILE + (buf) * AV_TILE; \
        *(LAS u32x4*)(Kb + r0 * AK_ROW + c0 * 16) = sk0; *(LAS u32x4*)(Kb + (r0 + 32) * AK_ROW + c0 * 16) = sk1; *(LAS u32x4*)(Kb + rr * AK_ROW + 256 + rc * 16) = sr; \
        *(LAS u32x4*)(Vb + r0 * AV_ROW + c0 * 16) = sv0; *(LAS u32x4*)(Vb + (r0 + 32) * AV_ROW + c0 * 16) = sv1; } while (0)
    const unsigned ldsb = (unsigned)(uintptr_t)lds;
    const unsigned vaddr0 = ldsb + 2 * AK_TILE + (4 * hi + ((lane & 15) >> 2)) * AV_ROW + (16 * ((lane >> 4) & 1) + 4 * (lane & 3)) * 2;
    __syncthreads();
    A_LOAD(0); A_WRITE(0);
    for (int kt = 0; kt < NT; ++kt) {
        __syncthreads();
        if (kt + 1 < NT) A_LOAD(kt + 1);
        if (kt <= my_last) {
            const int buf = kt & 1;
            const LAS unsigned char* Kl = lds + buf * AK_TILE + r32 * AK_ROW + hi * 16;
            f32x16 p0, p1;
#ifdef PROBE_A_QK
            int qreps = 2; asm volatile("" : "+s"(qreps));
            for (int qq = 0; qq < qreps; ++qq) {
#else
            {
#endif
#pragma unroll
            for (int r = 0; r < 16; ++r) { p0[r] = 0.f; p1[r] = 0.f; }
#pragma unroll
            for (int s = 0; s < 12; s += 2) {
                const bf16x8 a0 = *(const LAS bf16x8*)(Kl + s * 32), a1 = *(const LAS bf16x8*)(Kl + 32 * AK_ROW + s * 32);
                const bf16x8 c0 = *(const LAS bf16x8*)(Kl + s * 32 + 32), c1 = *(const LAS bf16x8*)(Kl + 32 * AK_ROW + s * 32 + 32);
                p0 = __builtin_amdgcn_mfma_f32_32x32x16_bf16(a0, qr[s], p0, 0, 0, 0);
                p1 = __builtin_amdgcn_mfma_f32_32x32x16_bf16(a1, qr[s], p1, 0, 0, 0);
                p0 = __builtin_amdgcn_mfma_f32_32x32x16_bf16(c0, qr[s + 1], p0, 0, 0, 0);
                p1 = __builtin_amdgcn_mfma_f32_32x32x16_bf16(c1, qr[s + 1], p1, 0, 0, 0);
                if ((s % 4) == 2) asm volatile("" ::: "memory");
            }
            }
            float tmax = p0[0];
#pragma unroll
            for (int r = 1; r < 16; ++r) tmax = fmaxf(tmax, p0[r]);
#pragma unroll
            for (int r = 0; r < 16; ++r) tmax = fmaxf(tmax, p1[r]);
            tmax = fmaxf(tmax, __shfl_xor(tmax, 32));
            const float mn = fmaxf(m_run, tmax), alpha = __builtin_amdgcn_exp2f((m_run - mn) * MLA_C), mc = mn * MLA_C;
            m_run = mn;
            float ls = 0.f;
#pragma unroll
            for (int r = 0; r < 16; ++r) { p0[r] = __builtin_amdgcn_exp2f(p0[r] * MLA_C - mc); p1[r] = __builtin_amdgcn_exp2f(p1[r] * MLA_C - mc); ls += p0[r] + p1[r]; }
            l_run = l_run * alpha + ls;
#pragma unroll
            for (int d = 0; d < 4; ++d)
#pragma unroll
                for (int r = 0; r < 16; ++r) o[d][r] *= alpha;
            bf16x8 pb[4];
            pb[0] = pack8(p0[0], p0[1], p0[2], p0[3], p0[4], p0[5], p0[6], p0[7]);
            pb[1] = pack8(p0[8], p0[9], p0[10], p0[11], p0[12], p0[13], p0[14], p0[15]);
            pb[2] = pack8(p1[0], p1[1], p1[2], p1[3], p1[4], p1[5], p1[6], p1[7]);
            pb[3] = pack8(p1[8], p1[9], p1[10], p1[11], p1[12], p1[13], p1[14], p1[15]);
            const unsigned va = vaddr0 + buf * AV_TILE;
            pv_block<0>(o[0], va, pb); pv_block<1>(o[1], va, pb); pv_block<2>(o[2], va, pb); pv_block<3>(o[3], va, pb);
#ifdef PROBE_A_PV
            { bf16x8 pz[4]; int zz = 0; asm volatile("" : "+v"(zz));
              _Pragma("unroll") for (int i = 0; i < 4; ++i) pz[i] = (bf16x8){(short)zz, (short)zz, (short)zz, (short)zz, (short)zz, (short)zz, (short)zz, (short)zz};
              pv_block<0>(o[0], va, pz); pv_block<1>(o[1], va, pz); pv_block<2>(o[2], va, pz); pv_block<3>(o[3], va, pz); }
#endif
        }
        if (kt + 1 < NT) A_WRITE((kt + 1) & 1);
    }
#undef A_LOAD
#undef A_WRITE
    const float inv = 1.f / (l_run + __shfl_xor(l_run, 32));
    bf16_t* op = OA + (size_t)tok * DM + h * 128 + 4 * hi;
#pragma unroll
    for (int d = 0; d < 4; ++d)
#pragma unroll
        for (int g = 0; g < 4; ++g) { u32x2 w; w.x = cvt_pk(o[d][4 * g] * inv, o[d][4 * g + 1] * inv); w.y = cvt_pk(o[d][4 * g + 2] * inv, o[d][4 * g + 3] * inv);
            *(u32x2*)(op + 32 * d + 8 * g) = w; }
}

constexpr int BK_ROW = 272, BK_TILE = 64 * BK_ROW;
constexpr int SB_FLAG_OFF = 2 * BK_TILE + 2 * AV_TILE;
__device__ __forceinline__ void sb_half(f32x16& p, int kbase, int qpos, float& run, int hi) {
    f32x16 L;
#pragma unroll
    for (int r = 0; r < 16; ++r) {
        const int kk = kbase + (r & 3) + 8 * (r >> 2);
        const float z = p[r] * SB_SCALE; const float e = __builtin_amdgcn_exp2f(-fabsf(z) * LOG2E); const float sp = __builtin_amdgcn_logf(1.f + e) * LN2;
        const bool bef = kk < qpos; const float madd = bef ? 0.f : -1e30f, mmul = bef ? 1.f : 0.f;
        p[r] = (fminf(z, 0.f) - sp) + madd; L[r] = (fminf(-z, 0.f) - sp) * mmul;
    }
    float qs[4], pq[4];
#pragma unroll
    for (int g = 0; g < 4; ++g) { qs[g] = (L[4 * g] + L[4 * g + 1]) + (L[4 * g + 2] + L[4 * g + 3]); pq[g] = __shfl_xor(qs[g], 32); }
#pragma unroll
    for (int g = 3; g >= 0; --g) {
        const float t3 = run + (hi == 0 ? pq[g] : 0.f), t2 = t3 + L[4 * g + 3], t1 = t2 + L[4 * g + 2], t0 = t1 + L[4 * g + 1];
        p[4 * g + 3] = __builtin_amdgcn_exp2f((p[4 * g + 3] + t3) * LOG2E); p[4 * g + 2] = __builtin_amdgcn_exp2f((p[4 * g + 2] + t2) * LOG2E);
        p[4 * g + 1] = __builtin_amdgcn_exp2f((p[4 * g + 1] + t1) * LOG2E); p[4 * g + 0] = __builtin_amdgcn_exp2f((p[4 * g + 0] + t0) * LOG2E);
        run += qs[g] + pq[g];
    }
}
struct SbSrc { const float* k_main; const float* v_main; const float* k_new; const float* v_new; int new_tile; };
__device__ __forceinline__ void attn_sb(LAS unsigned char* lds, int wave_k, const bf16_t* __restrict__ Qrow0  , const SbSrc src, bf16_t* __restrict__ Orow0  ,
                                        int kt_top, int nwact  , int qpos0  , int top_shift  ) {
    const int tid = phase_tid(wave_k);
    const int wid = __builtin_amdgcn_readfirstlane(tid >> 6), lane = tid & 63, r32 = lane & 31, hi = lane >> 5;
    const bool wact = wid < nwact;
    const int my_top = top_shift ? kt_top - ((7 - wid) >> 1) : kt_top;
    const int qpos = qpos0 + wid * 32 + r32;
    bf16x8 qr[8];
    if (wact) { const bf16_t* qp = Qrow0 + (size_t)(wid * 32 + r32) * 1024 + hi * 8;
#pragma unroll
        for (int s = 0; s < 8; ++s) qr[s] = *(const bf16x8*)(qp + 16 * s); }
    else {
#pragma unroll
        for (int s = 0; s < 8; ++s) qr[s] = (bf16x8){0, 0, 0, 0, 0, 0, 0, 0}; }
    f32x16 o[4];
#pragma unroll
    for (int d = 0; d < 4; ++d)
#pragma unroll
        for (int r = 0; r < 16; ++r) o[d][r] = 0.f;
    float carry = 0.f;
    const int srow = tid >> 3, scol = (tid & 7) * 16;
    f32x4 fk[4], fv[4];
#define B_LOADK(kt) do { const bool isnew = ((kt) == src.new_tile); const bool valid = !isnew || srow < 32; \
        const float* kp = (isnew ? src.k_new : src.k_main + (size_t)(kt) * 64 * 1024) + (size_t)srow * 1024 + scol; \
        if (valid) { _Pragma("unroll") for (int j = 0; j < 4; ++j) fk[j] = *(const f32x4*)(kp + 4 * j); } \
        else { _Pragma("unroll") for (int j = 0; j < 4; ++j) fk[j] = (f32x4){0.f, 0.f, 0.f, 0.f}; } } while (0)
#define B_LOADV(kt) do { const bool isnew = ((kt) == src.new_tile); const bool valid = !isnew || srow < 32; \
        const float* vp = (isnew ? src.v_new : src.v_main + (size_t)(kt) * 64 * 1024) + (size_t)srow * 1024 + scol; \
        if (valid) { _Pragma("unroll") for (int j = 0; j < 4; ++j) fv[j] = *(const f32x4*)(vp + 4 * j); } \
        else { _Pragma("unroll") for (int j = 0; j < 4; ++j) fv[j] = (f32x4){0.f, 0.f, 0.f, 0.f}; } } while (0)
#define B_WRITE(buf) do { LAS unsigned char* Kb = lds + (buf) * BK_TILE + srow * BK_ROW + scol * 2; LAS unsigned char* Vb = lds + 2 * BK_TILE + (buf) * AV_TILE + srow * AV_ROW + scol * 2; \
        u32x4 w; w.x = cvt_pk(fk[0][0], fk[0][1]); w.y = cvt_pk(fk[0][2], fk[0][3]); w.z = cvt_pk(fk[1][0], fk[1][1]); w.w = cvt_pk(fk[1][2], fk[1][3]); *(LAS u32x4*)Kb = w; \
        w.x = cvt_pk(fk[2][0], fk[2][1]); w.y = cvt_pk(fk[2][2], fk[2][3]); w.z = cvt_pk(fk[3][0], fk[3][1]); w.w = cvt_pk(fk[3][2], fk[3][3]); *(LAS u32x4*)(Kb + 16) = w; \
        w.x = cvt_pk(fv[0][0], fv[0][1]); w.y = cvt_pk(fv[0][2], fv[0][3]); w.z = cvt_pk(fv[1][0], fv[1][1]); w.w = cvt_pk(fv[1][2], fv[1][3]); *(LAS u32x4*)Vb = w; \
        w.x = cvt_pk(fv[2][0], fv[2][1]); w.y = cvt_pk(fv[2][2], fv[2][3]); w.z = cvt_pk(fv[3][0], fv[3][1]); w.w = cvt_pk(fv[3][2], fv[3][3]); *(LAS u32x4*)(Vb + 16) = w; } while (0)
    const unsigned ldsb = (unsigned)(uintptr_t)lds;
    const unsigned vaddr0 = ldsb + 2 * BK_TILE + (4 * hi + ((lane & 15) >> 2)) * AV_ROW + (16 * ((lane >> 4) & 1) + 4 * (lane & 3)) * 2;
    volatile LAS unsigned* flags = (volatile LAS unsigned*)(lds + SB_FLAG_OFF);
    __syncthreads();
    if (tid < 16) flags[tid] = 0u;
    B_LOADK(kt_top); B_LOADV(kt_top); B_WRITE(kt_top & 1);
    for (int kt = kt_top; kt >= 0; --kt) {
        __syncthreads();
        if (kt != kt_top) {
            unsigned alld = 1u;
#pragma unroll
            for (int w = 0; w < 8; ++w) alld &= flags[((kt + 1) & 1) * 8 + w];
#ifndef DBG_NO_EXIT
            if (alld) break;
        }
        unsigned mydone = wact ? 0u : 1u;
        const bool act = wact && kt <= my_top;
        const int buf = kt & 1;
        f32x16 p0, p1;
#pragma unroll
        for (int r = 0; r < 16; ++r) { p0[r] = 0.f; p1[r] = 0.f; }
        if (act) {
            const LAS unsigned char* Kl = lds + buf * BK_TILE + r32 * BK_ROW + hi * 16;
#pragma unroll
            for (int s = 0; s < 8; s += 2) {
                const bf16x8 a0 = *(const LAS bf16x8*)(Kl + s * 32), a1 = *(const LAS bf16x8*)(Kl + 32 * BK_ROW + s * 32);
                const bf16x8 c0 = *(const LAS bf16x8*)(Kl + s * 32 + 32), c1 = *(const LAS bf16x8*)(Kl + 32 * BK_ROW + s * 32 + 32);
                p0 = __builtin_amdgcn_mfma_f32_32x32x16_bf16(a0, qr[s], p0, 0, 0, 0);
                p1 = __builtin_amdgcn_mfma_f32_32x32x16_bf16(a1, qr[s], p1, 0, 0, 0);
                p0 = __builtin_amdgcn_mfma_f32_32x32x16_bf16(c0, qr[s + 1], p0, 0, 0, 0);
                p1 = __builtin_amdgcn_mfma_f32_32x32x16_bf16(c1, qr[s + 1], p1, 0, 0, 0);
                if ((s & 3) == 2) asm volatile("" ::: "memory");
            }
            float run = carry;
            sb_half(p1, kt * 64 + 32 + 4 * hi, qpos, run, hi);
            __builtin_amdgcn_sched_barrier(0);
            sb_half(p0, kt * 64 + 4 * hi, qpos, run, hi);
            carry = run;
        }
        asm volatile("" ::: "memory");
        if (kt > 0) { B_LOADK(kt - 1); B_LOADV(kt - 1); }
        if (act) {
            bf16x8 pb[4];
            pb[0] = pack8(p0[0], p0[1], p0[2], p0[3], p0[4], p0[5], p0[6], p0[7]);
            pb[1] = pack8(p0[8], p0[9], p0[10], p0[11], p0[12], p0[13], p0[14], p0[15]);
            pb[2] = pack8(p1[0], p1[1], p1[2], p1[3], p1[4], p1[5], p1[6], p1[7]);
            pb[3] = pack8(p1[8], p1[9], p1[10], p1[11], p1[12], p1[13], p1[14], p1[15]);
            const unsigned va = vaddr0 + buf * AV_TILE;
            pv_block<0>(o[0], va, pb); pv_block<1>(o[1], va, pb); pv_block<2>(o[2], va, pb); pv_block<3>(o[3], va, pb);
            mydone = __all(carry < -110.f) ? 1u : 0u;
        }
        if (lane == 0) flags[(kt & 1) * 8 + wid] = mydone;
        if (kt > 0) B_WRITE((kt - 1) & 1);
    }
#endif
#undef B_LOADK
#undef B_LOADV
#undef B_WRITE
    if (wact) {
        bf16_t* op = Orow0 + (size_t)(wid * 32 + r32) * 1024 + 4 * hi;
#pragma unroll
        for (int d = 0; d < 4; ++d)
#pragma unroll
            for (int g = 0; g < 4; ++g) { u32x2 w; w.x = cvt_pk(o[d][4 * g], o[d][4 * g + 1]); w.y = cvt_pk(o[d][4 * g + 2], o[d][4 * g + 3]); *(u32x2*)(op + 32 * d + 8 * g) = w; }
    }
}

constexpr int C_ROW = 1184, C_TILE = 32 * C_ROW, C_XOFF = 3 * C_TILE, C_XPB = 0, C_XAL = 8 * 1024;
template <int DT0> __device__ __forceinline__ void pvc8(f32x4 (&o)[32], unsigned vaddr, bf16x8 pb) {
#define PVC1(j) { const s16x4 lo = tr_read<(DT0 + j) * 32>(vaddr), hi_ = tr_read<16 * C_ROW + (DT0 + j) * 32>(vaddr); asm volatile("s_waitcnt lgkmcnt(0)" ::: "memory"); __builtin_amdgcn_sched_barrier(0); \
        o[DT0 + j] = __builtin_amdgcn_mfma_f32_16x16x32_bf16(PKTR(lo, hi_), pb, o[DT0 + j], 0, 0, 0); }
    PVC1(0) PVC1(1) PVC1(2) PVC1(3) PVC1(4) PVC1(5) PVC1(6) PVC1(7)
#undef PVC1
}
__device__ __forceinline__ void attn_mla_sample(LAS unsigned char* lds, int wave_k, const bf16_t* __restrict__ QLAT, const bf16_t* __restrict__ Q, const bf16_t* __restrict__ LATS  ,
                                                const bf16_t* __restrict__ KRS  , bf16_t* __restrict__ CTX, int b, int rg) {
    const int tid = phase_tid(wave_k);
    const int wid = __builtin_amdgcn_readfirstlane(tid >> 6), lane = tid & 63, c16 = lane & 15, g = lane >> 4;
    const bool pvw = wid >= 4; const int j4 = wid & 3;
    const int R = rg * 4 + j4, h = R >> 1, q = (R & 1) * 16 + c16;
    const int srow = b * DSEQ + q;
    f32x4 o[32];
#pragma unroll
    for (int d = 0; d < 32; ++d) o[d] = (f32x4){0.f, 0.f, 0.f, 0.f};
    if (!pvw) { const bf16_t* qp = QLAT + (size_t)srow * 8192 + h * 512 + g * 8;
#pragma unroll
      for (int s = 0; s < 16; ++s) o[s] = *(const f32x4*)(qp + 32 * s);
      const bf16_t* qr_ = Q + (size_t)(TP + srow) * 3072 + h * 192 + 128 + g * 8;
      o[16] = *(const f32x4*)qr_; o[17] = *(const f32x4*)(qr_ + 32); }
    float m_run = -INFINITY, l_run = 0.f;
    u32x4 st[5];
#define C_LOAD(kt) do { _Pragma("unroll") for (int j = 0; j < 4; ++j) { const int ch = tid + 512 * j, r = ch >> 6, c = ch & 63; st[j] = *(const u32x4*)(LATS + (size_t)((kt) * 32 + r) * 512 + c * 8); } \
        if (tid < 256) st[4] = *(const u32x4*)(KRS + (size_t)((kt) * 32 + (tid >> 3)) * 64 + (tid & 7) * 8); } while (0)
#define C_WRITE(buf) do { LAS unsigned char* Tb = lds + (buf) * C_TILE; _Pragma("unroll") for (int j = 0; j < 4; ++j) { const int ch = tid + 512 * j, r = ch >> 6, c = ch & 63; *(LAS u32x4*)(Tb + r * C_ROW + c * 16) = st[j]; } \
        if (tid < 256) *(LAS u32x4*)(Tb + (tid >> 3) * C_ROW + 1024 + (tid & 7) * 16) = st[4]; } while (0)
    const unsigned ldsb = (unsigned)(uintptr_t)lds;
    const unsigned vaddr0 = ldsb + (4 * g + (c16 >> 2)) * C_ROW + (c16 & 3) * 8;
    LAS unsigned char* xpb = lds + C_XOFF + C_XPB + j4 * 1024 + lane * 16;
    LAS unsigned char* xal = lds + C_XOFF + C_XAL + j4 * 256 + lane * 4;
    constexpr int NT = SKEYS / 32;
    __syncthreads();
    C_LOAD(0); C_WRITE(0);
    int tcur = 0, tprev = 2;
    for (int kt = 0; kt <= NT; ++kt) {
        __syncthreads();
        if (kt + 1 < NT) C_LOAD(kt + 1);
        if (!pvw) {
            if (kt < NT) {
                const LAS unsigned char* Kl = lds + tcur * C_TILE + c16 * C_ROW + g * 16;
                f32x4 s0 = (f32x4){0.f, 0.f, 0.f, 0.f}, s1 = s0;
#pragma unroll
                for (int s = 0; s < 18; s += 2) {
                    const bf16x8 a0 = *(const LAS bf16x8*)(Kl + s * 64), a1 = *(const LAS bf16x8*)(Kl + 16 * C_ROW + s * 64);
                    const bf16x8 e0 = *(const LAS bf16x8*)(Kl + s * 64 + 64), e1 = *(const LAS bf16x8*)(Kl + 16 * C_ROW + s * 64 + 64);
                    const bf16x8 qa = __builtin_bit_cast(bf16x8, o[s]), qb = __builtin_bit_cast(bf16x8, o[s + 1]);
                    s0 = __builtin_amdgcn_mfma_f32_16x16x32_bf16(a0, qa, s0, 0, 0, 0);
                    s1 = __builtin_amdgcn_mfma_f32_16x16x32_bf16(a1, qa, s1, 0, 0, 0);
                    s0 = __builtin_amdgcn_mfma_f32_16x16x32_bf16(e0, qb, s0, 0, 0, 0);
                    s1 = __builtin_amdgcn_mfma_f32_16x16x32_bf16(e1, qb, s1, 0, 0, 0);
                    if ((s % 6) == 4) asm volatile("" ::: "memory");
                }
                float tmax = fmaxf(fmaxf(fmaxf(s0[0], s0[1]), fmaxf(s0[2], s0[3])), fmaxf(fmaxf(s1[0], s1[1]), fmaxf(s1[2], s1[3])));
                tmax = fmaxf(tmax, __shfl_xor(tmax, 16)); tmax = fmaxf(tmax, __shfl_xor(tmax, 32));
                const float mn = fmaxf(m_run, tmax), alpha = __builtin_amdgcn_exp2f((m_run - mn) * MLA_C), mc = mn * MLA_C;
                m_run = mn;
                float ls = 0.f;
#pragma unroll
                for (int j = 0; j < 4; ++j) { s0[j] = __builtin_amdgcn_exp2f(s0[j] * MLA_C - mc); s1[j] = __builtin_amdgcn_exp2f(s1[j] * MLA_C - mc); ls += s0[j] + s1[j]; }
                l_run = l_run * alpha + ls;
                const bf16x8 pb = pack8(s0[0], s0[1], s0[2], s0[3], s1[0], s1[1], s1[2], s1[3]);
                *(LAS bf16x8*)(xpb + (kt & 1) * 4096) = pb; *(LAS float*)(xal + (kt & 1) * 1024) = alpha;
            }
        } else if (kt >= 1) {
            const bf16x8 pb = *(const LAS bf16x8*)(xpb + ((kt - 1) & 1) * 4096); const float alpha = *(const LAS float*)(xal + ((kt - 1) & 1) * 1024);
            if (__any(alpha != 1.f)) {
#pragma unroll
                for (int d = 0; d < 32; ++d) o[d] *= alpha;
            }
            const unsigned va = vaddr0 + tprev * C_TILE;
            pvc8<0>(o, va, pb); pvc8<8>(o, va, pb); pvc8<16>(o, va, pb); pvc8<24>(o, va, pb);
        }
        const int tnext = (tcur == 2) ? 0 : tcur + 1;
        if (kt + 1 < NT) C_WRITE(tnext);
        tprev = tcur; tcur = tnext;
    }
#undef C_LOAD
#undef C_WRITE
    if (!pvw) { float lt = l_run; lt += __shfl_xor(lt, 16); lt += __shfl_xor(lt, 32); *(LAS float*)(xal + 1024) = 1.f / lt; }
    __syncthreads();
    if (pvw) {
        const float inv = *(const LAS float*)(xal + 1024);
        bf16_t* op = CTX + (size_t)srow * 8192 + h * 512 + 4 * g;
#pragma unroll
        for (int d = 0; d < 32; ++d) { u32x2 w; w.x = cvt_pk(o[d][0] * inv, o[d][1] * inv); w.y = cvt_pk(o[d][2] * inv, o[d][3] * inv); *(u32x2*)(op + 16 * d) = w; }
    }
}

struct Args { const float* in[30]; float* out; unsigned char* ws; int ph_lo, ph_hi; };
constexpr int NWAVES = 8, NPH_LAYER = 14, NPHASES = 1 + NLAYER * NPH_LAYER;

template <class Map>
__device__ __forceinline__ void transpose_item(const float* W, int K, int Nsrc, bf16_t* WT, int ldt, LAS float* scr, int item, int lane, const Map& map) {
    const int nblk = Nsrc / 32, kb = item / nblk, nb = item % nblk, k0 = 64 * kb, n0 = 32 * nb;
#pragma unroll 8
    for (int i = 0; i < 32; ++i) { const int kk = 2 * i + (lane >> 5); scr[kk * 33 + (lane & 31)] = W[(size_t)(k0 + kk) * Nsrc + n0 + (lane & 31)]; }
    asm volatile("s_waitcnt lgkmcnt(0)" ::: "memory");
    const int c = lane & 7;
#pragma unroll
    for (int j = 0; j < 4; ++j) { const int n = (lane >> 3) + 8 * j; const LAS float* s = scr + (8 * c) * 33 + n;
        u32x4 o; o.x = cvt_pk(s[0 * 33], s[1 * 33]); o.y = cvt_pk(s[2 * 33], s[3 * 33]); o.z = cvt_pk(s[4 * 33], s[5 * 33]); o.w = cvt_pk(s[6 * 33], s[7 * 33]);
        *(u32x4*)(WT + (size_t)map(n0 + n) * ldt + k0 + 8 * c) = o; }
    asm volatile("s_waitcnt lgkmcnt(0)" ::: "memory");
}
struct MapId { __device__ __forceinline__ int operator()(int n) const { return n; } };
struct MapIn { __device__ __forceinline__ int operator()(int c) const { return c < 1024 ? c : (c < 1088 ? 8192 + (c - 1024) : c - 64); } };
struct MapQ { __device__ __forceinline__ int operator()(int c) const { const int h = c / 192, w = c - h * 192; if (w < 128) return c; const int j = w - 128; return h * 192 + 128 + 2 * (j & 31) + (j >> 5); } };
struct MapGU { __device__ __forceinline__ int operator()(int c) const { return c < FF ? (c >> 2) * 8 + (c & 3) : ((c - FF) >> 2) * 8 + 4 + ((c - FF) & 3); } };

__device__ __forceinline__ void ln_row(const float* __restrict__ xin, const float* __restrict__ gam, const float* __restrict__ bet, float* __restrict__ xo, bf16_t* __restrict__ xb, int lane) {
    const f32x4* xr = (const f32x4*)xin + lane;
    f32x4 v[8]; float s = 0.f;
#pragma unroll
    for (int j = 0; j < 8; ++j) { v[j] = xr[64 * j]; s += (v[j][0] + v[j][1]) + (v[j][2] + v[j][3]); }
    const float mean = wave_sum(s) * (1.f / DM); float s2 = 0.f;
#pragma unroll
    for (int j = 0; j < 8; ++j) { v[j] = v[j] - mean; s2 += (v[j][0] * v[j][0] + v[j][1] * v[j][1]) + (v[j][2] * v[j][2] + v[j][3] * v[j][3]); }
    const float rstd = 1.f / sqrtf(wave_sum(s2) * (1.f / DM) + LN_EPS);
#pragma unroll
    for (int j = 0; j < 8; ++j) { const f32x4 gg = ((const f32x4*)gam)[64 * j + lane], bb = ((const f32x4*)bet)[64 * j + lane]; const f32x4 y = v[j] * rstd * gg + bb;
        if (xo) ((f32x4*)xo)[64 * j + lane] = y;
        if (xb) { u32x2 w; w.x = cvt_pk(y[0], y[1]); w.y = cvt_pk(y[2], y[3]); ((u32x2*)xb)[64 * j + lane] = w; } }
}

#define P_X     ((float*)(ws + WS_X))
#define P_Y     ((float*)(ws + WS_Y))
#define P_XB    ((bf16_t*)(ws + WS_XB))
#define P_QA    ((float*)(ws + WS_QA))
#define P_KVA   ((float*)(ws + WS_KVA))
#define P_KRRAW ((float*)(ws + WS_KRRAW))
#define P_SBQ   ((bf16_t*)(ws + WS_SBQ))
#define P_GATE  ((bf16_t*)(ws + WS_GATE))
#define P_QN    ((bf16_t*)(ws + WS_QN))
#define P_LATB  ((bf16_t*)(ws + WS_LATB))
#define P_KRB   ((bf16_t*)(ws + WS_KRB))
#define P_Q     ((bf16_t*)(ws + WS_Q))
#define P_KVX   ((bf16_t*)(ws + WS_KVX))
#define P_QLAT  ((bf16_t*)(ws + WS_QLAT))
#define P_CTX   ((bf16_t*)(ws + WS_CTX))
#define P_OA    ((bf16_t*)(ws + WS_OA))
#define P_OB    ((bf16_t*)(ws + WS_OB))
#define P_T1    ((float*)(ws + WS_T1))
#define P_MRG   ((bf16_t*)(ws + WS_MRG))
#define P_FFB   ((bf16_t*)(ws + WS_FFB))
#define P_PP    ((float*)(ws + WS_PP))
#define P_LATS  ((bf16_t*)(ws + WS_LATS))
#define P_KRS   ((bf16_t*)(ws + WS_KRS))
#define P_PB    ((bf16_t*)(ws + WS_PB))
#define P_ROPE  ((float*)(ws + WS_ROPE))
#define P_WL(off) ((const bf16_t*)(ws + WS_W + (size_t)l * W_LAYER + (off)))

#ifndef PROBE_MASK
#define PROBE_MASK 0
#endif
#define REP0 (1 + (PROBE_MASK & 1))
#define REP(j) (1 + ((PROBE_MASK >> (1 + (j))) & 1))
#ifndef PHMASK
#define PHMASK 0xffff
#endif

__global__ void __launch_bounds__(512, 2) fwd_kernel(Args args) {
    extern __shared__ __attribute__((aligned(16))) unsigned char lds_raw[];
    LAS unsigned char* lds = (LAS unsigned char*)lds_raw;
    volatile LAS unsigned* MISC = (volatile LAS unsigned*)(lds + LDS_MISC);
    const int G_k = gridDim.x, bx_k = blockIdx.x, wave_k = __builtin_amdgcn_readfirstlane(threadIdx.x >> 6);
    unsigned char* const ws_k = args.ws;
    float* const out_k = args.out;
    for (int u = threadIdx.x; u < (LDS_BYTES - LDS_MISC) / 4; u += 512) MISC[u] = 0u;
    __syncthreads();
#if !MK_PER_PHASE
    const XcdBarrier bar = xcd_barrier_post((unsigned*)(ws_k + WS_CTL) + CW_BAR, MISC + 8);
#define GRID_BAR() xcd_barrier(bar, wave_k)
#else
#define GRID_BAR() do {} while (0)
#endif
    const int lo = args.ph_lo, hi = args.ph_hi;
#define IN(k) (lo <= (k) && (k) < hi)
#define LIN(j) (((PHMASK >> (1 + (j))) & 1) && IN(P0 + (j)))
#define SEAM(k) do { if (IN(k) && IN((k) + 1)) GRID_BAR(); } while (0)
#define PHASE_PTRS() unsigned zoff_ = 0u; int G = G_k, bx = bx_k; asm volatile("" : "+s"(zoff_), "+s"(G), "+s"(bx)); unsigned char* ws = ws_k + zoff_; float* out = out_k + zoff_; (void)out; (void)G; (void)bx
#define PHASE_IDS() PHASE_PTRS(); const int tid = phase_tid(wave_k); const int lane = tid & 63, wave = wave_k, gw = bx * NWAVES + wave, NGW = G * NWAVES; (void)lane; (void)gw; (void)NGW

    if ((PHMASK & 1) && IN(0)) for (int rep = 0; rep < REP0; ++rep) {
        PHASE_IDS();
        const size_t gtid = (size_t)bx * 512 + tid, gthreads = (size_t)G * 512;
        LAS float* scr = (LAS float*)(lds + wave * 16384);
        for (int l = 0; l < NLAYER; ++l) {
            unsigned char* wl = ws + WS_W + (size_t)l * W_LAYER;
            { const float* W = args.in[10] + (size_t)l * DM * 8256; bf16_t* WT = (bf16_t*)(wl + W_IN); const int nit = (DM / 64) * (8256 / 32);
              for (int it = gw; it < nit; it += NGW) transpose_item(W, DM, 8256, WT, DM, scr, it, lane, MapIn());
              for (size_t i = gtid; i < (size_t)192 * DM / 8; i += gthreads) ((u32x4*)(WT + (size_t)8256 * DM))[i] = (u32x4){0u, 0u, 0u, 0u}; }
            { const float* W = args.in[13] + (size_t)l * 512 * 3072; bf16_t* WT = (bf16_t*)(wl + W_QB); const int nit = (512 / 64) * (3072 / 32);
              for (int it = gw; it < nit; it += NGW) transpose_item(W, 512, 3072, WT, 512, scr, it, lane, MapQ()); }
            { const float* W = args.in[15] + (size_t)l * 512 * 4096; bf16_t* WT = (bf16_t*)(wl + W_KVBT); const int nit = (512 / 64) * (4096 / 32);
              for (int it = gw; it < nit; it += NGW) transpose_item(W, 512, 4096, WT, 512, scr, it, lane, MapId());
              bf16_t* WN = (bf16_t*)(wl + W_KVBN);
              for (size_t i = gtid; i < (size_t)16 * 512 * 256 / 8; i += gthreads) { const int k8 = (int)(i & 31) * 8, c = (int)(i >> 5) & 511, hh = (int)(i >> 14);
                  f32x4 a = (f32x4){0.f, 0.f, 0.f, 0.f}, b = a;
                  if (k8 < 128) { const float* src = W + (size_t)c * 4096 + hh * 256 + k8; a = *(const f32x4*)src; b = *(const f32x4*)(src + 4); }
                  st_bf16x8(WN + 8 * i, a, b); }
              bf16_t* BD = (bf16_t*)(wl + W_UVBD);
              for (size_t i = gtid; i < (size_t)2048 * 1024 / 2; i += gthreads) { const int n = (int)(i / 512), k2 = (int)(i % 512) * 2, hh = n >> 7, v = n & 127; unsigned w = 0u;
                  if ((k2 >> 9) == (hh & 1)) { const int c = k2 & 511; w = cvt_pk(W[(size_t)c * 4096 + hh * 256 + 128 + v], W[(size_t)(c + 1) * 4096 + hh * 256 + 128 + v]); }
                  ((unsigned*)BD)[i] = w; } }
            { const float* W = args.in[16] + (size_t)l * DM * DM; bf16_t* WT = (bf16_t*)(wl + W_BA); const int nit = (DM / 64) * (DM / 32);
              for (int it = gw; it < nit; it += NGW) transpose_item(W, DM, DM, WT, DM, scr, it, lane, MapId()); }
            { const float* W = args.in[17] + (size_t)l * 1024 * DM; bf16_t* WT = (bf16_t*)(wl + W_BB); const int nit = (1024 / 64) * (DM / 32);
              for (int it = gw; it < nit; it += NGW) transpose_item(W, 1024, DM, WT, 1024, scr, it, lane, MapId()); }
            { const float* W = args.in[18] + (size_t)l * DM * DM; bf16_t* WT = (bf16_t*)(wl + W_OUT); const int nit = (DM / 64) * (DM / 32);
              for (int it = gw; it < nit; it += NGW) transpose_item(W, DM, DM, WT, DM, scr, it, lane, MapId()); }
            { const float* W = args.in[21] + (size_t)l * DM * 2 * FF; bf16_t* WT = (bf16_t*)(wl + W_GU); const int nit = (DM / 64) * (2 * FF / 32);
              for (int it = gw; it < nit; it += NGW) transpose_item(W, DM, 2 * FF, WT, DM, scr, it, lane, MapGU()); }
            { const float* W = args.in[22] + (size_t)l * FF * DM; bf16_t* WT = (bf16_t*)(wl + W_DN); const int nit = (FF / 64) * (DM / 32);
              for (int it = gw; it < nit; it += NGW) transpose_item(W, FF, DM, WT, FF, scr, it, lane, MapId()); }
            { const float* W = args.in[25] + (size_t)l * DM * DM; bf16_t* WT = (bf16_t*)(wl + W_PG); const int nit = (DM / 64) * (DM / 32);
              for (int it = gw; it < nit; it += NGW) transpose_item(W, DM, DM, WT, DM, scr, it, lane, MapId()); }
            { const float* W = args.in[27] + (size_t)l * PLE * DM; bf16_t* WT = (bf16_t*)(wl + W_PP); const int nit = (PLE / 64) * (DM / 32);
              for (int it = gw; it < nit; it += NGW) transpose_item(W, PLE, DM, WT, PLE, scr, it, lane, MapId()); }
        }
        for (size_t i = gtid; i < (size_t)SEQ * 32; i += gthreads) { float c, s; rope_cs_slow((int)(i >> 5), (int)(i & 31), c, s); P_ROPE[i] = c; P_ROPE[(size_t)SEQ * 32 + i] = s; }
        { const float* cl = args.in[2];
          for (size_t i = gtid; i < (size_t)NLAYER * NDB * PAST * 512 / 8; i += gthreads) { const size_t e = i * 8, lb_ = e / ((size_t)PAST * 512), rem = e % ((size_t)PAST * 512);
              const f32x4 a = *(const f32x4*)(cl + e), b = *(const f32x4*)(cl + e + 4); st_bf16x8(P_LATS + lb_ * (size_t)SKEYS * 512 + rem, a, b); }
          const float* ck = args.in[3];
          for (size_t i = gtid; i < (size_t)NLAYER * NDB * PAST * 32; i += gthreads) { const size_t rowi = i / 32; const int p = (int)(i % 32); const size_t lb_ = rowi / PAST, rr = rowi % PAST;
              ((unsigned*)(P_KRS + (lb_ * SKEYS + rr) * 64))[p] = cvt_pk(ck[rowi * 64 + p], ck[rowi * 64 + 32 + p]); } }
        { const float* pp = args.in[6]; const float* ps = args.in[7];
          for (size_t i = gtid; i < (size_t)NLAYER * TT * PLE / 8; i += gthreads) { const size_t e = i * 8, l = e / ((size_t)TT * PLE), rem = e % ((size_t)TT * PLE);
              const float* src = rem < (size_t)TP * PLE ? pp + l * (size_t)TP * PLE + rem : ps + l * (size_t)TS * PLE + (rem - (size_t)TP * PLE);
              st_bf16x8(P_PB + e, *(const f32x4*)src, *(const f32x4*)(src + 4)); } }
        for (int m = gw; m < TT; m += NGW) { const float* xin = m < TP ? args.in[0] + (size_t)m * DM : args.in[1] + (size_t)(m - TP) * DM;
            ln_row(xin, args.in[8], args.in[9], P_X + (size_t)m * DM, P_XB + (size_t)m * DM, lane); }
    }
    SEAM(0);

    for (int l = 0; l < NLAYER; ++l) {
        const int P0 = 1 + l * NPH_LAYER;
        if (LIN(0)) for (int rep = 0; rep < REP(0); ++rep) {
            PHASE_PTRS();
            pg8::Order S; S.init(TT, 30 * 256, 1, G, bx, 1);
            pg8::EpiIn E{P_QA, P_KVA, P_KRRAW, P_SBQ, P_GATE, out + O_K_P + (size_t)l * TP * 1024, out + O_K_S + (size_t)l * TS * 1024,
                         out + O_V_P + (size_t)l * TP * 1024, out + O_V_S + (size_t)l * TS * 1024, args.in[11] + (size_t)l * 4096};
            pg8::gemm_phase<pg8::Shape<DM, DM, DM>>(lds, wave_k, P_XB, P_WL(W_IN), S, E);
        }
        SEAM(P0 + 0);
        if (LIN(1)) for (int rep = 0; rep < REP(1); ++rep) {
            PHASE_IDS();
            const float* gq = args.in[12] + (size_t)l * 512; const float* gkv = args.in[14] + (size_t)l * 512;
            bf16_t* LATS_l = P_LATS + (size_t)l * NDB * SKEYS * 512; bf16_t* KRS_l = P_KRS + (size_t)l * NDB * SKEYS * 64;
            for (int m = gw; m < TT; m += NGW) {
                { const f32x4 a = ((const f32x4*)(P_QA + (size_t)m * 512))[2 * lane], b = ((const f32x4*)(P_QA + (size_t)m * 512))[2 * lane + 1];
                  const float ss = wave_sum((a[0] * a[0] + a[1] * a[1]) + (a[2] * a[2] + a[3] * a[3]) + (b[0] * b[0] + b[1] * b[1]) + (b[2] * b[2] + b[3] * b[3]));
                  const float r = 1.f / sqrtf(ss * (1.f / 512.f) + RMS_EPS); const f32x4 g0 = ((const f32x4*)gq)[2 * lane], g1 = ((const f32x4*)gq)[2 * lane + 1];
                  st_bf16x8(P_QN + (size_t)m * 512 + 8 * lane, a * r * g0, b * r * g1); }
                { const f32x4 a = ((const f32x4*)(P_KVA + (size_t)m * 512))[2 * lane], b = ((const f32x4*)(P_KVA + (size_t)m * 512))[2 * lane + 1];
                  const float ss = wave_sum((a[0] * a[0] + a[1] * a[1]) + (a[2] * a[2] + a[3] * a[3]) + (b[0] * b[0] + b[1] * b[1]) + (b[2] * b[2] + b[3] * b[3]));
                  const float r = 1.f / sqrtf(ss * (1.f / 512.f) + RMS_EPS); const f32x4 g0 = ((const f32x4*)gkv)[2 * lane], g1 = ((const f32x4*)gkv)[2 * lane + 1];
                  const f32x4 y0 = a * r * g0, y1 = b * r * g1;
                  float* od; bf16_t* ob;
                  if (m < TP) { od = out + O_LAT_P + ((size_t)l * TP + m) * 512; ob = P_LATB + (size_t)m * 512; }
                  else { const int sm = m - TP, bb = sm >> 5, qq = sm & 31; od = out + O_LAT_S + ((size_t)l * TS + sm) * 512; ob = LATS_l + ((size_t)bb * SKEYS + PAST + qq) * 512; }
                  st_f32x8(od + 8 * lane, y0, y1); st_bf16x8(ob + 8 * lane, y0, y1); }
                if (lane < 32) { const float x1 = P_KRRAW[(size_t)m * 64 + lane], x2 = P_KRRAW[(size_t)m * 64 + 32 + lane];
                  const int pos = tok_pos(m); const float c = P_ROPE[pos * 32 + lane], s = P_ROPE[SEQ * 32 + pos * 32 + lane];
                  const float y1 = x1 * c - x2 * s, y2 = x2 * c + x1 * s;
                  float* od; bf16_t* ob;
                  if (m < TP) { od = out + O_KR_P + ((size_t)l * TP + m) * 64; ob = P_KRB + (size_t)m * 64; }
                  else { const int sm = m - TP, bb = sm >> 5, qq = sm & 31; od = out + O_KR_S + ((size_t)l * TS + sm) * 64; ob = KRS_l + ((size_t)bb * SKEYS + PAST + qq) * 64; }
                  od[lane] = y1; od[32 + lane] = y2; ((unsigned*)ob)[lane] = cvt_pk(y1, y2); }
            }
        }
        SEAM(P0 + 1);
        if (LIN(2)) for (int rep = 0; rep < REP(2); ++rep) {
            PHASE_PTRS();
            { pg8::Order S; S.init(TT, 3 * 256, 1, G, bx, 2);
              pg8::EpiIn E{P_QA, P_KVA, P_KRRAW, P_SBQ, P_GATE, out + O_K_P + (size_t)l * TP * 1024, out + O_K_S + (size_t)l * TS * 1024,
                           out + O_V_P + (size_t)l * TP * 1024, out + O_V_S + (size_t)l * TS * 1024, args.in[11] + (size_t)l * 4096};
              pg8::gemm_phase<pg8::Shape<DM, DM, DM>>(lds, wave_k, P_XB, P_WL(W_IN), S, E); }
            { pg8::Order S; S.init(TT, 3072, 1, G, (bx + 154) & 255); pg8::EpiQ E{P_Q, P_ROPE}; pg8::gemm_phase<pg8::Shape<512, 512, 512>>(lds, wave_k, P_QN, P_WL(W_QB), S, E); }
            { pg8::Order S; S.init(TP, 4096, 1, 154, bx >= 102 ? bx - 102 : (1 << 28)); pg8::EpiBf16 E{P_KVX, 4096, 0}; pg8::gemm_phase<pg8::Shape<512, 512, 512>>(lds, wave_k, P_LATB, P_WL(W_KVBT), S, E); }
            { pg8::Order S; S.init(TP, DM, 1, G, bx); pg8::EpiF32 E{P_PP, DM}; pg8::gemm_phase<pg8::Shape<PLE, PLE, PLE>>(lds, wave_k, P_PB + (size_t)l * TT * PLE, P_WL(W_PP), S, E);
              pg8::gemm_small<PLE, PLE, PLE, 0>(lds, wave_k, P_PB + (size_t)l * TT * PLE, P_WL(W_PP), TP, 8, 32, G, bx, E); }
        }
        SEAM(P0 + 2);
        if (LIN(3)) for (int rep = 0; rep < REP(3); ++rep) {
            PHASE_PTRS();
            pg8::Order S; S.init(TS, 512, 16, G, bx); pg8::EpiBf16 E{P_QLAT, 8192, 512};
            pg8::gemm_phase<pg8::Shape<256, 3072, 256, 192, 512 * 256, 0>>(lds, wave_k, P_Q + (size_t)TP * 3072, P_WL(W_KVBN), S, E);
        }
        SEAM(P0 + 3);
        if (LIN(4)) for (int rep = 0; rep < REP(4); ++rep) {
            PHASE_IDS();
            volatile LAS int* qslot = (volatile LAS int*)(MISC + 16);
            unsigned* qc = (unsigned*)(ws + WS_CTL) + CW_Q + (size_t)(l * 2 + rep) * 4 * 64;
#ifndef PROBE_ATT
#define PROBE_ATT 0
#endif
#ifndef NO_C
            for (int r2 = 0; r2 < 1 + (PROBE_ATT & 1); ++r2)
            for (;;) {
                __syncthreads(); if (tid == 0) qslot[0] = (int)atomicAdd(qc + (r2 ? 3 : 0) * 64, 1u); __syncthreads();
                const int it = qslot[0]; if (it >= 128) break;
                const int b = it >> 3, rg = it & 7;
                attn_mla_sample(lds, wave_k, P_QLAT, P_Q, P_LATS + ((size_t)l * NDB + b) * SKEYS * 512, P_KRS + ((size_t)l * NDB + b) * SKEYS * 64, P_CTX, b, rg);
            }
#endif
#ifndef NO_A
            for (int r2 = 0; r2 < 1 + ((PROBE_ATT >> 1) & 1); ++r2)
            for (;;) {
                __syncthreads(); if (tid == 0) qslot[0] = (int)atomicAdd(qc + (r2 ? 3 : 1) * 64, 1u); __syncthreads();
                const int it = qslot[0]; if (it >= 512) break;
                const int qb = 15 - (it >> 5), bh = it & 31, b = bh >> 4, h = bh & 15;
                attn_mla_prompt(lds, wave_k, P_Q, P_KVX, P_KRB, P_OA, b, h, qb);
            }
#endif
#ifndef NO_B
            for (int r2 = 0; r2 < 1 + ((PROBE_ATT >> 2) & 1); ++r2)
            for (;;) {
                __syncthreads(); if (tid == 0) qslot[0] = (int)atomicAdd(qc + (r2 ? 3 : 2) * 64, 1u); __syncthreads();
                const int it = qslot[0]; if (it >= 256 + 128) break;
#ifdef DBG_ONLY_D
                if (it < 256) continue;
#endif
#ifdef DBG_ONLY_B
                if (it >= 256) continue;
#endif
                SbSrc src; size_t row0; int kt_top, nwact, qpos0, top_shift, h;
                if (it < 256) {
                    const int qb = 15 - (it >> 4), bh = it & 15, b = bh >> 3; h = bh & 7;
                    src.k_main = out + O_K_P + ((size_t)l * TP + (size_t)b * SEQ) * 1024 + h * 128; src.v_main = out + O_V_P + ((size_t)l * TP + (size_t)b * SEQ) * 1024 + h * 128;
                    src.k_new = src.k_main; src.v_new = src.v_main; src.new_tile = -1;
                    row0 = (size_t)b * SEQ + qb * 256; kt_top = 4 * qb + 3; nwact = 8; qpos0 = qb * 256; top_shift = 1;
                } else {
                    const int u = it - 256, b = u >> 3; h = u & 7;
                    src.k_main = args.in[4] + ((size_t)(l * NDB + b) * PAST) * 1024 + h * 128; src.v_main = args.in[5] + ((size_t)(l * NDB + b) * PAST) * 1024 + h * 128;
                    src.k_new = out + O_K_S + ((size_t)l * TS + (size_t)b * DSEQ) * 1024 + h * 128; src.v_new = out + O_V_S + ((size_t)l * TS + (size_t)b * DSEQ) * 1024 + h * 128; src.new_tile = 32;
                    row0 = (size_t)TP + b * DSEQ; kt_top = 32; nwact = 1; qpos0 = PAST; top_shift = 0;
                }
                attn_sb(lds, wave_k, P_SBQ + row0 * 1024 + h * 128, src, P_OB + row0 * 1024 + h * 128, kt_top, nwact, qpos0, top_shift);
            }
#endif
            __syncthreads();
        }
        SEAM(P0 + 4);
        if (LIN(5)) for (int rep = 0; rep < REP(5); ++rep) {
            PHASE_PTRS();
            { pg8::EpiBf16 E{P_OA + (size_t)TP * DM, DM, 0}; pg8::gemm_small<1024, 8192, 1024, 1024>(lds, wave_k, P_CTX, P_WL(W_UVBD), 0, 8, 32, G, bx, E); }
            { pg8::Order S; S.init(TP, DM, 1, G, bx); pg8::EpiBrB E{P_T1, P_GATE}; pg8::gemm_phase<pg8::Shape<1024, 1024, 1024>>(lds, wave_k, P_OB, P_WL(W_BB), S, E);
              pg8::gemm_small<1024, 1024, 1024, 0>(lds, wave_k, P_OB, P_WL(W_BB), TP, 8, 32, G, bx, E); }
        }
        SEAM(P0 + 5);
        if (LIN(6)) for (int rep = 0; rep < REP(6); ++rep) { PHASE_PTRS(); pg8::Order S; S.init(TP, DM, 1, G, bx); pg8::EpiBrA E{P_MRG, P_T1, P_GATE}; pg8::gemm_phase<pg8::Shape<DM, DM, DM>>(lds, wave_k, P_OA, P_WL(W_BA), S, E);
            pg8::gemm_small<DM, DM, DM, 0>(lds, wave_k, P_OA, P_WL(W_BA), TP, 8, 32, G, bx, E); }
        SEAM(P0 + 6);
        if (LIN(7)) for (int rep = 0; rep < REP(7); ++rep) { PHASE_PTRS(); pg8::Order S; S.init(TP, DM, 1, G, bx); pg8::EpiRes E{P_Y, P_X}; pg8::gemm_phase<pg8::Shape<DM, DM, DM>>(lds, wave_k, P_MRG, P_WL(W_OUT), S, E);
            pg8::gemm_small<DM, DM, DM, 0>(lds, wave_k, P_MRG, P_WL(W_OUT), TP, 8, 32, G, bx, E); }
        SEAM(P0 + 7);
        if (LIN(8)) for (int rep = 0; rep < REP(8); ++rep) { PHASE_IDS(); for (int m = gw; m < TT; m += NGW) ln_row(P_Y + (size_t)m * DM, args.in[19] + (size_t)l * DM, args.in[20] + (size_t)l * DM, P_X + (size_t)m * DM, P_XB + (size_t)m * DM, lane); }
        SEAM(P0 + 8);
        if (LIN(9)) for (int rep = 0; rep < REP(9); ++rep) { PHASE_PTRS(); pg8::Order S; S.init(TT, 2 * FF, 1, G, bx); pg8::EpiGU E{P_FFB}; pg8::gemm_phase<pg8::Shape<DM, DM, DM>>(lds, wave_k, P_XB, P_WL(W_GU), S, E); }
        SEAM(P0 + 9);
        if (LIN(10)) for (int rep = 0; rep < REP(10); ++rep) { PHASE_PTRS(); pg8::Order S; S.init(TP, DM, 1, G, bx); pg8::EpiRes E{P_Y, P_X}; pg8::gemm_phase<pg8::Shape<FF, FF, FF>>(lds, wave_k, P_FFB, P_WL(W_DN), S, E);
            pg8::gemm_small<FF, FF, FF, 0>(lds, wave_k, P_FFB, P_WL(W_DN), TP, 8, 32, G, bx, E); }
        SEAM(P0 + 10);
        if (LIN(11)) for (int rep = 0; rep < REP(11); ++rep) { PHASE_IDS(); for (int m = gw; m < TT; m += NGW) ln_row(P_Y + (size_t)m * DM, args.in[23] + (size_t)l * DM, args.in[24] + (size_t)l * DM, P_X + (size_t)m * DM, P_XB + (size_t)m * DM, lane); }
        SEAM(P0 + 11);
        if (LIN(12)) for (int rep = 0; rep < REP(12); ++rep) { PHASE_PTRS(); pg8::Order S; S.init(TP, DM, 1, G, bx); pg8::EpiPle E{P_Y, P_X, P_PP, args.in[26] + (size_t)l * DM}; pg8::gemm_phase<pg8::Shape<DM, DM, DM>>(lds, wave_k, P_XB, P_WL(W_PG), S, E);
            pg8::gemm_small<DM, DM, DM, 0>(lds, wave_k, P_XB, P_WL(W_PG), TP, 8, 32, G, bx, E); }
        SEAM(P0 + 12);
        if (LIN(13)) for (int rep = 0; rep < REP(13); ++rep) {
            PHASE_IDS();
            const float* gam = args.in[28] + (size_t)l * DM; const float* bet = args.in[29] + (size_t)l * DM;
            if (l + 1 < NLAYER) { for (int m = gw; m < TT; m += NGW) ln_row(P_Y + (size_t)m * DM, gam, bet, P_X + (size_t)m * DM, P_XB + (size_t)m * DM, lane); }
            else { for (int m = gw; m < TT; m += NGW) ln_row(P_Y + (size_t)m * DM, gam, bet, out + O_Y_P + (size_t)m * DM, nullptr, lane); }
        }
        SEAM(P0 + 13);
    }
#undef IN
#undef LIN
#undef SEAM
}

extern "C" void kernel_launch(void* const* d_in, const int* in_sizes, int n_in, void* d_out, int out_size, void* d_ws, size_t ws_size, hipStream_t stream) {
    static int grid = 0;
    if (grid == 0) {
        if (n_in != 30 || out_size != (int)O_END || ws_size < WS_END) {
            fprintf(stderr, "kernel_launch: shape mismatch n_in %d out %d ws %zu (need %zu)\n", n_in, out_size, ws_size, (size_t)WS_END); grid = -1; return; }
        int dev = 0, cus = 0, per_cu = 0;
        if (hipGetDevice(&dev) != hipSuccess || hipDeviceGetAttribute(&cus, hipDeviceAttributeMultiprocessorCount, dev) != hipSuccess) { grid = -1; return; }
        if (hipFuncSetAttribute((const void*)fwd_kernel, hipFuncAttributeMaxDynamicSharedMemorySize, LDS_BYTES) != hipSuccess) { fprintf(stderr, "kernel_launch: hipFuncSetAttribute failed\n"); grid = -1; return; }
        if (hipOccupancyMaxActiveBlocksPerMultiprocessor(&per_cu, (const void*)fwd_kernel, 512, LDS_BYTES) != hipSuccess || per_cu < 1)
            fprintf(stderr, "kernel_launch: occupancy query reports %d blocks per CU\n", per_cu);
        (void)hipGetLastError();
        grid = cus;
    }
    if (grid <= 0) return;
#ifdef DBG_ZERO_ALL
    (void)hipMemsetAsync(d_ws, 0, WS_END, stream); (void)hipMemsetAsync(d_out, 0, (size_t)O_END * 4, stream);
#else
    (void)hipMemsetAsync(d_ws, 0, CTL_BYTES, stream);
#endif
    Args a;
    memset(&a, 0, sizeof(a));
    for (int i = 0; i < 30; ++i) a.in[i] = (const float*)d_in[i];
    a.out = (float*)d_out; a.ws = (unsigned char*)d_ws;
#if MK_PER_PHASE
#ifndef DBG_PH_MAX
#define DBG_PH_MAX NPHASES
#endif
    for (int p = 0; p < DBG_PH_MAX; ++p) { a.ph_lo = p; a.ph_hi = p + 1; hipLaunchKernelGGL(fwd_kernel, dim3(grid), dim3(512), LDS_BYTES, stream, a); }
#else
    a.ph_lo = 0; a.ph_hi = NPHASES;
    hipLaunchKernelGGL(fwd_kernel, dim3(grid), dim3(512), LDS_BYTES, stream, a);
#endif
#ifdef DBG_COPY_OFF
    (void)hipMemcpyAsync(d_out, (const char*)d_ws + DBG_COPY_OFF, DBG_COPY_BYTES, hipMemcpyDeviceToDevice, stream);
#endif
    const hipError_t le = hipPeekAtLastError();
    if (le != hipSuccess) fprintf(stderr, "kernel_launch: launch failed: %s\n", hipGetErrorName(le));
}
```

```cpp
#include <hip/hip_runtime.h>
#include <cstdio>
#include <cstdint>
#include <cstring>

#ifndef MK_PER_PHASE
#define MK_PER_PHASE 0
#endif

#define LAS __attribute__((address_space(3)))
#define GAS __attribute__((address_space(1)))
typedef unsigned short bf16_t;
typedef short bf16x8 __attribute__((ext_vector_type(8)));
typedef short s16x4 __attribute__((ext_vector_type(4)));
typedef float f32x4 __attribute__((ext_vector_type(4)));
typedef float f32x16 __attribute__((ext_vector_type(16)));
typedef unsigned u32x4 __attribute__((ext_vector_type(4)));
typedef unsigned u32x2 __attribute__((ext_vector_type(2)));

constexpr int DM = 2048, TP = 8192, TS = 512, TT = 8704, SEQ = 4096, PAST = 2048, DSEQ = 32, NDB = 16, NLAYER = 2;
constexpr int NIN = 8448;
constexpr int FF = 5632, PLE = 256, SKEYS = PAST + DSEQ;
constexpr float ALPHA = 1.41421356237309515f;
constexpr float LN_EPS = 1e-5f, RMS_EPS = 1e-6f;
constexpr float LOG2E = 1.4426950408889634f, LN2 = 0.6931471805599453f;
constexpr float MLA_C = 0.07216878364870322f * LOG2E;
constexpr float SB_SCALE = 0.08838834764831845f;

constexpr size_t O_Y_P = 0, O_Y_S = 16777216, O_LAT_P = 17825792, O_KR_P = 26214400, O_K_P = 27262976, O_V_P = 44040192,
                 O_LAT_S = 60817408, O_KR_S = 61341696, O_K_S = 61407232, O_V_S = 62455808, O_END = 63504384;

constexpr size_t al256(size_t x) { return (x + 255) & ~(size_t)255; }
constexpr size_t WS_CTL = 0, CTL_BYTES = 1u << 20;
constexpr size_t W_IN = 0, W_QB = W_IN + (size_t)NIN * DM * 2, W_KVBT = W_QB + (size_t)3072 * 512 * 2, W_KVBN = W_KVBT + (size_t)4096 * 512 * 2,
                 W_UVBD = W_KVBN + (size_t)512 * 4096 * 2, W_BA = W_UVBD + (size_t)2048 * 1024 * 2, W_BB = W_BA + (size_t)DM * DM * 2,
                 W_OUT = W_BB + (size_t)DM * 1024 * 2, W_GU = W_OUT + (size_t)DM * DM * 2, W_DN = W_GU + (size_t)2 * FF * DM * 2,
                 W_PG = W_DN + (size_t)DM * FF * 2, W_PP = W_PG + (size_t)DM * DM * 2, W_LAYER = W_PP + (size_t)DM * PLE * 2;
constexpr size_t WS_W = CTL_BYTES;
constexpr size_t WS_LATS = WS_W + NLAYER * W_LAYER;
constexpr size_t WS_KRS = WS_LATS + (size_t)NLAYER * NDB * SKEYS * 512 * 2;
constexpr size_t WS_PB = WS_KRS + (size_t)NLAYER * NDB * SKEYS * 64 * 2;
constexpr size_t WS_X = WS_PB + (size_t)NLAYER * TT * PLE * 2;
constexpr size_t WS_Y = WS_X + (size_t)TT * DM * 4;
constexpr size_t WS_XB = WS_Y + (size_t)TT * DM * 4;
constexpr size_t WS_QA = WS_XB + (size_t)TT * DM * 2;
constexpr size_t WS_KVA = WS_QA + (size_t)TT * 512 * 4;
constexpr size_t WS_KRRAW = WS_KVA + (size_t)TT * 512 * 4;
constexpr size_t WS_SBQ = WS_KRRAW + (size_t)TT * 64 * 4;
constexpr size_t WS_GATE = WS_SBQ + (size_t)TT * 1024 * 2;
constexpr size_t WS_QN = WS_GATE + (size_t)TT * 4096 * 2;
constexpr size_t WS_LATB = WS_QN + (size_t)TT * 512 * 2;
constexpr size_t WS_KRB = WS_LATB + (size_t)TP * 512 * 2;
constexpr size_t WS_Q = WS_KRB + (size_t)TP * 64 * 2;
constexpr size_t WS_KVX = WS_Q + (size_t)TT * 3072 * 2 + 4096;
constexpr size_t WS_QLAT = WS_KVX + (size_t)TP * 4096 * 2;
constexpr size_t WS_CTX = WS_QLAT + (size_t)TS * 8192 * 2;
constexpr size_t WS_OA = WS_CTX + (size_t)TS * 8192 * 2;
constexpr size_t WS_OB = WS_OA + (size_t)TT * DM * 2;
constexpr size_t WS_T1 = WS_OB + (size_t)TT * 1024 * 2;
constexpr size_t WS_MRG = WS_T1 + (size_t)TT * DM * 4;
constexpr size_t WS_FFB = WS_MRG + (size_t)TT * DM * 2;
constexpr size_t WS_PP = WS_FFB + (size_t)TT * FF * 2;
constexpr size_t WS_ROPE = WS_PP + (size_t)TT * DM * 4;
constexpr size_t WS_END = WS_ROPE + (size_t)2 * SEQ * 32 * 4;

constexpr int CW_BAR = 4096, CW_Q = 16384;

constexpr int LDS_STAGE = 131072, LDS_MISC = LDS_STAGE, LDS_BYTES = 147456;

typedef __bf16 bf16x2_t __attribute__((ext_vector_type(2)));
typedef float f32x2_t __attribute__((ext_vector_type(2)));
__device__ __forceinline__ unsigned cvt_pk(float lo, float hi) { const f32x2_t v = {lo, hi}; const bf16x2_t b = __builtin_convertvector(v, bf16x2_t); return __builtin_bit_cast(unsigned, b); }
__device__ __forceinline__ float bflo(unsigned w) { return __uint_as_float(w << 16); }
__device__ __forceinline__ float bfhi(unsigned w) { return __uint_as_float(w & 0xffff0000u); }
__device__ __forceinline__ void st_bf16x8(bf16_t* p, f32x4 a, f32x4 b) { u32x4 w; w.x = cvt_pk(a[0], a[1]); w.y = cvt_pk(a[2], a[3]); w.z = cvt_pk(b[0], b[1]); w.w = cvt_pk(b[2], b[3]); *(u32x4*)p = w; }
__device__ __forceinline__ void st_f32x8(float* p, f32x4 a, f32x4 b) { *(f32x4*)p = a; *(f32x4*)(p + 4) = b; }
__device__ __forceinline__ void ld_bf16x8(const bf16_t* p, f32x4& a, f32x4& b) { const u32x4 w = *(const u32x4*)p; a = (f32x4){bflo(w.x), bfhi(w.x), bflo(w.y), bfhi(w.y)}; b = (f32x4){bflo(w.z), bfhi(w.z), bflo(w.w), bfhi(w.w)}; }
__device__ __forceinline__ float sigmoidf_(float x) { return __builtin_amdgcn_rcpf(1.f + __builtin_amdgcn_exp2f(-x * LOG2E)); }
__device__ __forceinline__ float wave_sum(float v) {
#pragma unroll
    for (int o = 1; o < 64; o <<= 1) v += __shfl_xor(v, o);
    return v;
}
__device__ __forceinline__ int tok_pos(int row) { return row < TP ? (row & (SEQ - 1)) : PAST + ((row - TP) & (DSEQ - 1)); }
__device__ __forceinline__ void rope_cs_slow(int pos, int i, float& c, float& s) {
    const float invf = __builtin_amdgcn_exp2f(-(float)i * 0.41524101186092029f);
    const float ang = (float)pos * invf;
    double a = (double)ang * 0.15915494309189535; a -= __builtin_floor(a);
    const float f = (float)a;
    c = __builtin_amdgcn_cosf(f); s = __builtin_amdgcn_sinf(f);
}

__device__ __forceinline__ int phase_tid(int wave_k) { int ln; asm volatile("v_mbcnt_lo_u32_b32 %0, -1, 0\n\tv_mbcnt_hi_u32_b32 %0, -1, %0" : "=v"(ln)); return (wave_k << 6) | ln; }
#define XB_TMO      128
#define XB_XCNT(j)  (256  + 64 * (j))
#define XB_XSUB(j)  (1280 + 64 * (j))
#define XB_XGEN(j)  (2304 + 64 * (j))
#define XB_TOP      3328
#define XB_TOPGEN   3392
#define XCD_BAR_WORDS 3456
#define XB_SPIN_CAP (1u << 22)
__device__ __forceinline__ unsigned xb_ld(unsigned* p)              { return __hip_atomic_load(p, __ATOMIC_RELAXED, __HIP_MEMORY_SCOPE_AGENT); }
__device__ __forceinline__ unsigned xb_add(unsigned* p, unsigned v) { return __hip_atomic_fetch_add(p, v, __ATOMIC_RELAXED, __HIP_MEMORY_SCOPE_AGENT); }
__device__ __forceinline__ unsigned xb_xcc_id() { return (unsigned)__builtin_amdgcn_s_getreg((3 << 11) | 20) & 0xFu; }
#define XB_SPIN(cond, bar) do { unsigned _sp = 0; while (cond) { __builtin_amdgcn_s_sleep(1); \
    if ((++_sp & 255u) == 0u) { if (xb_ld(&(bar)[XB_TMO])) break; if (_sp > XB_SPIN_CAP) { atomicAdd(&(bar)[XB_TMO], 1u); break; } } } } while (0)
struct XcdBarrier { unsigned* bar; unsigned x; volatile LAS unsigned* st; };
__device__ __forceinline__ XcdBarrier xcd_barrier_post(unsigned* bar, volatile LAS unsigned* st) {
    XcdBarrier b; b.bar = bar; b.x = xb_xcc_id(); b.st = st;
    if (threadIdx.x == 0) (void)xb_add(&bar[XB_XCNT(b.x)], 1u);
    return b;
}
__device__ __forceinline__ void xcd_barrier_complete(unsigned* bar, unsigned x, unsigned& nloc, unsigned& nx) {
    const unsigned G = gridDim.x * gridDim.y * gridDim.z;
    unsigned sum, cnt, mine, sp = 0u;
    for (;;) {
        sum = 0u; cnt = 0u; mine = 0u;
#pragma unroll
        for (unsigned j = 0; j < 16; ++j) { const unsigned c = xb_ld(&bar[XB_XCNT(j)]); sum += c; cnt += (c > 0u) ? 1u : 0u; mine = (j == x) ? c : mine; }
        if (sum == G) break;
        __builtin_amdgcn_s_sleep(1);
        if ((++sp & 255u) == 0u) { if (xb_ld(&bar[XB_TMO])) break; if (sp > XB_SPIN_CAP) { atomicAdd(&bar[XB_TMO], 1u); break; } }
    }
    nloc = mine > 0u ? mine : 1u; nx = cnt > 0u ? cnt : 1u;
}
__device__ __forceinline__ void xcd_barrier(const XcdBarrier& b, int wave_k) {
    asm volatile("s_waitcnt vmcnt(0)" ::: "memory");
    __syncthreads();
    if (phase_tid(wave_k) == 0) {
        unsigned* bar = b.bar;
        __builtin_amdgcn_s_waitcnt(0);
        unsigned nloc = b.st[0], nx = b.st[1];
        if (nloc == 0u) { xcd_barrier_complete(bar, b.x, nloc, nx); b.st[0] = nloc; b.st[1] = nx; }
        const unsigned old = xb_add(&bar[XB_XSUB(b.x)], 1u);
        const unsigned gen = old / nloc;
        if (old + 1u == (gen + 1u) * nloc) {
            __builtin_amdgcn_fence(__ATOMIC_RELEASE, "agent");
            asm volatile("s_waitcnt vmcnt(0)" ::: "memory");
            const unsigned og = xb_add(&bar[XB_TOP], 1u);
            const unsigned tg = og / nx;
            if (og + 1u == (tg + 1u) * nx) xb_add(&bar[XB_TOPGEN], 1u);
            else XB_SPIN(xb_ld(&bar[XB_TOPGEN]) == tg, bar);
            __builtin_amdgcn_fence(__ATOMIC_ACQUIRE, "agent");
            xb_add(&bar[XB_XGEN(b.x)], 1u);
            asm volatile("s_waitcnt vmcnt(0)" ::: "memory");
        } else {
            XB_SPIN(xb_ld(&bar[XB_XGEN(b.x)]) == gen, bar);
            __builtin_amdgcn_fence(__ATOMIC_ACQUIRE, "agent");
            asm volatile("s_waitcnt vmcnt(0)" ::: "memory");
        }
    }
    __syncthreads();
}

namespace pg8 {
constexpr int BM = 256, BK = 64, HALF = 128, HTB = HALF * BK * 2, NXCD = 8, WGM = 8;
__host__ __device__ __forceinline__ int lds_byte(int r, int c) { const int st = (r >> 4) * 2 + (c >> 5), rr = r & 15, cc = c & 31, ob = rr * 64 + cc * 2; return st * 1024 + (ob ^ (((ob >> 9) & 1) << 5)); }
__host__ __device__ __forceinline__ void stage_rc(int b, int& R, int& C) { const int st = b / 1024, sb = b % 1024, swz = sb ^ (((sb >> 9) & 1) << 5); R = (st >> 1) * 16 + swz / 64; C = (st & 1) * 32 + (swz % 64) / 2; }
__host__ __device__ __forceinline__ int perm32(int rho) { const int n = rho >> 4, i = rho & 15; return 8 * (i >> 2) + 4 * n + (i & 3); }

struct Unit { int pm, pn, z; };
template <int K_, int LDA_, int LDB_, int SAZ_ = 0, int SBZ_ = 0, int APN_ = 0> struct Shape { static constexpr int K = K_, lda = LDA_, ldb = LDB_, sAz = SAZ_, sBz = SBZ_, a_pn = APN_; };

struct Order {
    int nM, nN, per, total, G, c, mode;
    __device__ void init(int M, int N, int nz, int G_, int c_, int mode_ = 0) { nM = M / BM; nN = N / BM; per = nM * nN; total = per * nz; G = G_; c = c_; mode = mode_; }
    __device__ bool next(int i, Unit& u) const {
        const long L = (long)i * G + c; if (L >= total) return false;
        const int z = (int)(L / per); int wgid = (int)(L % per);
        { const int q = per / NXCD, r = per % NXCD, xcd = wgid % NXCD, off = wgid / NXCD; wgid = (xcd < r ? xcd * (q + 1) : r * (q + 1) + (xcd - r) * q) + off; }
        const int nig = WGM * nN, gid = wgid / nig, fm = gid * WGM, gsz = (nM - fm) < WGM ? (nM - fm) : WGM;
        u.pm = fm + ((wgid % nig) % gsz); int pn = (wgid % nig) / gsz;
        if (mode == 1) pn = pn < 4 ? pn : (pn == 4 ? 32 : pn - 1); else if (mode == 2) pn += 29;
        u.pn = pn; u.z = z; return true;
    }
};

#define EPI_LOOP(...) \
    _Pragma("unroll") for (int ai = 0; ai < 2; ++ai) _Pragma("unroll") for (int m = 0; m < 4; ++m) { const int row = u.pm * 256 + ai * 128 + wr * 64 + m * 16 + fr; \
    _Pragma("unroll") for (int bj = 0; bj < 2; ++bj) { const int col = u.pn * 256 + bj * 128 + wc * 32 + fq * 8; f32x4 v0 = acc[ai][bj][m][0], v1 = acc[ai][bj][m][1]; __VA_ARGS__ } asm volatile("" ::: "memory"); }

template <class g, class Epi>
__device__ __forceinline__ void gemm_phase(LAS unsigned char* lds, int wave_k, const bf16_t* gA, const bf16_t* gBt, const Order& S, const Epi& E) {
    const int tid = phase_tid(wave_k);
    const int wid = __builtin_amdgcn_readfirstlane(tid >> 6), lane = tid & 63, wr = wid >> 2, wc = wid & 3, fr = lane & 15, fq = lane >> 4;
    constexpr int K = g::K, nt = K / BK;
    unsigned voffA[2], voffB[2];
#pragma unroll
    for (int i = 0; i < 2; ++i) { int R, C; stage_rc(tid * 16 + i * 8192, R, C); const int Rb = (R & ~31) + perm32(R & 31);
        voffA[i] = (unsigned)(R * g::lda + C) * 2u; voffB[i] = (unsigned)(Rb * g::ldb + C) * 2u; }
    const size_t kstep = (size_t)(BK * 2);
    constexpr size_t hstepA = (size_t)HALF * g::lda * 2, hstepB = (size_t)HALF * g::ldb * 2;
    constexpr size_t tstepA = 2 * hstepA, tstepB = 2 * hstepB;
    const unsigned ldsw = (unsigned)wid * 1024u;
    const int aoff = lds_byte(wr * 64 + fr, fq * 8), boff = lds_byte(wc * 32 + fr, fq * 8);
#define PG8_UA(u_) ((const char*)gA + ((size_t)(u_).z * g::sAz + (size_t)(u_).pn * (size_t)g::a_pn) * 2 + (size_t)(u_).pm * tstepA)
#define PG8_UB(u_) ((const char*)gBt + (size_t)(u_).z * g::sBz * 2 + (size_t)(u_).pn * tstepB)
#define PG8_SA(b, h) (((b) * 2 + (h)) * HTB)
#define PG8_SB(b, h) ((4 + (b) * 2 + (h)) * HTB)
#define PG8_STAGE(bufoff, gbase, voff) do { _Pragma("unroll") for (int _i = 0; _i < 2; ++_i) \
        __builtin_amdgcn_global_load_lds((const unsigned*)((const char*)(gbase) + (voff)[_i]), (LAS unsigned*)(lds + (bufoff) + ldsw + _i * 8192), 16, 0, 0); } while (0)
#define PG8_LDA(dst, b, h) do { _Pragma("unroll") for (int m = 0; m < 4; ++m) _Pragma("unroll") for (int k = 0; k < 2; ++k) dst[m][k] = *(const LAS bf16x8*)(lds + PG8_SA(b, h) + aoff + m * 2048 + k * 1024); } while (0)
#define PG8_LDB(dst, b, h) do { _Pragma("unroll") for (int n = 0; n < 2; ++n) _Pragma("unroll") for (int k = 0; k < 2; ++k) dst[n][k] = *(const LAS bf16x8*)(lds + PG8_SB(b, h) + boff + n * 2048 + k * 1024); } while (0)
#define PG8_MMA(ai, bj, At, Bt) do { __builtin_amdgcn_s_setprio(1); _Pragma("unroll") for (int m = 0; m < 4; ++m) _Pragma("unroll") for (int n = 0; n < 2; ++n) _Pragma("unroll") for (int k = 0; k < 2; ++k) \
        acc[ai][bj][m][n] = __builtin_amdgcn_mfma_f32_16x16x32_bf16(Bt[n][k], At[m][k], acc[ai][bj][m][n], 0, 0, 0); __builtin_amdgcn_s_setprio(0); } while (0)
#define PG8_WAIT_V(n) asm volatile("s_waitcnt vmcnt(" #n ")" ::: "memory")
#define PG8_WAIT_L(n) asm volatile("s_waitcnt lgkmcnt(" #n ")" ::: "memory")
#define PG8_BAR __builtin_amdgcn_s_barrier()
#define PG8_SCHED __builtin_amdgcn_sched_barrier(0)
    Unit cur, nxt; int ui = 0;
    if (!S.next(0, cur)) return;
    f32x4 acc[2][2][4][2];
#pragma unroll
    for (int a = 0; a < 2; ++a)
#pragma unroll
        for (int b = 0; b < 2; ++b)
#pragma unroll
            for (int m = 0; m < 4; ++m)
#pragma unroll
                for (int n = 0; n < 2; ++n) acc[a][b][m][n] = (f32x4){0.f, 0.f, 0.f, 0.f};
    bf16x8 At[4][2], B0[2][2], B1[2][2];
    const char* cA = PG8_UA(cur); const char* cB = PG8_UB(cur);
    PG8_STAGE(PG8_SB(0, 0), cB, voffB); PG8_STAGE(PG8_SB(0, 1), cB + hstepB, voffB); PG8_STAGE(PG8_SA(0, 0), cA, voffA); PG8_STAGE(PG8_SA(0, 1), cA + hstepA, voffA);
    if (wr == 1) PG8_BAR;
    PG8_WAIT_V(2); PG8_BAR;
    PG8_STAGE(PG8_SB(1, 0), cB + kstep, voffB); PG8_STAGE(PG8_SA(1, 0), cA + kstep, voffA); PG8_STAGE(PG8_SB(1, 1), cB + hstepB + kstep, voffB);
    PG8_WAIT_V(6); PG8_BAR;
    for (;;) {
        const bool has_next = S.next(ui + 1, nxt);
        const char* nA = has_next ? PG8_UA(nxt) : cA; const char* nB = has_next ? PG8_UB(nxt) : cB;
#pragma unroll 1
        for (int t = 0; t < nt; t += 2) {
            const bool last = (t == nt - 2);
            const char* a1 = cA + (size_t)(t + 1) * kstep;
            const char* a2 = last ? nA : cA + (size_t)(t + 2) * kstep; const char* b2 = last ? nB : cB + (size_t)(t + 2) * kstep;
            const char* a3 = a2 + kstep; const char* b3 = b2 + kstep;
            PG8_LDB(B0, 0, 0); PG8_LDB(B1, 0, 1); PG8_SCHED; PG8_LDA(At, 0, 0); PG8_STAGE(PG8_SA(1, 1), a1 + hstepA, voffA);
            PG8_WAIT_V(8); PG8_WAIT_L(0); PG8_BAR; PG8_MMA(0, 0, At, B0); PG8_MMA(0, 1, At, B1); PG8_BAR; PG8_SCHED;
            PG8_LDA(At, 0, 1); PG8_STAGE(PG8_SB(0, 0), b2, voffB); PG8_STAGE(PG8_SB(0, 1), b2 + hstepB, voffB); PG8_STAGE(PG8_SA(0, 0), a2, voffA);
            PG8_WAIT_V(8); PG8_WAIT_L(0); PG8_BAR; PG8_MMA(1, 0, At, B0); PG8_MMA(1, 1, At, B1); PG8_BAR; PG8_SCHED;
            PG8_LDB(B0, 1, 0); PG8_LDB(B1, 1, 1); PG8_SCHED; PG8_LDA(At, 1, 0); PG8_STAGE(PG8_SA(0, 1), a2 + hstepA, voffA);
            PG8_WAIT_V(8); PG8_WAIT_L(0); PG8_BAR; PG8_MMA(0, 0, At, B0); PG8_MMA(0, 1, At, B1); PG8_BAR; PG8_SCHED;
            PG8_LDA(At, 1, 1); PG8_STAGE(PG8_SB(1, 0), b3, voffB); PG8_STAGE(PG8_SB(1, 1), b3 + hstepB, voffB); PG8_STAGE(PG8_SA(1, 0), a3, voffA);
            PG8_WAIT_V(8); PG8_WAIT_L(0); PG8_BAR; PG8_MMA(1, 0, At, B0); PG8_MMA(1, 1, At, B1); PG8_BAR; PG8_SCHED;
        }
        if (wr == 0) PG8_BAR;
        { const Unit& u = cur; EPI_LOOP( E.apply(row, col, u.z, v0, v1); ) }
        if (!has_next) break;
#pragma unroll
        for (int a = 0; a < 2; ++a)
#pragma unroll
            for (int b = 0; b < 2; ++b)
#pragma unroll
                for (int m = 0; m < 4; ++m)
#pragma unroll
                    for (int n = 0; n < 2; ++n) acc[a][b][m][n] = (f32x4){0.f, 0.f, 0.f, 0.f};
        cur = nxt; cA = nA; cB = nB; ++ui;
        if (wr == 1) PG8_BAR;
    }
    PG8_WAIT_V(0);
    PG8_BAR;
#undef PG8_UA
#undef PG8_UB
#undef PG8_SA
#undef PG8_SB
#undef PG8_STAGE
#undef PG8_LDA
#undef PG8_LDB
#undef PG8_MMA
#undef PG8_WAIT_V
#undef PG8_WAIT_L
#undef PG8_BAR
#undef PG8_SCHED
}

struct EpiIn {
    float* QA; float* KVA; float* KRRAW; bf16_t* SBQ; bf16_t* GATE; float* k_p; float* k_s; float* v_p; float* v_s; const float* bgate;
    __device__ __forceinline__ void apply(int row, int col, int z, f32x4 v0, f32x4 v1) const {
        const int pn = col >> 8;
        if (pn < 2) st_f32x8(QA + (unsigned)(row * 512 + col), v0, v1);
        else if (pn < 4) st_f32x8(KVA + (unsigned)(row * 512 + col - 512), v0, v1);
        else if (pn < 8) st_bf16x8(SBQ + (unsigned)(row * 1024 + col - 1024), v0, v1);
        else if (pn < 12) { float* d = row < TP ? k_p : k_s - (size_t)TP * 1024; st_f32x8(d + (unsigned)(row * 1024 + col - 2048), v0, v1); }
        else if (pn < 16) { float* d = row < TP ? v_p : v_s - (size_t)TP * 1024; st_f32x8(d + (unsigned)(row * 1024 + col - 3072), v0, v1); }
        else if (pn < 32) { const unsigned c = (unsigned)(col - 4096); const f32x4 b0 = *(const f32x4*)(bgate + c), b1 = *(const f32x4*)(bgate + c + 4); f32x4 g0, g1;
#pragma unroll
            for (int j = 0; j < 4; ++j) { g0[j] = sigmoidf_(v0[j] + b0[j]); g1[j] = sigmoidf_(v1[j] + b1[j]); }
            st_bf16x8(GATE + ((unsigned)(row * 4096) + c), g0, g1); }
        else { const int c = col - 8192; if (c < 64) st_f32x8(KRRAW + (unsigned)(row * 64 + c), v0, v1); }
    }
};
struct EpiQ {
    bf16_t* Q; const float* ROPE;
    __device__ __forceinline__ void apply(int row, int col, int z, f32x4 v0, f32x4 v1) const {
        const int h = col / 192, w = col - h * 192;
        if (w >= 128) { const int pos = tok_pos(row), i0 = (w - 128) >> 1; const f32x4 c = *(const f32x4*)(ROPE + pos * 32 + i0), s = *(const f32x4*)(ROPE + SEQ * 32 + pos * 32 + i0);
            { const float a = v0[0], b = v0[1]; v0[0] = a * c[0] - b * s[0]; v0[1] = b * c[0] + a * s[0]; }
            { const float a = v0[2], b = v0[3]; v0[2] = a * c[1] - b * s[1]; v0[3] = b * c[1] + a * s[1]; }
            { const float a = v1[0], b = v1[1]; v1[0] = a * c[2] - b * s[2]; v1[1] = b * c[2] + a * s[2]; }
            { const float a = v1[2], b = v1[3]; v1[2] = a * c[3] - b * s[3]; v1[3] = b * c[3] + a * s[3]; } }
        st_bf16x8(Q + (unsigned)(row * 3072 + col), v0, v1);
    }
};
struct EpiBf16 {
    bf16_t* O; int ldc; int zoff;
    __device__ __forceinline__ void apply(int row, int col, int z, f32x4 v0, f32x4 v1) const { st_bf16x8(O + (unsigned)(row * ldc + z * zoff + col), v0, v1); }
};
struct EpiF32 {
    float* O; int ldc;
    __device__ __forceinline__ void apply(int row, int col, int z, f32x4 v0, f32x4 v1) const { st_f32x8(O + (unsigned)(row * ldc + col), v0, v1); }
};
struct EpiBrB {
    float* T1; const bf16_t* GATE;
    __device__ __forceinline__ void apply(int row, int col, int z, f32x4 v0, f32x4 v1) const {
        f32x4 g0, g1; ld_bf16x8(GATE + (unsigned)(row * 4096 + 2048 + col), g0, g1); st_f32x8(T1 + (unsigned)(row * DM + col), v0 * g0, v1 * g1); }
};
struct EpiBrA {
    bf16_t* MRG; const float* T1; const bf16_t* GATE;
    __device__ __forceinline__ void apply(int row, int col, int z, f32x4 v0, f32x4 v1) const {
        f32x4 g0, g1; ld_bf16x8(GATE + (unsigned)(row * 4096 + col), g0, g1); const float* t = T1 + (unsigned)(row * DM + col);
        const f32x4 t0 = *(const f32x4*)t, t1 = *(const f32x4*)(t + 4); st_bf16x8(MRG + (unsigned)(row * DM + col), t0 + v0 * g0, t1 + v1 * g1); }
};
struct EpiRes {
    float* Y; const float* X;
    __device__ __forceinline__ void apply(int row, int col, int z, f32x4 v0, f32x4 v1) const {
        const float* x = X + (unsigned)(row * DM + col); const f32x4 x0 = *(const f32x4*)x, x1 = *(const f32x4*)(x + 4);
        st_f32x8(Y + (unsigned)(row * DM + col), x0 * ALPHA + v0, x1 * ALPHA + v1); }
};
struct EpiGU {
    bf16_t* FFB;
    __device__ __forceinline__ void apply(int row, int col, int z, f32x4 v0, f32x4 v1) const {
        f32x4 r;
#pragma unroll
        for (int j = 0; j < 4; ++j) r[j] = v0[j] * sigmoidf_(v0[j]) * v1[j];
        u32x2 w; w.x = cvt_pk(r[0], r[1]); w.y = cvt_pk(r[2], r[3]); *(u32x2*)(FFB + (unsigned)(row * FF + (col >> 1))) = w; }
};
struct EpiPle {
    float* Y; const float* X; const float* PP; const float* bias;
    __device__ __forceinline__ void apply(int row, int col, int z, f32x4 v0, f32x4 v1) const {
        const unsigned o = (unsigned)(row * DM + col); const f32x4 x0 = *(const f32x4*)(X + o), x1 = *(const f32x4*)(X + o + 4), p0 = *(const f32x4*)(PP + o), p1 = *(const f32x4*)(PP + o + 4);
        const f32x4 b0 = *(const f32x4*)(bias + (unsigned)col), b1 = *(const f32x4*)(bias + (unsigned)col + 4); f32x4 r0, r1;
#pragma unroll
        for (int j = 0; j < 4; ++j) { r0[j] = x0[j] * ALPHA + sigmoidf_(v0[j] + b0[j]) * p0[j]; r1[j] = x1[j] * ALPHA + sigmoidf_(v1[j] + b1[j]) * p1[j]; }
        st_f32x8(Y + o, r0, r1); }
};

template <int K, int LDA, int LDB, int APN, class Epi>
__device__ __forceinline__ void gemm_small(LAS unsigned char* lds, int wave_k, const bf16_t* gA, const bf16_t* gBt, int row0, int n_rt, int n_ct, int G, int c, const Epi& E) {
    const int tid = phase_tid(wave_k);
    const int wid = __builtin_amdgcn_readfirstlane(tid >> 6), lane = tid & 63, wc = wid & 1, wm = wid >> 1, fr = lane & 15, fq = lane >> 4;
    constexpr int nt = K / 64;
    int R, C; stage_rc(tid * 16, R, C);
    const int Rb = (R & ~31) + perm32(R & 31);
    const unsigned voffA = (unsigned)(R * LDA + C) * 2u, voffB = (unsigned)(Rb * LDB + C) * 2u;
    const unsigned ldsw = (unsigned)wid * 1024u;
    const int aoff = lds_byte(wm * 16 + fr, fq * 8), boff = lds_byte(wc * 32 + fr, fq * 8);
#define SM_STAGE(slot, pa, pb) do { \
        __builtin_amdgcn_global_load_lds((const unsigned*)((pa) + voffA), (LAS unsigned*)(lds + (slot) * 16384 + ldsw), 16, 0, 0); \
        __builtin_amdgcn_global_load_lds((const unsigned*)((pb) + voffB), (LAS unsigned*)(lds + (slot) * 16384 + 8192 + ldsw), 16, 0, 0); } while (0)
    for (int u = c; u < n_rt * n_ct; u += G) {
        const int xcd = u & 7, idx = u >> 3, rt = idx % n_rt, ct = xcd * (n_ct >> 3) + idx / n_rt;
        const char* pa = (const char*)gA + ((size_t)(row0 + rt * 64) * LDA + (size_t)(ct >> 2) * APN) * 2;
        const char* pb = (const char*)gBt + (size_t)(ct * 64) * LDB * 2;
        f32x4 acc0 = (f32x4){0.f, 0.f, 0.f, 0.f}, acc1 = acc0;
        SM_STAGE(0, pa, pb); SM_STAGE(1, pa + 128, pb + 128); SM_STAGE(2, pa + 256, pb + 256);
#pragma unroll 1
        for (int t = 0; t < nt; ++t) {
            asm volatile("s_waitcnt vmcnt(4)" ::: "memory");
            __builtin_amdgcn_s_barrier();
            { const int tn = (t + 3 < nt) ? t + 3 : nt - 1;
              SM_STAGE((t + 3) & 3, pa + (size_t)tn * 128, pb + (size_t)tn * 128); }
            const LAS unsigned char* sl = lds + (t & 3) * 16384;
            const bf16x8 a0 = *(const LAS bf16x8*)(sl + aoff), a1 = *(const LAS bf16x8*)(sl + aoff + 1024);
            const bf16x8 b00 = *(const LAS bf16x8*)(sl + 8192 + boff), b01 = *(const LAS bf16x8*)(sl + 8192 + boff + 1024);
            const bf16x8 b10 = *(const LAS bf16x8*)(sl + 8192 + boff + 2048), b11 = *(const LAS bf16x8*)(sl + 8192 + boff + 2048 + 1024);
            acc0 = __builtin_amdgcn_mfma_f32_16x16x32_bf16(b00, a0, acc0, 0, 0, 0); acc1 = __builtin_amdgcn_mfma_f32_16x16x32_bf16(b10, a0, acc1, 0, 0, 0);
            acc0 = __builtin_amdgcn_mfma_f32_16x16x32_bf16(b01, a1, acc0, 0, 0, 0); acc1 = __builtin_amdgcn_mfma_f32_16x16x32_bf16(b11, a1, acc1, 0, 0, 0);
        }
        asm volatile("s_waitcnt vmcnt(0)" ::: "memory");
        __builtin_amdgcn_s_barrier();
        E.apply(row0 + rt * 64 + wm * 16 + fr, ct * 64 + wc * 32 + fq * 8, 0, acc0, acc1);
    }
#undef SM_STAGE
}
}

template <int OFF> __device__ __forceinline__ s16x4 tr_read(unsigned addr) {
    s16x4 r; asm volatile("ds_read_b64_tr_b16 %0, %1 offset:%2" : "=&v"(r) : "v"(addr), "i"(OFF) : "memory"); return r;
}
#define PKTR(L, H) ((bf16x8){L[0], L[1], L[2], L[3], H[0], H[1], H[2], H[3]})
__device__ __forceinline__ bf16x8 pack8(float a0, float a1, float a2, float a3, float a4, float a5, float a6, float a7) {
    u32x4 w; w.x = cvt_pk(a0, a1); w.y = cvt_pk(a2, a3); w.z = cvt_pk(a4, a5); w.w = cvt_pk(a6, a7); return __builtin_bit_cast(bf16x8, w);
}
constexpr int AV_ROW = 320;
template <int DBLK> __device__ __forceinline__ void pv_block(f32x16& od, unsigned vaddr, const bf16x8 (&pb)[4]) {
    const s16x4 l0 = tr_read<(0 * 16 + 0) * AV_ROW + DBLK * 64>(vaddr), h0 = tr_read<(0 * 16 + 8) * AV_ROW + DBLK * 64>(vaddr);
    const s16x4 l1 = tr_read<(1 * 16 + 0) * AV_ROW + DBLK * 64>(vaddr), h1 = tr_read<(1 * 16 + 8) * AV_ROW + DBLK * 64>(vaddr);
    const s16x4 l2 = tr_read<(2 * 16 + 0) * AV_ROW + DBLK * 64>(vaddr), h2 = tr_read<(2 * 16 + 8) * AV_ROW + DBLK * 64>(vaddr);
    const s16x4 l3 = tr_read<(3 * 16 + 0) * AV_ROW + DBLK * 64>(vaddr), h3 = tr_read<(3 * 16 + 8) * AV_ROW + DBLK * 64>(vaddr);
    asm volatile("s_waitcnt lgkmcnt(0)" ::: "memory"); __builtin_amdgcn_sched_barrier(0);
    od = __builtin_amdgcn_mfma_f32_32x32x16_bf16(PKTR(l0, h0), pb[0], od, 0, 0, 0);
    od = __builtin_amdgcn_mfma_f32_32x32x16_bf16(PKTR(l1, h1), pb[1], od, 0, 0, 0);
    od = __builtin_amdgcn_mfma_f32_32x32x16_bf16(PKTR(l2, h2), pb[2], od, 0, 0, 0);
    od = __builtin_amdgcn_mfma_f32_32x32x16_bf16(PKTR(l3, h3), pb[3], od, 0, 0, 0);
}

constexpr int AK_ROW = 400, AK_TILE = 64 * AK_ROW, AV_TILE = 64 * AV_ROW;
__device__ __forceinline__ void attn_mla_prompt(LAS unsigned char* lds, int wave_k, const bf16_t* __restrict__ Q, const bf16_t* __restrict__ KVX, const bf16_t* __restrict__ KRB,
                                                bf16_t* __restrict__ OA, int b, int h, int qb) {
    const int tid = phase_tid(wave_k);
    const int wid = __builtin_amdgcn_readfirstlane(tid >> 6), lane = tid & 63, r32 = lane & 31, hi = lane >> 5;
    const int NT = 4 * qb + 4, my_last = 4 * qb + (wid >> 1);
    const int tok = b * SEQ + qb * 256 + wid * 32 + r32;
    bf16x8 qr[12];
    { const bf16_t* qp = Q + (size_t)tok * 3072 + h * 192 + hi * 8;
#pragma unroll
      for (int s = 0; s < 12; ++s) qr[s] = *(const bf16x8*)(qp + 16 * s); }
    f32x16 o[4];
#pragma unroll
    for (int d = 0; d < 4; ++d)
#pragma unroll
        for (int r = 0; r < 16; ++r) o[d][r] = 0.f;
    float m_run = -INFINITY, l_run = 0.f;
    const bf16_t* kbase = KVX + (size_t)(b * SEQ) * 4096 + h * 256;
    const bf16_t* rbase = KRB + (size_t)(b * SEQ) * 64;
    const int r0 = tid >> 4, c0 = tid & 15, rr = tid >> 3, rc = tid & 7;
    u32x4 sk0, sk1, sr, sv0, sv1;
#define A_LOAD(kt) do { const bf16_t* kp = kbase + (size_t)((kt) * 64 + r0) * 4096 + c0 * 8; \
        sk0 = *(const u32x4*)kp; sk1 = *(const u32x4*)(kp + (size_t)32 * 4096); sv0 = *(const u32x4*)(kp + 128); sv1 = *(const u32x4*)(kp + (size_t)32 * 4096 + 128); \
        sr = *(const u32x4*)(rbase + (size_t)((kt) * 64 + rr) * 64 + rc * 8); } while (0)
#define A_WRITE(buf) do { LAS unsigned char* Kb = lds + (buf) * AK_TILE; LAS unsigned char* Vb = lds + 2 * AK_TILE + (buf) * AV_TILE; \
        *(LAS u32x4*)(Kb + r0 * AK_ROW + c0 * 16) = sk0; *(LAS u32x4*)(Kb + (r0 + 32) * AK_ROW + c0 * 16) = sk1; *(LAS u32x4*)(Kb + rr * AK_ROW + 256 + rc * 16) = sr; \
        *(LAS u32x4*)(Vb + r0 * AV_ROW + c0 * 16) = sv0; *(LAS u32x4*)(Vb + (r0 + 32) * AV_ROW + c0 * 16) = sv1; } while (0)
    const unsigned ldsb = (unsigned)(uintptr_t)lds;
    const unsigned vaddr0 = ldsb + 2 * AK_TILE + (4 * hi + ((lane & 15) >> 2)) * AV_ROW + (16 * ((lane >> 4) & 1) + 4 * (lane & 3)) * 2;
    __syncthreads();
    A_LOAD(0); A_WRITE(0);
    for (int kt = 0; kt < NT; ++kt) {
        __syncthreads();
        if (kt + 1 < NT) A_LOAD(kt + 1);
        if (kt <= my_last) {
            const int buf = kt & 1;
            const LAS unsigned char* Kl = lds + buf * AK_TILE + r32 * AK_ROW + hi * 16;
            f32x16 p0, p1;
#ifdef PROBE_A_QK
            int qreps = 2; asm volatile("" : "+s"(qreps));
            for (int qq = 0; qq < qreps; ++qq) {
#else
            {
#endif
#pragma unroll
            for (int r = 0; r < 16; ++r) { p0[r] = 0.f; p1[r] = 0.f; }
#pragma unroll
            for (int s = 0; s < 12; s += 2) {
                const bf16x8 a0 = *(const LAS bf16x8*)(Kl + s * 32), a1 = *(const LAS bf16x8*)(Kl + 32 * AK_ROW + s * 32);
                const bf16x8 c0 = *(const LAS bf16x8*)(Kl + s * 32 + 32), c1 = *(const LAS bf16x8*)(Kl + 32 * AK_ROW + s * 32 + 32);
                p0 = __builtin_amdgcn_mfma_f32_32x32x16_bf16(a0, qr[s], p0, 0, 0, 0);
                p1 = __builtin_amdgcn_mfma_f32_32x32x16_bf16(a1, qr[s], p1, 0, 0, 0);
                p0 = __builtin_amdgcn_mfma_f32_32x32x16_bf16(c0, qr[s + 1], p0, 0, 0, 0);
                p1 = __builtin_amdgcn_mfma_f32_32x32x16_bf16(c1, qr[s + 1], p1, 0, 0, 0);
                if ((s % 4) == 2) asm volatile("" ::: "memory");
            }
            }
            float tmax = p0[0];
#pragma unroll
            for (int r = 1; r < 16; ++r) tmax = fmaxf(tmax, p0[r]);
#pragma unroll
            for (int r = 0; r < 16; ++r) tmax = fmaxf(tmax, p1[r]);
            tmax = fmaxf(tmax, __shfl_xor(tmax, 32));
            const float mn = fmaxf(m_run, tmax), alpha = __builtin_amdgcn_exp2f((m_run - mn) * MLA_C), mc = mn * MLA_C;
            m_run = mn;
            float ls = 0.f;
#pragma unroll
            for (int r = 0; r < 16; ++r) { p0[r] = __builtin_amdgcn_exp2f(p0[r] * MLA_C - mc); p1[r] = __builtin_amdgcn_exp2f(p1[r] * MLA_C - mc); ls += p0[r] + p1[r]; }
            l_run = l_run * alpha + ls;
#pragma unroll
            for (int d = 0; d < 4; ++d)
#pragma unroll
                for (int r = 0; r < 16; ++r) o[d][r] *= alpha;
            bf16x8 pb[4];
            pb[0] = pack8(p0[0], p0[1], p0[2], p0[3], p0[4], p0[5], p0[6], p0[7]);
            pb[1] = pack8(p0[8], p0[9], p0[10], p0[11], p0[12], p0[13], p0[14], p0[15]);
            pb[2] = pack8(p1[0], p1[1], p1[2], p1[3], p1[4], p1[5], p1[6], p1[7]);
            pb[3] = pack8(p1[8], p1[9], p1[10], p1[11], p1[12], p1[13], p1[14], p1[15]);
            const unsigned va = vaddr0 + buf * AV_TILE;
            pv_block<0>(o[0], va, pb); pv_block<1>(o[1], va, pb); pv_block<2>(o[2], va, pb); pv_block<3>(o[3], va, pb);
#ifdef PROBE_A_PV
            { bf16x8 pz[4]; int zz = 0; asm volatile("" : "+v"(zz));
              _Pragma("unroll") for (int i = 0; i < 4; ++i) pz[i] = (bf16x8){(short)zz, (short)zz, (short)zz, (short)zz, (short)zz, (short)zz, (short)zz, (short)zz};
              pv_block<0>(o[0], va, pz); pv_block<1>(o[1], va, pz); pv_block<2>(o[2], va, pz); pv_block<3>(o[3], va, pz); }
#endif
        }
        if (kt + 1 < NT) A_WRITE((kt + 1) & 1);
    }
#undef A_LOAD
#undef A_WRITE
    const float inv = 1.f / (l_run + __shfl_xor(l_run, 32));
    bf16_t* op = OA + (size_t)tok * DM + h * 128 + 4 * hi;
#pragma unroll
    for (int d = 0; d < 4; ++d)
#pragma unroll
        for (int g = 0; g < 4; ++g) { u32x2 w; w.x = cvt_pk(o[d][4 * g] * inv, o[d][4 * g + 1] * inv); w.y = cvt_pk(o[d][4 * g + 2] * inv, o[d][4 * g + 3] * inv);
            *(u32x2*)(op + 32 * d + 8 * g) = w; }
}

constexpr int BK_ROW = 272, BK_TILE = 64 * BK_ROW;
constexpr int SB_FLAG_OFF = 2 * BK_TILE + 2 * AV_TILE;
__device__ __forceinline__ void sb_half(f32x16& p, int kbase, int qpos, float& run, int hi) {
    f32x16 L;
#pragma unroll
    for (int r = 0; r < 16; ++r) {
        const int kk = kbase + (r & 3) + 8 * (r >> 2);
        const float z = p[r] * SB_SCALE; const float e = __builtin_amdgcn_exp2f(-fabsf(z) * LOG2E); const float sp = __builtin_amdgcn_logf(1.f + e) * LN2;
        const bool bef = kk < qpos; const float madd = bef ? 0.f : -1e30f, mmul = bef ? 1.f : 0.f;
        p[r] = (fminf(z, 0.f) - sp) + madd; L[r] = (fminf(-z, 0.f) - sp) * mmul;
    }
    float qs[4], pq[4];
#pragma unroll
    for (int g = 0; g < 4; ++g) { qs[g] = (L[4 * g] + L[4 * g + 1]) + (L[4 * g + 2] + L[4 * g + 3]); pq[g] = __shfl_xor(qs[g], 32); }
#pragma unroll
    for (int g = 3; g >= 0; --g) {
        const float t3 = run + (hi == 0 ? pq[g] : 0.f), t2 = t3 + L[4 * g + 3], t1 = t2 + L[4 * g + 2], t0 = t1 + L[4 * g + 1];
        p[4 * g + 3] = __builtin_amdgcn_exp2f((p[4 * g + 3] + t3) * LOG2E); p[4 * g + 2] = __builtin_amdgcn_exp2f((p[4 * g + 2] + t2) * LOG2E);
        p[4 * g + 1] = __builtin_amdgcn_exp2f((p[4 * g + 1] + t1) * LOG2E); p[4 * g + 0] = __builtin_amdgcn_exp2f((p[4 * g + 0] + t0) * LOG2E);
        run += qs[g] + pq[g];
    }
}
struct SbSrc { const float* k_main; const float* v_main; const float* k_new; const float* v_new; int new_tile; };
__device__ __forceinline__ void attn_sb(LAS unsigned char* lds, int wave_k, const bf16_t* __restrict__ Qrow0  , const SbSrc src, bf16_t* __restrict__ Orow0  ,
                                        int kt_top, int nwact  , int qpos0  , int top_shift  ) {
    const int tid = phase_tid(wave_k);
    const int wid = __builtin_amdgcn_readfirstlane(tid >> 6), lane = tid & 63, r32 = lane & 31, hi = lane >> 5;
    const bool wact = wid < nwact;
    const int my_top = top_shift ? kt_top - ((7 - wid) >> 1) : kt_top;
    const int qpos = qpos0 + wid * 32 + r32;
    bf16x8 qr[8];
    if (wact) { const bf16_t* qp = Qrow0 + (size_t)(wid * 32 + r32) * 1024 + hi * 8;
#pragma unroll
        for (int s = 0; s < 8; ++s) qr[s] = *(const bf16x8*)(qp + 16 * s); }
    else {
#pragma unroll
        for (int s = 0; s < 8; ++s) qr[s] = (bf16x8){0, 0, 0, 0, 0, 0, 0, 0}; }
    f32x16 o[4];
#pragma unroll
    for (int d = 0; d < 4; ++d)
#pragma unroll
        for (int r = 0; r < 16; ++r) o[d][r] = 0.f;
    float carry = 0.f;
    const int srow = tid >> 3, scol = (tid & 7) * 16;
    f32x4 fk[4], fv[4];
#define B_LOADK(kt) do { const bool isnew = ((kt) == src.new_tile); const bool valid = !isnew || srow < 32; \
        const float* kp = (isnew ? src.k_new : src.k_main + (size_t)(kt) * 64 * 1024) + (size_t)srow * 1024 + scol; \
        if (valid) { _Pragma("unroll") for (int j = 0; j < 4; ++j) fk[j] = *(const f32x4*)(kp + 4 * j); } \
        else { _Pragma("unroll") for (int j = 0; j < 4; ++j) fk[j] = (f32x4){0.f, 0.f, 0.f, 0.f}; } } while (0)
#define B_LOADV(kt) do { const bool isnew = ((kt) == src.new_tile); const bool valid = !isnew || srow < 32; \
        const float* vp = (isnew ? src.v_new : src.v_main + (size_t)(kt) * 64 * 1024) + (size_t)srow * 1024 + scol; \
        if (valid) { _Pragma("unroll") for (int j = 0; j < 4; ++j) fv[j] = *(const f32x4*)(vp + 4 * j); } \
        else { _Pragma("unroll") for (int j = 0; j < 4; ++j) fv[j] = (f32x4){0.f, 0.f, 0.f, 0.f}; } } while (0)
#define B_WRITE(buf) do { LAS unsigned char* Kb = lds + (buf) * BK_TILE + srow * BK_ROW + scol * 2; LAS unsigned char* Vb = lds + 2 * BK_TILE + (buf) * AV_TILE + srow * AV_ROW + scol * 2; \
        u32x4 w; w.x = cvt_pk(fk[0][0], fk[0][1]); w.y = cvt_pk(fk[0][2], fk[0][3]); w.z = cvt_pk(fk[1][0], fk[1][1]); w.w = cvt_pk(fk[1][2], fk[1][3]); *(LAS u32x4*)Kb = w; \
        w.x = cvt_pk(fk[2][0], fk[2][1]); w.y = cvt_pk(fk[2][2], fk[2][3]); w.z = cvt_pk(fk[3][0], fk[3][1]); w.w = cvt_pk(fk[3][2], fk[3][3]); *(LAS u32x4*)(Kb + 16) = w; \
        w.x = cvt_pk(fv[0][0], fv[0][1]); w.y = cvt_pk(fv[0][2], fv[0][3]); w.z = cvt_pk(fv[1][0], fv[1][1]); w.w = cvt_pk(fv[1][2], fv[1][3]); *(LAS u32x4*)Vb = w; \
        w.x = cvt_pk(fv[2][0], fv[2][1]); w.y = cvt_pk(fv[2][2], fv[2][3]); w.z = cvt_pk(fv[3][0], fv[3][1]); w.w = cvt_pk(fv[3][2], fv[3][3]); *(LAS u32x4*)(Vb + 16) = w; } while (0)
    const unsigned ldsb = (unsigned)(uintptr_t)lds;
    const unsigned vaddr0 = ldsb + 2 * BK_TILE + (4 * hi + ((lane & 15) >> 2)) * AV_ROW + (16 * ((lane >> 4) & 1) + 4 * (lane & 3)) * 2;
    volatile LAS unsigned* flags = (volatile LAS unsigned*)(lds + SB_FLAG_OFF);
    __syncthreads();
    if (tid < 16) flags[tid] = 0u;
    B_LOADK(kt_top); B_LOADV(kt_top); B_WRITE(kt_top & 1);
    for (int kt = kt_top; kt >= 0; --kt) {
        __syncthreads();
        if (kt != kt_top) {
            unsigned alld = 1u;
#pragma unroll
            for (int w = 0; w < 8; ++w) alld &= flags[((kt + 1) & 1) * 8 + w];
#ifndef DBG_NO_EXIT
            if (alld) break;
        }
        unsigned mydone = wact ? 0u : 1u;
        const bool act = wact && kt <= my_top;
        const int buf = kt & 1;
        f32x16 p0, p1;
#pragma unroll
        for (int r = 0; r < 16; ++r) { p0[r] = 0.f; p1[r] = 0.f; }
        if (act) {
            const LAS unsigned char* Kl = lds + buf * BK_TILE + r32 * BK_ROW + hi * 16;
#pragma unroll
            for (int s = 0; s < 8; s += 2) {
                const bf16x8 a0 = *(const LAS bf16x8*)(Kl + s * 32), a1 = *(const LAS bf16x8*)(Kl + 32 * BK_ROW + s * 32);
                const bf16x8 c0 = *(const LAS bf16x8*)(Kl + s * 32 + 32), c1 = *(const LAS bf16x8*)(Kl + 32 * BK_ROW + s * 32 + 32);
                p0 = __builtin_amdgcn_mfma_f32_32x32x16_bf16(a0, qr[s], p0, 0, 0, 0);
                p1 = __builtin_amdgcn_mfma_f32_32x32x16_bf16(a1, qr[s], p1, 0, 0, 0);
                p0 = __builtin_amdgcn_mfma_f32_32x32x16_bf16(c0, qr[s + 1], p0, 0, 0, 0);
                p1 = __builtin_amdgcn_mfma_f32_32x32x16_bf16(c1, qr[s + 1], p1, 0, 0, 0);
                if ((s & 3) == 2) asm volatile("" ::: "memory");
            }
            float run = carry;
            sb_half(p1, kt * 64 + 32 + 4 * hi, qpos, run, hi);
            __builtin_amdgcn_sched_barrier(0);
            sb_half(p0, kt * 64 + 4 * hi, qpos, run, hi);
            carry = run;
        }
        asm volatile("" ::: "memory");
        if (kt > 0) { B_LOADK(kt - 1); B_LOADV(kt - 1); }
        if (act) {
            bf16x8 pb[4];
            pb[0] = pack8(p0[0], p0[1], p0[2], p0[3], p0[4], p0[5], p0[6], p0[7]);
            pb[1] = pack8(p0[8], p0[9], p0[10], p0[11], p0[12], p0[13], p0[14], p0[15]);
            pb[2] = pack8(p1[0], p1[1], p1[2], p1[3], p1[4], p1[5], p1[6], p1[7]);
            pb[3] = pack8(p1[8], p1[9], p1[10], p1[11], p1[12], p1[13], p1[14], p1[15]);
            const unsigned va = vaddr0 + buf * AV_TILE;
            pv_block<0>(o[0], va, pb); pv_block<1>(o[1], va, pb); pv_block<2>(o[2], va, pb); pv_block<3>(o[3], va, pb);
            mydone = __all(carry < -110.f) ? 1u : 0u;
        }
        if (lane == 0) flags[(kt & 1) * 8 + wid] = mydone;
        if (kt > 0) B_WRITE((kt - 1) & 1);
    }
#endif
#undef B_LOADK
#undef B_LOADV
#undef B_WRITE
    if (wact) {
        bf16_t* op = Orow0 + (size_t)(wid * 32 + r32) * 1024 + 4 * hi;
#pragma unroll
        for (int d = 0; d < 4; ++d)
#pragma unroll
            for (int g = 0; g < 4; ++g) { u32x2 w; w.x = cvt_pk(o[d][4 * g], o[d][4 * g + 1]); w.y = cvt_pk(o[d][4 * g + 2], o[d][4 * g + 3]); *(u32x2*)(op + 32 * d + 8 * g) = w; }
    }
}

constexpr int C_ROW = 1184, C_TILE = 32 * C_ROW, C_XOFF = 3 * C_TILE, C_XPB = 0, C_XAL = 8 * 1024;
template <int DT0> __device__ __forceinline__ void pvc8(f32x4 (&o)[32], unsigned vaddr, bf16x8 pb) {
#define PVC1(j) { const s16x4 lo = tr_read<(DT0 + j) * 32>(vaddr), hi_ = tr_read<16 * C_ROW + (DT0 + j) * 32>(vaddr); asm volatile("s_waitcnt lgkmcnt(0)" ::: "memory"); __builtin_amdgcn_sched_barrier(0); \
        o[DT0 + j] = __builtin_amdgcn_mfma_f32_16x16x32_bf16(PKTR(lo, hi_), pb, o[DT0 + j], 0, 0, 0); }
    PVC1(0) PVC1(1) PVC1(2) PVC1(3) PVC1(4) PVC1(5) PVC1(6) PVC1(7)
#undef PVC1
}
__device__ __forceinline__ void attn_mla_sample(LAS unsigned char* lds, int wave_k, const bf16_t* __restrict__ QLAT, const bf16_t* __restrict__ Q, const bf16_t* __restrict__ LATS  ,
                                                const bf16_t* __restrict__ KRS  , bf16_t* __restrict__ CTX, int b, int rg) {
    const int tid = phase_tid(wave_k);
    const int wid = __builtin_amdgcn_readfirstlane(tid >> 6), lane = tid & 63, c16 = lane & 15, g = lane >> 4;
    const bool pvw = wid >= 4; const int j4 = wid & 3;
    const int R = rg * 4 + j4, h = R >> 1, q = (R & 1) * 16 + c16;
    const int srow = b * DSEQ + q;
    f32x4 o[32];
#pragma unroll
    for (int d = 0; d < 32; ++d) o[d] = (f32x4){0.f, 0.f, 0.f, 0.f};
    if (!pvw) { const bf16_t* qp = QLAT + (size_t)srow * 8192 + h * 512 + g * 8;
#pragma unroll
      for (int s = 0; s < 16; ++s) o[s] = *(const f32x4*)(qp + 32 * s);
      const bf16_t* qr_ = Q + (size_t)(TP + srow) * 3072 + h * 192 + 128 + g * 8;
      o[16] = *(const f32x4*)qr_; o[17] = *(const f32x4*)(qr_ + 32); }
    float m_run = -INFINITY, l_run = 0.f;
    u32x4 st[5];
#define C_LOAD(kt) do { _Pragma("unroll") for (int j = 0; j < 4; ++j) { const int ch = tid + 512 * j, r = ch >> 6, c = ch & 63; st[j] = *(const u32x4*)(LATS + (size_t)((kt) * 32 + r) * 512 + c * 8); } \
        if (tid < 256) st[4] = *(const u32x4*)(KRS + (size_t)((kt) * 32 + (tid >> 3)) * 64 + (tid & 7) * 8); } while (0)
#define C_WRITE(buf) do { LAS unsigned char* Tb = lds + (buf) * C_TILE; _Pragma("unroll") for (int j = 0; j < 4; ++j) { const int ch = tid + 512 * j, r = ch >> 6, c = ch & 63; *(LAS u32x4*)(Tb + r * C_ROW + c * 16) = st[j]; } \
        if (tid < 256) *(LAS u32x4*)(Tb + (tid >> 3) * C_ROW + 1024 + (tid & 7) * 16) = st[4]; } while (0)
    const unsigned ldsb = (unsigned)(uintptr_t)lds;
    const unsigned vaddr0 = ldsb + (4 * g + (c16 >> 2)) * C_ROW + (c16 & 3) * 8;
    LAS unsigned char* xpb = lds + C_XOFF + C_XPB + j4 * 1024 + lane * 16;
    LAS unsigned char* xal = lds + C_XOFF + C_XAL + j4 * 256 + lane * 4;
    constexpr int NT = SKEYS / 32;
    __syncthreads();
    C_LOAD(0); C_WRITE(0);
    int tcur = 0, tprev = 2;
    for (int kt = 0; kt <= NT; ++kt) {
        __syncthreads();
        if (kt + 1 < NT) C_LOAD(kt + 1);
        if (!pvw) {
            if (kt < NT) {
                const LAS unsigned char* Kl = lds + tcur * C_TILE + c16 * C_ROW + g * 16;
                f32x4 s0 = (f32x4){0.f, 0.f, 0.f, 0.f}, s1 = s0;
#pragma unroll
                for (int s = 0; s < 18; s += 2) {
                    const bf16x8 a0 = *(const LAS bf16x8*)(Kl + s * 64), a1 = *(const LAS bf16x8*)(Kl + 16 * C_ROW + s * 64);
                    const bf16x8 e0 = *(const LAS bf16x8*)(Kl + s * 64 + 64), e1 = *(const LAS bf16x8*)(Kl + 16 * C_ROW + s * 64 + 64);
                    const bf16x8 qa = __builtin_bit_cast(bf16x8, o[s]), qb = __builtin_bit_cast(bf16x8, o[s + 1]);
                    s0 = __builtin_amdgcn_mfma_f32_16x16x32_bf16(a0, qa, s0, 0, 0, 0);
                    s1 = __builtin_amdgcn_mfma_f32_16x16x32_bf16(a1, qa, s1, 0, 0, 0);
                    s0 = __builtin_amdgcn_mfma_f32_16x16x32_bf16(e0, qb, s0, 0, 0, 0);
                    s1 = __builtin_amdgcn_mfma_f32_16x16x32_bf16(e1, qb, s1, 0, 0, 0);
                    if ((s % 6) == 4) asm volatile("" ::: "memory");
                }
                float tmax = fmaxf(fmaxf(fmaxf(s0[0], s0[1]), fmaxf(s0[2], s0[3])), fmaxf(fmaxf(s1[0], s1[1]), fmaxf(s1[2], s1[3])));
                tmax = fmaxf(tmax, __shfl_xor(tmax, 16)); tmax = fmaxf(tmax, __shfl_xor(tmax, 32));
                const float mn = fmaxf(m_run, tmax), alpha = __builtin_amdgcn_exp2f((m_run - mn) * MLA_C), mc = mn * MLA_C;
                m_run = mn;
                float ls = 0.f;
#pragma unroll
                for (int j = 0; j < 4; ++j) { s0[j] = __builtin_amdgcn_exp2f(s0[j] * MLA_C - mc); s1[j] = __builtin_amdgcn_exp2f(s1[j] * MLA_C - mc); ls += s0[j] + s1[j]; }
                l_run = l_run * alpha + ls;
                const bf16x8 pb = pack8(s0[0], s0[1], s0[2], s0[3], s1[0], s1[1], s1[2], s1[3]);
                *(LAS bf16x8*)(xpb + (kt & 1) * 4096) = pb; *(LAS float*)(xal + (kt & 1) * 1024) = alpha;
            }
        } else if (kt >= 1) {
            const bf16x8 pb = *(const LAS bf16x8*)(xpb + ((kt - 1) & 1) * 4096); const float alpha = *(const LAS float*)(xal + ((kt - 1) & 1) * 1024);
            if (__any(alpha != 1.f)) {
#pragma unroll
                for (int d = 0; d < 32; ++d) o[d] *= alpha;
            }
            const unsigned va = vaddr0 + tprev * C_TILE;
            pvc8<0>(o, va, pb); pvc8<8>(o, va, pb); pvc8<16>(o, va, pb); pvc8<24>(o, va, pb);
        }
        const int tnext = (tcur == 2) ? 0 : tcur + 1;
        if (kt + 1 < NT) C_WRITE(tnext);
        tprev = tcur; tcur = tnext;
    }
#undef C_LOAD
#undef C_WRITE
    if (!pvw) { float lt = l_run; lt += __shfl_xor(lt, 16); lt += __shfl_xor(lt, 32); *(LAS float*)(xal + 1024) = 1.f / lt; }
    __syncthreads();
    if (pvw) {
        const float inv = *(const LAS float*)(xal + 1024);
        bf16_t* op = CTX + (size_t)srow * 8192 + h * 512 + 4 * g;
#pragma unroll
        for (int d = 0; d < 32; ++d) { u32x2 w; w.x = cvt_pk(o[d][0] * inv, o[d][1] * inv); w.y = cvt_pk(o[d][2] * inv, o[d][3] * inv); *(u32x2*)(op + 16 * d) = w; }
    }
}

struct Args { const float* in[30]; float* out; unsigned char* ws; int ph_lo, ph_hi; };
constexpr int NWAVES = 8, NPH_LAYER = 14, NPHASES = 1 + NLAYER * NPH_LAYER;

template <class Map>
__device__ __forceinline__ void transpose_item(const float* W, int K, int Nsrc, bf16_t* WT, int ldt, LAS float* scr, int item, int lane, const Map& map) {
    const int nblk = Nsrc / 32, kb = item / nblk, nb = item % nblk, k0 = 64 * kb, n0 = 32 * nb;
#pragma unroll 8
    for (int i = 0; i < 32; ++i) { const int kk = 2 * i + (lane >> 5); scr[kk * 33 + (lane & 31)] = W[(size_t)(k0 + kk) * Nsrc + n0 + (lane & 31)]; }
    asm volatile("s_waitcnt lgkmcnt(0)" ::: "memory");
    const int c = lane & 7;
#pragma unroll
    for (int j = 0; j < 4; ++j) { const int n = (lane >> 3) + 8 * j; const LAS float* s = scr + (8 * c) * 33 + n;
        u32x4 o; o.x = cvt_pk(s[0 * 33], s[1 * 33]); o.y = cvt_pk(s[2 * 33], s[3 * 33]); o.z = cvt_pk(s[4 * 33], s[5 * 33]); o.w = cvt_pk(s[6 * 33], s[7 * 33]);
        *(u32x4*)(WT + (size_t)map(n0 + n) * ldt + k0 + 8 * c) = o; }
    asm volatile("s_waitcnt lgkmcnt(0)" ::: "memory");
}
struct MapId { __device__ __forceinline__ int operator()(int n) const { return n; } };
struct MapIn { __device__ __forceinline__ int operator()(int c) const { return c < 1024 ? c : (c < 1088 ? 8192 + (c - 1024) : c - 64); } };
struct MapQ { __device__ __forceinline__ int operator()(int c) const { const int h = c / 192, w = c - h * 192; if (w < 128) return c; const int j = w - 128; return h * 192 + 128 + 2 * (j & 31) + (j >> 5); } };
struct MapGU { __device__ __forceinline__ int operator()(int c) const { return c < FF ? (c >> 2) * 8 + (c & 3) : ((c - FF) >> 2) * 8 + 4 + ((c - FF) & 3); } };

__device__ __forceinline__ void ln_row(const float* __restrict__ xin, const float* __restrict__ gam, const float* __restrict__ bet, float* __restrict__ xo, bf16_t* __restrict__ xb, int lane) {
    const f32x4* xr = (const f32x4*)xin + lane;
    f32x4 v[8]; float s = 0.f;
#pragma unroll
    for (int j = 0; j < 8; ++j) { v[j] = xr[64 * j]; s += (v[j][0] + v[j][1]) + (v[j][2] + v[j][3]); }
    const float mean = wave_sum(s) * (1.f / DM); float s2 = 0.f;
#pragma unroll
    for (int j = 0; j < 8; ++j) { v[j] = v[j] - mean; s2 += (v[j][0] * v[j][0] + v[j][1] * v[j][1]) + (v[j][2] * v[j][2] + v[j][3] * v[j][3]); }
    const float rstd = 1.f / sqrtf(wave_sum(s2) * (1.f / DM) + LN_EPS);
#pragma unroll
    for (int j = 0; j < 8; ++j) { const f32x4 gg = ((const f32x4*)gam)[64 * j + lane], bb = ((const f32x4*)bet)[64 * j + lane]; const f32x4 y = v[j] * rstd * gg + bb;
        if (xo) ((f32x4*)xo)[64 * j + lane] = y;
        if (xb) { u32x2 w; w.x = cvt_pk(y[0], y[1]); w.y = cvt_pk(y[2], y[3]); ((u32x2*)xb)[64 * j + lane] = w; } }
}

#define P_X     ((float*)(ws + WS_X))
#define P_Y     ((float*)(ws + WS_Y))
#define P_XB    ((bf16_t*)(ws + WS_XB))
#define P_QA    ((float*)(ws + WS_QA))
#define P_KVA   ((float*)(ws + WS_KVA))
#define P_KRRAW ((float*)(ws + WS_KRRAW))
#define P_SBQ   ((bf16_t*)(ws + WS_SBQ))
#define P_GATE  ((bf16_t*)(ws + WS_GATE))
#define P_QN    ((bf16_t*)(ws + WS_QN))
#define P_LATB  ((bf16_t*)(ws + WS_LATB))
#define P_KRB   ((bf16_t*)(ws + WS_KRB))
#define P_Q     ((bf16_t*)(ws + WS_Q))
#define P_KVX   ((bf16_t*)(ws + WS_KVX))
#define P_QLAT  ((bf16_t*)(ws + WS_QLAT))
#define P_CTX   ((bf16_t*)(ws + WS_CTX))
#define P_OA    ((bf16_t*)(ws + WS_OA))
#define P_OB    ((bf16_t*)(ws + WS_OB))
#define P_T1    ((float*)(ws + WS_T1))
#define P_MRG   ((bf16_t*)(ws + WS_MRG))
#define P_FFB   ((bf16_t*)(ws + WS_FFB))
#define P_PP    ((float*)(ws + WS_PP))
#define P_LATS  ((bf16_t*)(ws + WS_LATS))
#define P_KRS   ((bf16_t*)(ws + WS_KRS))
#define P_PB    ((bf16_t*)(ws + WS_PB))
#define P_ROPE  ((float*)(ws + WS_ROPE))
#define P_WL(off) ((const bf16_t*)(ws + WS_W + (size_t)l * W_LAYER + (off)))

#ifndef PROBE_MASK
#define PROBE_MASK 0
#endif
#define REP0 (1 + (PROBE_MASK & 1))
#define REP(j) (1 + ((PROBE_MASK >> (1 + (j))) & 1))
#ifndef PHMASK
#define PHMASK 0xffff
#endif

__global__ void __launch_bounds__(512, 2) fwd_kernel(Args args) {
    extern __shared__ __attribute__((aligned(16))) unsigned char lds_raw[];
    LAS unsigned char* lds = (LAS unsigned char*)lds_raw;
    volatile LAS unsigned* MISC = (volatile LAS unsigned*)(lds + LDS_MISC);
    const int G_k = gridDim.x, bx_k = blockIdx.x, wave_k = __builtin_amdgcn_readfirstlane(threadIdx.x >> 6);
    unsigned char* const ws_k = args.ws;
    float* const out_k = args.out;
    for (int u = threadIdx.x; u < (LDS_BYTES - LDS_MISC) / 4; u += 512) MISC[u] = 0u;
    __syncthreads();
#if !MK_PER_PHASE
    const XcdBarrier bar = xcd_barrier_post((unsigned*)(ws_k + WS_CTL) + CW_BAR, MISC + 8);
#define GRID_BAR() xcd_barrier(bar, wave_k)
#else
#define GRID_BAR() do {} while (0)
#endif
    const int lo = args.ph_lo, hi = args.ph_hi;
#define IN(k) (lo <= (k) && (k) < hi)
#define LIN(j) (((PHMASK >> (1 + (j))) & 1) && IN(P0 + (j)))
#define SEAM(k) do { if (IN(k) && IN((k) + 1)) GRID_BAR(); } while (0)
#define PHASE_PTRS() unsigned zoff_ = 0u; int G = G_k, bx = bx_k; asm volatile("" : "+s"(zoff_), "+s"(G), "+s"(bx)); unsigned char* ws = ws_k + zoff_; float* out = out_k + zoff_; (void)out; (void)G; (void)bx
#define PHASE_IDS() PHASE_PTRS(); const int tid = phase_tid(wave_k); const int lane = tid & 63, wave = wave_k, gw = bx * NWAVES + wave, NGW = G * NWAVES; (void)lane; (void)gw; (void)NGW

    if ((PHMASK & 1) && IN(0)) for (int rep = 0; rep < REP0; ++rep) {
        PHASE_IDS();
        const size_t gtid = (size_t)bx * 512 + tid, gthreads = (size_t)G * 512;
        LAS float* scr = (LAS float*)(lds + wave * 16384);
        {
            constexpr int I_IN = (DM / 64) * (8256 / 32), I_QB = (512 / 64) * (3072 / 32), I_KV = (512 / 64) * (4096 / 32), I_BA = (DM / 64) * (DM / 32), I_BB = (1024 / 64) * (DM / 32),
                          I_OUT = I_BA, I_GU = (DM / 64) * (2 * FF / 32), I_DN = (FF / 64) * (DM / 32), I_PG = I_BA, I_PP = (PLE / 64) * (DM / 32);
            constexpr int I_LAYER = I_IN + I_QB + I_KV + I_BA + I_BB + I_OUT + I_GU + I_DN + I_PG + I_PP;
            for (int g = gw; g < NLAYER * I_LAYER; g += NGW) {
                const int l = g / I_LAYER; int r = g - l * I_LAYER;
                unsigned char* wl = ws + WS_W + (size_t)l * W_LAYER;
                if (r < I_IN) { transpose_item(args.in[10] + (size_t)l * DM * 8256, DM, 8256, (bf16_t*)(wl + W_IN), DM, scr, r, lane, MapIn()); continue; } r -= I_IN;
                if (r < I_QB) { transpose_item(args.in[13] + (size_t)l * 512 * 3072, 512, 3072, (bf16_t*)(wl + W_QB), 512, scr, r, lane, MapQ()); continue; } r -= I_QB;
                if (r < I_KV) { transpose_item(args.in[15] + (size_t)l * 512 * 4096, 512, 4096, (bf16_t*)(wl + W_KVBT), 512, scr, r, lane, MapId()); continue; } r -= I_KV;
                if (r < I_BA) { transpose_item(args.in[16] + (size_t)l * DM * DM, DM, DM, (bf16_t*)(wl + W_BA), DM, scr, r, lane, MapId()); continue; } r -= I_BA;
                if (r < I_BB) { transpose_item(args.in[17] + (size_t)l * 1024 * DM, 1024, DM, (bf16_t*)(wl + W_BB), 1024, scr, r, lane, MapId()); continue; } r -= I_BB;
                if (r < I_OUT) { transpose_item(args.in[18] + (size_t)l * DM * DM, DM, DM, (bf16_t*)(wl + W_OUT), DM, scr, r, lane, MapId()); continue; } r -= I_OUT;
                if (r < I_GU) { transpose_item(args.in[21] + (size_t)l * DM * 2 * FF, DM, 2 * FF, (bf16_t*)(wl + W_GU), DM, scr, r, lane, MapGU()); continue; } r -= I_GU;
                if (r < I_DN) { transpose_item(args.in[22] + (size_t)l * FF * DM, FF, DM, (bf16_t*)(wl + W_DN), FF, scr, r, lane, MapId()); continue; } r -= I_DN;
                if (r < I_PG) { transpose_item(args.in[25] + (size_t)l * DM * DM, DM, DM, (bf16_t*)(wl + W_PG), DM, scr, r, lane, MapId()); continue; } r -= I_PG;
                transpose_item(args.in[27] + (size_t)l * PLE * DM, PLE, DM, (bf16_t*)(wl + W_PP), PLE, scr, r, lane, MapId());
            }
        }
        for (int l = 0; l < NLAYER; ++l) {
            unsigned char* wl = ws + WS_W + (size_t)l * W_LAYER;
            { bf16_t* WT = (bf16_t*)(wl + W_IN);
              for (size_t i = gtid; i < (size_t)192 * DM / 8; i += gthreads) ((u32x4*)(WT + (size_t)8256 * DM))[i] = (u32x4){0u, 0u, 0u, 0u}; }
            { const float* W = args.in[15] + (size_t)l * 512 * 4096;
              bf16_t* WN = (bf16_t*)(wl + W_KVBN);
              for (size_t i = gtid; i < (size_t)16 * 512 * 256 / 8; i += gthreads) { const int k8 = (int)(i & 31) * 8, c = (int)(i >> 5) & 511, hh = (int)(i >> 14);
                  f32x4 a = (f32x4){0.f, 0.f, 0.f, 0.f}, b = a;
                  if (k8 < 128) { const float* src = W + (size_t)c * 4096 + hh * 256 + k8; a = *(const f32x4*)src; b = *(const f32x4*)(src + 4); }
                  st_bf16x8(WN + 8 * i, a, b); }
              bf16_t* BD = (bf16_t*)(wl + W_UVBD);
              for (size_t i = gtid; i < (size_t)2048 * 1024 / 2; i += gthreads) { const int n = (int)(i / 512), k2 = (int)(i % 512) * 2, hh = n >> 7, v = n & 127; unsigned w = 0u;
                  if ((k2 >> 9) == (hh & 1)) { const int c = k2 & 511; w = cvt_pk(W[(size_t)c * 4096 + hh * 256 + 128 + v], W[(size_t)(c + 1) * 4096 + hh * 256 + 128 + v]); }
                  ((unsigned*)BD)[i] = w; } }
        }
        for (size_t i = gtid; i < (size_t)SEQ * 32; i += gthreads) { float c, s; rope_cs_slow((int)(i >> 5), (int)(i & 31), c, s); P_ROPE[i] = c; P_ROPE[(size_t)SEQ * 32 + i] = s; }
        { const float* cl = args.in[2];
          for (size_t i = gtid; i < (size_t)NLAYER * NDB * PAST * 512 / 8; i += gthreads) { const size_t e = i * 8, lb_ = e / ((size_t)PAST * 512), rem = e % ((size_t)PAST * 512);
              const f32x4 a = *(const f32x4*)(cl + e), b = *(const f32x4*)(cl + e + 4); st_bf16x8(P_LATS + lb_ * (size_t)SKEYS * 512 + rem, a, b); }
          const float* ck = args.in[3];
          for (size_t i = gtid; i < (size_t)NLAYER * NDB * PAST * 32; i += gthreads) { const size_t rowi = i / 32; const int p = (int)(i % 32); const size_t lb_ = rowi / PAST, rr = rowi % PAST;
              ((unsigned*)(P_KRS + (lb_ * SKEYS + rr) * 64))[p] = cvt_pk(ck[rowi * 64 + p], ck[rowi * 64 + 32 + p]); } }
        { const float* pp = args.in[6]; const float* ps = args.in[7];
          for (size_t i = gtid; i < (size_t)NLAYER * TT * PLE / 8; i += gthreads) { const size_t e = i * 8, l = e / ((size_t)TT * PLE), rem = e % ((size_t)TT * PLE);
              const float* src = rem < (size_t)TP * PLE ? pp + l * (size_t)TP * PLE + rem : ps + l * (size_t)TS * PLE + (rem - (size_t)TP * PLE);
              st_bf16x8(P_PB + e, *(const f32x4*)src, *(const f32x4*)(src + 4)); } }
        for (int m = gw; m < TT; m += NGW) { const float* xin = m < TP ? args.in[0] + (size_t)m * DM : args.in[1] + (size_t)(m - TP) * DM;
            ln_row(xin, args.in[8], args.in[9], P_X + (size_t)m * DM, P_XB + (size_t)m * DM, lane); }
    }
    SEAM(0);

    for (int l = 0; l < NLAYER; ++l) {
        const int P0 = 1 + l * NPH_LAYER;
        if (LIN(0)) for (int rep = 0; rep < REP(0); ++rep) {
            PHASE_PTRS();
            pg8::Order S; S.init(TT, 30 * 256, 1, G, bx, 1);
            pg8::EpiIn E{P_QA, P_KVA, P_KRRAW, P_SBQ, P_GATE, out + O_K_P + (size_t)l * TP * 1024, out + O_K_S + (size_t)l * TS * 1024,
                         out + O_V_P + (size_t)l * TP * 1024, out + O_V_S + (size_t)l * TS * 1024, args.in[11] + (size_t)l * 4096};
            pg8::gemm_phase<pg8::Shape<DM, DM, DM>>(lds, wave_k, P_XB, P_WL(W_IN), S, E);
        }
        SEAM(P0 + 0);
        if (LIN(1)) for (int rep = 0; rep < REP(1); ++rep) {
            PHASE_IDS();
            const float* gq = args.in[12] + (size_t)l * 512; const float* gkv = args.in[14] + (size_t)l * 512;
            bf16_t* LATS_l = P_LATS + (size_t)l * NDB * SKEYS * 512; bf16_t* KRS_l = P_KRS + (size_t)l * NDB * SKEYS * 64;
            for (int m = gw; m < TT; m += NGW) {
                { const f32x4 a = ((const f32x4*)(P_QA + (size_t)m * 512))[2 * lane], b = ((const f32x4*)(P_QA + (size_t)m * 512))[2 * lane + 1];
                  const float ss = wave_sum((a[0] * a[0] + a[1] * a[1]) + (a[2] * a[2] + a[3] * a[3]) + (b[0] * b[0] + b[1] * b[1]) + (b[2] * b[2] + b[3] * b[3]));
                  const float r = 1.f / sqrtf(ss * (1.f / 512.f) + RMS_EPS); const f32x4 g0 = ((const f32x4*)gq)[2 * lane], g1 = ((const f32x4*)gq)[2 * lane + 1];
                  st_bf16x8(P_QN + (size_t)m * 512 + 8 * lane, a * r * g0, b * r * g1); }
                { const f32x4 a = ((const f32x4*)(P_KVA + (size_t)m * 512))[2 * lane], b = ((const f32x4*)(P_KVA + (size_t)m * 512))[2 * lane + 1];
                  const float ss = wave_sum((a[0] * a[0] + a[1] * a[1]) + (a[2] * a[2] + a[3] * a[3]) + (b[0] * b[0] + b[1] * b[1]) + (b[2] * b[2] + b[3] * b[3]));
                  const float r = 1.f / sqrtf(ss * (1.f / 512.f) + RMS_EPS); const f32x4 g0 = ((const f32x4*)gkv)[2 * lane], g1 = ((const f32x4*)gkv)[2 * lane + 1];
                  const f32x4 y0 = a * r * g0, y1 = b * r * g1;
                  float* od; bf16_t* ob;
                  if (m < TP) { od = out + O_LAT_P + ((size_t)l * TP + m) * 512; ob = P_LATB + (size_t)m * 512; }
                  else { const int sm = m - TP, bb = sm >> 5, qq = sm & 31; od = out + O_LAT_S + ((size_t)l * TS + sm) * 512; ob = LATS_l + ((size_t)bb * SKEYS + PAST + qq) * 512; }
                  st_f32x8(od + 8 * lane, y0, y1); st_bf16x8(ob + 8 * lane, y0, y1); }
                if (lane < 32) { const float x1 = P_KRRAW[(size_t)m * 64 + lane], x2 = P_KRRAW[(size_t)m * 64 + 32 + lane];
                  const int pos = tok_pos(m); const float c = P_ROPE[pos * 32 + lane], s = P_ROPE[SEQ * 32 + pos * 32 + lane];
                  const float y1 = x1 * c - x2 * s, y2 = x2 * c + x1 * s;
                  float* od; bf16_t* ob;
                  if (m < TP) { od = out + O_KR_P + ((size_t)l * TP + m) * 64; ob = P_KRB + (size_t)m * 64; }
                  else { const int sm = m - TP, bb = sm >> 5, qq = sm & 31; od = out + O_KR_S + ((size_t)l * TS + sm) * 64; ob = KRS_l + ((size_t)bb * SKEYS + PAST + qq) * 64; }
                  od[lane] = y1; od[32 + lane] = y2; ((unsigned*)ob)[lane] = cvt_pk(y1, y2); }
            }
        }
        SEAM(P0 + 1);
        if (LIN(2)) for (int rep = 0; rep < REP(2); ++rep) {
            PHASE_PTRS();
            { pg8::Order S; S.init(TT, 3 * 256, 1, G, bx, 2);
              pg8::EpiIn E{P_QA, P_KVA, P_KRRAW, P_SBQ, P_GATE, out + O_K_P + (size_t)l * TP * 1024, out + O_K_S + (size_t)l * TS * 1024,
                           out + O_V_P + (size_t)l * TP * 1024, out + O_V_S + (size_t)l * TS * 1024, args.in[11] + (size_t)l * 4096};
              pg8::gemm_phase<pg8::Shape<DM, DM, DM>>(lds, wave_k, P_XB, P_WL(W_IN), S, E); }
            { pg8::Order S; S.init(TT, 3072, 1, G, (bx + 154) & 255); pg8::EpiQ E{P_Q, P_ROPE}; pg8::gemm_phase<pg8::Shape<512, 512, 512>>(lds, wave_k, P_QN, P_WL(W_QB), S, E); }
            { pg8::Order S; S.init(TP, 4096, 1, 154, bx >= 102 ? bx - 102 : (1 << 28)); pg8::EpiBf16 E{P_KVX, 4096, 0}; pg8::gemm_phase<pg8::Shape<512, 512, 512>>(lds, wave_k, P_LATB, P_WL(W_KVBT), S, E); }
            { pg8::Order S; S.init(TP, DM, 1, G, bx); pg8::EpiF32 E{P_PP, DM}; pg8::gemm_phase<pg8::Shape<PLE, PLE, PLE>>(lds, wave_k, P_PB + (size_t)l * TT * PLE, P_WL(W_PP), S, E);
              pg8::gemm_small<PLE, PLE, PLE, 0>(lds, wave_k, P_PB + (size_t)l * TT * PLE, P_WL(W_PP), TP, 8, 32, G, bx, E); }
        }
        SEAM(P0 + 2);
        if (LIN(3)) for (int rep = 0; rep < REP(3); ++rep) {
            PHASE_PTRS();
            pg8::Order S; S.init(TS, 512, 16, G, bx); pg8::EpiBf16 E{P_QLAT, 8192, 512};
            pg8::gemm_phase<pg8::Shape<256, 3072, 256, 192, 512 * 256, 0>>(lds, wave_k, P_Q + (size_t)TP * 3072, P_WL(W_KVBN), S, E);
        }
        SEAM(P0 + 3);
        if (LIN(4)) for (int rep = 0; rep < REP(4); ++rep) {
            PHASE_IDS();
            volatile LAS int* qslot = (volatile LAS int*)(MISC + 16);
            unsigned* qc = (unsigned*)(ws + WS_CTL) + CW_Q + (size_t)(l * 2 + rep) * 4 * 64;
#ifndef PROBE_ATT
#define PROBE_ATT 0
#endif
#ifndef NO_C
            for (int r2 = 0; r2 < 1 + (PROBE_ATT & 1); ++r2)
            for (;;) {
                __syncthreads(); if (tid == 0) qslot[0] = (int)atomicAdd(qc + (r2 ? 3 : 0) * 64, 1u); __syncthreads();
                const int it = qslot[0]; if (it >= 128) break;
                const int b = it >> 3, rg = it & 7;
                attn_mla_sample(lds, wave_k, P_QLAT, P_Q, P_LATS + ((size_t)l * NDB + b) * SKEYS * 512, P_KRS + ((size_t)l * NDB + b) * SKEYS * 64, P_CTX, b, rg);
            }
#endif
#ifndef NO_A
            for (int r2 = 0; r2 < 1 + ((PROBE_ATT >> 1) & 1); ++r2)
            for (;;) {
                __syncthreads(); if (tid == 0) qslot[0] = (int)atomicAdd(qc + (r2 ? 3 : 1) * 64, 1u); __syncthreads();
                const int it = qslot[0]; if (it >= 512) break;
                const int qb = 15 - (it >> 5), bh = it & 31, b = bh >> 4, h = bh & 15;
                attn_mla_prompt(lds, wave_k, P_Q, P_KVX, P_KRB, P_OA, b, h, qb);
            }
#endif
#ifndef NO_B
            for (int r2 = 0; r2 < 1 + ((PROBE_ATT >> 2) & 1); ++r2)
            for (;;) {
                __syncthreads(); if (tid == 0) qslot[0] = (int)atomicAdd(qc + (r2 ? 3 : 2) * 64, 1u); __syncthreads();
                const int it = qslot[0]; if (it >= 256 + 128) break;
#ifdef DBG_ONLY_D
                if (it < 256) continue;
#endif
#ifdef DBG_ONLY_B
                if (it >= 256) continue;
#endif
                SbSrc src; size_t row0; int kt_top, nwact, qpos0, top_shift, h;
                if (it < 256) {
                    const int qb = 15 - (it >> 4), bh = it & 15, b = bh >> 3; h = bh & 7;
                    src.k_main = out + O_K_P + ((size_t)l * TP + (size_t)b * SEQ) * 1024 + h * 128; src.v_main = out + O_V_P + ((size_t)l * TP + (size_t)b * SEQ) * 1024 + h * 128;
                    src.k_new = src.k_main; src.v_new = src.v_main; src.new_tile = -1;
                    row0 = (size_t)b * SEQ + qb * 256; kt_top = 4 * qb + 3; nwact = 8; qpos0 = qb * 256; top_shift = 1;
                } else {
                    const int u = it - 256, b = u >> 3; h = u & 7;
                    src.k_main = args.in[4] + ((size_t)(l * NDB + b) * PAST) * 1024 + h * 128; src.v_main = args.in[5] + ((size_t)(l * NDB + b) * PAST) * 1024 + h * 128;
                    src.k_new = out + O_K_S + ((size_t)l * TS + (size_t)b * DSEQ) * 1024 + h * 128; src.v_new = out + O_V_S + ((size_t)l * TS + (size_t)b * DSEQ) * 1024 + h * 128; src.new_tile = 32;
                    row0 = (size_t)TP + b * DSEQ; kt_top = 32; nwact = 1; qpos0 = PAST; top_shift = 0;
                }
                attn_sb(lds, wave_k, P_SBQ + row0 * 1024 + h * 128, src, P_OB + row0 * 1024 + h * 128, kt_top, nwact, qpos0, top_shift);
            }
#endif
            __syncthreads();
        }
        SEAM(P0 + 4);
        if (LIN(5)) for (int rep = 0; rep < REP(5); ++rep) {
            PHASE_PTRS();
            { pg8::EpiBf16 E{P_OA + (size_t)TP * DM, DM, 0}; pg8::gemm_small<1024, 8192, 1024, 1024>(lds, wave_k, P_CTX, P_WL(W_UVBD), 0, 8, 32, G, bx, E); }
            { pg8::Order S; S.init(TP, DM, 1, G, bx); pg8::EpiBrB E{P_T1, P_GATE}; pg8::gemm_phase<pg8::Shape<1024, 1024, 1024>>(lds, wave_k, P_OB, P_WL(W_BB), S, E);
              pg8::gemm_small<1024, 1024, 1024, 0>(lds, wave_k, P_OB, P_WL(W_BB), TP, 8, 32, G, bx, E); }
        }
        SEAM(P0 + 5);
        if (LIN(6)) for (int rep = 0; rep < REP(6); ++rep) { PHASE_PTRS(); pg8::Order S; S.init(TP, DM, 1, G, bx); pg8::EpiBrA E{P_MRG, P_T1, P_GATE}; pg8::gemm_phase<pg8::Shape<DM, DM, DM>>(lds, wave_k, P_OA, P_WL(W_BA), S, E);
            pg8::gemm_small<DM, DM, DM, 0>(lds, wave_k, P_OA, P_WL(W_BA), TP, 8, 32, G, bx, E); }
        SEAM(P0 + 6);
        if (LIN(7)) for (int rep = 0; rep < REP(7); ++rep) { PHASE_PTRS(); pg8::Order S; S.init(TP, DM, 1, G, bx); pg8::EpiRes E{P_Y, P_X}; pg8::gemm_phase<pg8::Shape<DM, DM, DM>>(lds, wave_k, P_MRG, P_WL(W_OUT), S, E);
            pg8::gemm_small<DM, DM, DM, 0>(lds, wave_k, P_MRG, P_WL(W_OUT), TP, 8, 32, G, bx, E); }
        SEAM(P0 + 7);
        if (LIN(8)) for (int rep = 0; rep < REP(8); ++rep) { PHASE_IDS(); for (int m = gw; m < TT; m += NGW) ln_row(P_Y + (size_t)m * DM, args.in[19] + (size_t)l * DM, args.in[20] + (size_t)l * DM, P_X + (size_t)m * DM, P_XB + (size_t)m * DM, lane); }
        SEAM(P0 + 8);
        if (LIN(9)) for (int rep = 0; rep < REP(9); ++rep) { PHASE_PTRS(); pg8::Order S; S.init(TT, 2 * FF, 1, G, bx); pg8::EpiGU E{P_FFB}; pg8::gemm_phase<pg8::Shape<DM, DM, DM>>(lds, wave_k, P_XB, P_WL(W_GU), S, E); }
        SEAM(P0 + 9);
        if (LIN(10)) for (int rep = 0; rep < REP(10); ++rep) { PHASE_PTRS(); pg8::Order S; S.init(TP, DM, 1, G, bx); pg8::EpiRes E{P_Y, P_X}; pg8::gemm_phase<pg8::Shape<FF, FF, FF>>(lds, wave_k, P_FFB, P_WL(W_DN), S, E);
            pg8::gemm_small<FF, FF, FF, 0>(lds, wave_k, P_FFB, P_WL(W_DN), TP, 8, 32, G, bx, E); }
        SEAM(P0 + 10);
        if (LIN(11)) for (int rep = 0; rep < REP(11); ++rep) { PHASE_IDS(); for (int m = gw; m < TT; m += NGW) ln_row(P_Y + (size_t)m * DM, args.in[23] + (size_t)l * DM, args.in[24] + (size_t)l * DM, P_X + (size_t)m * DM, P_XB + (size_t)m * DM, lane); }
        SEAM(P0 + 11);
        if (LIN(12)) for (int rep = 0; rep < REP(12); ++rep) { PHASE_PTRS(); pg8::Order S; S.init(TP, DM, 1, G, bx); pg8::EpiPle E{P_Y, P_X, P_PP, args.in[26] + (size_t)l * DM}; pg8::gemm_phase<pg8::Shape<DM, DM, DM>>(lds, wave_k, P_XB, P_WL(W_PG), S, E);
            pg8::gemm_small<DM, DM, DM, 0>(lds, wave_k, P_XB, P_WL(W_PG), TP, 8, 32, G, bx, E); }
        SEAM(P0 + 12);
        if (LIN(13)) for (int rep = 0; rep < REP(13); ++rep) {
            PHASE_IDS();
            const float* gam = args.in[28] + (size_t)l * DM; const float* bet = args.in[29] + (size_t)l * DM;
            if (l + 1 < NLAYER) { for (int m = gw; m < TT; m += NGW) ln_row(P_Y + (size_t)m * DM, gam, bet, P_X + (size_t)m * DM, P_XB + (size_t)m * DM, lane); }
            else { for (int m = gw; m < TT; m += NGW) ln_row(P_Y + (size_t)m * DM, gam, bet, out + O_Y_P + (size_t)m * DM, nullptr, lane); }
        }
        SEAM(P0 + 13);
    }
#undef IN
#undef LIN
#undef SEAM
}

extern "C" void kernel_launch(void* const* d_in, const int* in_sizes, int n_in, void* d_out, int out_size, void* d_ws, size_t ws_size, hipStream_t stream) {
    static int grid = 0;
    if (grid == 0) {
        if (n_in != 30 || out_size != (int)O_END || ws_size < WS_END) {
            fprintf(stderr, "kernel_launch: shape mismatch n_in %d out %d ws %zu (need %zu)\n", n_in, out_size, ws_size, (size_t)WS_END); grid = -1; return; }
        int dev = 0, cus = 0, per_cu = 0;
        if (hipGetDevice(&dev) != hipSuccess || hipDeviceGetAttribute(&cus, hipDeviceAttributeMultiprocessorCount, dev) != hipSuccess) { grid = -1; return; }
        if (hipFuncSetAttribute((const void*)fwd_kernel, hipFuncAttributeMaxDynamicSharedMemorySize, LDS_BYTES) != hipSuccess) { fprintf(stderr, "kernel_launch: hipFuncSetAttribute failed\n"); grid = -1; return; }
        if (hipOccupancyMaxActiveBlocksPerMultiprocessor(&per_cu, (const void*)fwd_kernel, 512, LDS_BYTES) != hipSuccess || per_cu < 1)
            fprintf(stderr, "kernel_launch: occupancy query reports %d blocks per CU\n", per_cu);
        (void)hipGetLastError();
        grid = cus;
    }
    if (grid <= 0) return;
#ifdef DBG_ZERO_ALL
    (void)hipMemsetAsync(d_ws, 0, WS_END, stream); (void)hipMemsetAsync(d_out, 0, (size_t)O_END * 4, stream);
#else
    (void)hipMemsetAsync(d_ws, 0, CTL_BYTES, stream);
#endif
    Args a;
    memset(&a, 0, sizeof(a));
    for (int i = 0; i < 30; ++i) a.in[i] = (const float*)d_in[i];
    a.out = (float*)d_out; a.ws = (unsigned char*)d_ws;
#if MK_PER_PHASE
#ifndef DBG_PH_MAX
#define DBG_PH_MAX NPHASES
#endif
    for (int p = 0; p < DBG_PH_MAX; ++p) { a.ph_lo = p; a.ph_hi = p + 1; hipLaunchKernelGGL(fwd_kernel, dim3(grid), dim3(512), LDS_BYTES, stream, a); }
#else
    a.ph_lo = 0; a.ph_hi = NPHASES;
    hipLaunchKernelGGL(fwd_kernel, dim3(grid), dim3(512), LDS_BYTES, stream, a);
#endif
#ifdef DBG_COPY_OFF
    (void)hipMemcpyAsync(d_out, (const char*)d_ws + DBG_COPY_OFF, DBG_COPY_BYTES, hipMemcpyDeviceToDevice, stream);
#endif
    const hipError_t le = hipPeekAtLastError();
    if (le != hipSuccess) fprintf(stderr, "kernel_launch: launch failed: %s\n", hipGetErrorName(le));
}
```

```cpp
#include <hip/hip_runtime.h>
#include <cstdio>
#include <cstdint>
#include <cstring>

#ifndef MK_PER_PHASE
#define MK_PER_PHASE 0
#endif

#define LAS __attribute__((address_space(3)))
#define GAS __attribute__((address_space(1)))
typedef unsigned short bf16_t;
typedef short bf16x8 __attribute__((ext_vector_type(8)));
typedef short s16x4 __attribute__((ext_vector_type(4)));
typedef float f32x4 __attribute__((ext_vector_type(4)));
typedef float f32x16 __attribute__((ext_vector_type(16)));
typedef unsigned u32x4 __attribute__((ext_vector_type(4)));
typedef unsigned u32x2 __attribute__((ext_vector_type(2)));

constexpr int DM = 2048, TP = 8192, TS = 512, TT = 8704, SEQ = 4096, PAST = 2048, DSEQ = 32, NDB = 16, NLAYER = 2;
constexpr int NIN = 8448;
constexpr int FF = 5632, PLE = 256, SKEYS = PAST + DSEQ;
constexpr float ALPHA = 1.41421356237309515f;
constexpr float LN_EPS = 1e-5f, RMS_EPS = 1e-6f;
constexpr float LOG2E = 1.4426950408889634f, LN2 = 0.6931471805599453f;
constexpr float MLA_C = 0.07216878364870322f * LOG2E;
constexpr float SB_SCALE = 0.08838834764831845f;

constexpr size_t O_Y_P = 0, O_Y_S = 16777216, O_LAT_P = 17825792, O_KR_P = 26214400, O_K_P = 27262976, O_V_P = 44040192,
                 O_LAT_S = 60817408, O_KR_S = 61341696, O_K_S = 61407232, O_V_S = 62455808, O_END = 63504384;

constexpr size_t al256(size_t x) { return (x + 255) & ~(size_t)255; }
constexpr size_t WS_CTL = 0, CTL_BYTES = 1u << 20;
constexpr size_t W_IN = 0, W_QB = W_IN + (size_t)NIN * DM * 2, W_KVBT = W_QB + (size_t)3072 * 512 * 2, W_KVBN = W_KVBT + (size_t)4096 * 512 * 2,
                 W_UVBD = W_KVBN + (size_t)512 * 4096 * 2, W_BA = W_UVBD + (size_t)2048 * 1024 * 2, W_BB = W_BA + (size_t)DM * DM * 2,
                 W_OUT = W_BB + (size_t)DM * 1024 * 2, W_GU = W_OUT + (size_t)DM * DM * 2, W_DN = W_GU + (size_t)2 * FF * DM * 2,
                 W_PG = W_DN + (size_t)DM * FF * 2, W_PP = W_PG + (size_t)DM * DM * 2, W_LAYER = W_PP + (size_t)DM * PLE * 2;
constexpr size_t WS_W = CTL_BYTES;
constexpr size_t WS_LATS = WS_W + NLAYER * W_LAYER;
constexpr size_t WS_KRS = WS_LATS + (size_t)NLAYER * NDB * SKEYS * 512 * 2;
constexpr size_t WS_PB = WS_KRS + (size_t)NLAYER * NDB * SKEYS * 64 * 2;
constexpr size_t WS_X = WS_PB + (size_t)NLAYER * TT * PLE * 2;
constexpr size_t WS_Y = WS_X + (size_t)TT * DM * 4;
constexpr size_t WS_XB = WS_Y + (size_t)TT * DM * 4;
constexpr size_t WS_QA = WS_XB + (size_t)TT * DM * 2;
constexpr size_t WS_KVA = WS_QA + (size_t)TT * 512 * 4;
constexpr size_t WS_KRRAW = WS_KVA + (size_t)TT * 512 * 4;
constexpr size_t WS_SBQ = WS_KRRAW + (size_t)TT * 64 * 4;
constexpr size_t WS_GATE = WS_SBQ + (size_t)TT * 1024 * 2;
constexpr size_t WS_QN = WS_GATE + (size_t)TT * 4096 * 2;
constexpr size_t WS_LATB = WS_QN + (size_t)TT * 512 * 2;
constexpr size_t WS_KRB = WS_LATB + (size_t)TP * 512 * 2;
constexpr size_t WS_Q = WS_KRB + (size_t)TP * 64 * 2;
constexpr size_t WS_KVX = WS_Q + (size_t)TT * 3072 * 2 + 4096;
constexpr size_t WS_QLAT = WS_KVX + (size_t)TP * 4096 * 2;
constexpr size_t WS_CTX = WS_QLAT + (size_t)TS * 8192 * 2;
constexpr size_t WS_OA = WS_CTX + (size_t)TS * 8192 * 2;
constexpr size_t WS_OB = WS_OA + (size_t)TT * DM * 2;
constexpr size_t WS_T1 = WS_OB + (size_t)TT * 1024 * 2;
constexpr size_t WS_MRG = WS_T1 + (size_t)TT * DM * 4;
constexpr size_t WS_FFB = WS_MRG + (size_t)TT * DM * 2;
constexpr size_t WS_PP = WS_FFB + (size_t)TT * FF * 2;
constexpr size_t WS_ROPE = WS_PP + (size_t)TT * DM * 4;
constexpr size_t WS_END = WS_ROPE + (size_t)2 * SEQ * 32 * 4;

constexpr int CW_BAR = 4096, CW_Q = 16384;

constexpr int LDS_STAGE = 131072, LDS_MISC = LDS_STAGE, LDS_BYTES = 147456;

typedef __bf16 bf16x2_t __attribute__((ext_vector_type(2)));
typedef float f32x2_t __attribute__((ext_vector_type(2)));
__device__ __forceinline__ unsigned cvt_pk(float lo, float hi) { const f32x2_t v = {lo, hi}; const bf16x2_t b = __builtin_convertvector(v, bf16x2_t); return __builtin_bit_cast(unsigned, b); }
__device__ __forceinline__ float bflo(unsigned w) { return __uint_as_float(w << 16); }
__device__ __forceinline__ float bfhi(unsigned w) { return __uint_as_float(w & 0xffff0000u); }
__device__ __forceinline__ void st_bf16x8(bf16_t* p, f32x4 a, f32x4 b) { u32x4 w; w.x = cvt_pk(a[0], a[1]); w.y = cvt_pk(a[2], a[3]); w.z = cvt_pk(b[0], b[1]); w.w = cvt_pk(b[2], b[3]); *(u32x4*)p = w; }
__device__ __forceinline__ void st_f32x8(float* p, f32x4 a, f32x4 b) { *(f32x4*)p = a; *(f32x4*)(p + 4) = b; }
__device__ __forceinline__ void ld_bf16x8(const bf16_t* p, f32x4& a, f32x4& b) { const u32x4 w = *(const u32x4*)p; a = (f32x4){bflo(w.x), bfhi(w.x), bflo(w.y), bfhi(w.y)}; b = (f32x4){bflo(w.z), bfhi(w.z), bflo(w.w), bfhi(w.w)}; }
__device__ __forceinline__ float sigmoidf_(float x) { return __builtin_amdgcn_rcpf(1.f + __builtin_amdgcn_exp2f(-x * LOG2E)); }
__device__ __forceinline__ float wave_sum(float v) {
#pragma unroll
    for (int o = 1; o < 64; o <<= 1) v += __shfl_xor(v, o);
    return v;
}
__device__ __forceinline__ int tok_pos(int row) { return row < TP ? (row & (SEQ - 1)) : PAST + ((row - TP) & (DSEQ - 1)); }
__device__ __forceinline__ void rope_cs_slow(int pos, int i, float& c, float& s) {
    const float invf = __builtin_amdgcn_exp2f(-(float)i * 0.41524101186092029f);
    const float ang = (float)pos * invf;
    double a = (double)ang * 0.15915494309189535; a -= __builtin_floor(a);
    const float f = (float)a;
    c = __builtin_amdgcn_cosf(f); s = __builtin_amdgcn_sinf(f);
}

__device__ __forceinline__ int phase_tid(int wave_k) { int ln; asm volatile("v_mbcnt_lo_u32_b32 %0, -1, 0\n\tv_mbcnt_hi_u32_b32 %0, -1, %0" : "=v"(ln)); return (wave_k << 6) | ln; }
#define XB_TMO      128
#define XB_XCNT(j)  (256  + 64 * (j))
#define XB_XSUB(j)  (1280 + 64 * (j))
#define XB_XGEN(j)  (2304 + 64 * (j))
#define XB_TOP      3328
#define XB_TOPGEN   3392
#define XCD_BAR_WORDS 3456
#define XB_SPIN_CAP (1u << 22)
__device__ __forceinline__ unsigned xb_ld(unsigned* p)              { return __hip_atomic_load(p, __ATOMIC_RELAXED, __HIP_MEMORY_SCOPE_AGENT); }
__device__ __forceinline__ unsigned xb_add(unsigned* p, unsigned v) { return __hip_atomic_fetch_add(p, v, __ATOMIC_RELAXED, __HIP_MEMORY_SCOPE_AGENT); }
__device__ __forceinline__ unsigned xb_xcc_id() { return (unsigned)__builtin_amdgcn_s_getreg((3 << 11) | 20) & 0xFu; }
#define XB_SPIN(cond, bar) do { unsigned _sp = 0; while (cond) { __builtin_amdgcn_s_sleep(1); \
    if ((++_sp & 255u) == 0u) { if (xb_ld(&(bar)[XB_TMO])) break; if (_sp > XB_SPIN_CAP) { atomicAdd(&(bar)[XB_TMO], 1u); break; } } } } while (0)
struct XcdBarrier { unsigned* bar; unsigned x; volatile LAS unsigned* st; };
__device__ __forceinline__ XcdBarrier xcd_barrier_post(unsigned* bar, volatile LAS unsigned* st) {
    XcdBarrier b; b.bar = bar; b.x = xb_xcc_id(); b.st = st;
    if (threadIdx.x == 0) (void)xb_add(&bar[XB_XCNT(b.x)], 1u);
    return b;
}
__device__ __forceinline__ void xcd_barrier_complete(unsigned* bar, unsigned x, unsigned& nloc, unsigned& nx) {
    const unsigned G = gridDim.x * gridDim.y * gridDim.z;
    unsigned sum, cnt, mine, sp = 0u;
    for (;;) {
        sum = 0u; cnt = 0u; mine = 0u;
#pragma unroll
        for (unsigned j = 0; j < 16; ++j) { const unsigned c = xb_ld(&bar[XB_XCNT(j)]); sum += c; cnt += (c > 0u) ? 1u : 0u; mine = (j == x) ? c : mine; }
        if (sum == G) break;
        __builtin_amdgcn_s_sleep(1);
        if ((++sp & 255u) == 0u) { if (xb_ld(&bar[XB_TMO])) break; if (sp > XB_SPIN_CAP) { atomicAdd(&bar[XB_TMO], 1u); break; } }
    }
    nloc = mine > 0u ? mine : 1u; nx = cnt > 0u ? cnt : 1u;
}
__device__ __forceinline__ void xcd_barrier(const XcdBarrier& b, int wave_k) {
    asm volatile("s_waitcnt vmcnt(0)" ::: "memory");
    __syncthreads();
    if (phase_tid(wave_k) == 0) {
        unsigned* bar = b.bar;
        __builtin_amdgcn_s_waitcnt(0);
        unsigned nloc = b.st[0], nx = b.st[1];
        if (nloc == 0u) { xcd_barrier_complete(bar, b.x, nloc, nx); b.st[0] = nloc; b.st[1] = nx; }
        const unsigned old = xb_add(&bar[XB_XSUB(b.x)], 1u);
        const unsigned gen = old / nloc;
        if (old + 1u == (gen + 1u) * nloc) {
            __builtin_amdgcn_fence(__ATOMIC_RELEASE, "agent");
            asm volatile("s_waitcnt vmcnt(0)" ::: "memory");
            const unsigned og = xb_add(&bar[XB_TOP], 1u);
            const unsigned tg = og / nx;
            if (og + 1u == (tg + 1u) * nx) xb_add(&bar[XB_TOPGEN], 1u);
            else XB_SPIN(xb_ld(&bar[XB_TOPGEN]) == tg, bar);
            __builtin_amdgcn_fence(__ATOMIC_ACQUIRE, "agent");
            xb_add(&bar[XB_XGEN(b.x)], 1u);
            asm volatile("s_waitcnt vmcnt(0)" ::: "memory");
        } else {
            XB_SPIN(xb_ld(&bar[XB_XGEN(b.x)]) == gen, bar);
            __builtin_amdgcn_fence(__ATOMIC_ACQUIRE, "agent");
            asm volatile("s_waitcnt vmcnt(0)" ::: "memory");
        }
    }
    __syncthreads();
}

namespace pg8 {
constexpr int BM = 256, BK = 64, HALF = 128, HTB = HALF * BK * 2, NXCD = 8, WGM = 8;
__host__ __device__ __forceinline__ int lds_byte(int r, int c) { const int st = (r >> 4) * 2 + (c >> 5), rr = r & 15, cc = c & 31, ob = rr * 64 + cc * 2; return st * 1024 + (ob ^ (((ob >> 9) & 1) << 5)); }
__host__ __device__ __forceinline__ void stage_rc(int b, int& R, int& C) { const int st = b / 1024, sb = b % 1024, swz = sb ^ (((sb >> 9) & 1) << 5); R = (st >> 1) * 16 + swz / 64; C = (st & 1) * 32 + (swz % 64) / 2; }
__host__ __device__ __forceinline__ int perm32(int rho) { const int n = rho >> 4, i = rho & 15; return 8 * (i >> 2) + 4 * n + (i & 3); }

struct Unit { int pm, pn, z; };
template <int K_, int LDA_, int LDB_, int SAZ_ = 0, int SBZ_ = 0, int APN_ = 0> struct Shape { static constexpr int K = K_, lda = LDA_, ldb = LDB_, sAz = SAZ_, sBz = SBZ_, a_pn = APN_; };

struct Order {
    int nM, nN, per, total, G, c, mode;
    __device__ void init(int M, int N, int nz, int G_, int c_, int mode_ = 0) { nM = M / BM; nN = N / BM; per = nM * nN; total = per * nz; G = G_; c = c_; mode = mode_; }
    __device__ bool next(int i, Unit& u) const {
        const long L = (long)i * G + c; if (L >= total) return false;
        const int z = (int)(L / per); int wgid = (int)(L % per);
        { const int q = per / NXCD, r = per % NXCD, xcd = wgid % NXCD, off = wgid / NXCD; wgid = (xcd < r ? xcd * (q + 1) : r * (q + 1) + (xcd - r) * q) + off; }
        const int nig = WGM * nN, gid = wgid / nig, fm = gid * WGM, gsz = (nM - fm) < WGM ? (nM - fm) : WGM;
        u.pm = fm + ((wgid % nig) % gsz); int pn = (wgid % nig) / gsz;
        if (mode == 1) pn = pn < 4 ? pn : (pn == 4 ? 32 : pn - 1); else if (mode == 2) pn += 29;
        u.pn = pn; u.z = z; return true;
    }
};

#define EPI_LOOP(...) \
    _Pragma("unroll") for (int ai = 0; ai < 2; ++ai) _Pragma("unroll") for (int m = 0; m < 4; ++m) { const int row = u.pm * 256 + ai * 128 + wr * 64 + m * 16 + fr; \
    _Pragma("unroll") for (int bj = 0; bj < 2; ++bj) { const int col = u.pn * 256 + bj * 128 + wc * 32 + fq * 8; f32x4 v0 = acc[ai][bj][m][0], v1 = acc[ai][bj][m][1]; __VA_ARGS__ } asm volatile("" ::: "memory"); }

template <class g, class Epi>
__device__ __forceinline__ void gemm_phase(LAS unsigned char* lds, int wave_k, const bf16_t* gA, const bf16_t* gBt, const Order& S, const Epi& E) {
    const int tid = phase_tid(wave_k);
    const int wid = __builtin_amdgcn_readfirstlane(tid >> 6), lane = tid & 63, wr = wid >> 2, wc = wid & 3, fr = lane & 15, fq = lane >> 4;
    constexpr int K = g::K, nt = K / BK;
    unsigned voffA[2], voffB[2];
#pragma unroll
    for (int i = 0; i < 2; ++i) { int R, C; stage_rc(tid * 16 + i * 8192, R, C); const int Rb = (R & ~31) + perm32(R & 31);
        voffA[i] = (unsigned)(R * g::lda + C) * 2u; voffB[i] = (unsigned)(Rb * g::ldb + C) * 2u; }
    const size_t kstep = (size_t)(BK * 2);
    constexpr size_t hstepA = (size_t)HALF * g::lda * 2, hstepB = (size_t)HALF * g::ldb * 2;
    constexpr size_t tstepA = 2 * hstepA, tstepB = 2 * hstepB;
    const unsigned ldsw = (unsigned)wid * 1024u;
    const int aoff = lds_byte(wr * 64 + fr, fq * 8), boff = lds_byte(wc * 32 + fr, fq * 8);
#define PG8_UA(u_) ((const char*)gA + ((size_t)(u_).z * g::sAz + (size_t)(u_).pn * (size_t)g::a_pn) * 2 + (size_t)(u_).pm * tstepA)
#define PG8_UB(u_) ((const char*)gBt + (size_t)(u_).z * g::sBz * 2 + (size_t)(u_).pn * tstepB)
#define PG8_SA(b, h) (((b) * 2 + (h)) * HTB)
#define PG8_SB(b, h) ((4 + (b) * 2 + (h)) * HTB)
#define PG8_STAGE(bufoff, gbase, voff) do { _Pragma("unroll") for (int _i = 0; _i < 2; ++_i) \
        __builtin_amdgcn_global_load_lds((const unsigned*)((const char*)(gbase) + (voff)[_i]), (LAS unsigned*)(lds + (bufoff) + ldsw + _i * 8192), 16, 0, 0); } while (0)
#define PG8_LDA(dst, b, h) do { _Pragma("unroll") for (int m = 0; m < 4; ++m) _Pragma("unroll") for (int k = 0; k < 2; ++k) dst[m][k] = *(const LAS bf16x8*)(lds + PG8_SA(b, h) + aoff + m * 2048 + k * 1024); } while (0)
#define PG8_LDB(dst, b, h) do { _Pragma("unroll") for (int n = 0; n < 2; ++n) _Pragma("unroll") for (int k = 0; k < 2; ++k) dst[n][k] = *(const LAS bf16x8*)(lds + PG8_SB(b, h) + boff + n * 2048 + k * 1024); } while (0)
#define PG8_MMA(ai, bj, At, Bt) do { __builtin_amdgcn_s_setprio(1); _Pragma("unroll") for (int m = 0; m < 4; ++m) _Pragma("unroll") for (int n = 0; n < 2; ++n) _Pragma("unroll") for (int k = 0; k < 2; ++k) \
        acc[ai][bj][m][n] = __builtin_amdgcn_mfma_f32_16x16x32_bf16(Bt[n][k], At[m][k], acc[ai][bj][m][n], 0, 0, 0); __builtin_amdgcn_s_setprio(0); } while (0)
#define PG8_WAIT_V(n) asm volatile("s_waitcnt vmcnt(" #n ")" ::: "memory")
#define PG8_WAIT_L(n) asm volatile("s_waitcnt lgkmcnt(" #n ")" ::: "memory")
#define PG8_BAR __builtin_amdgcn_s_barrier()
#define PG8_SCHED __builtin_amdgcn_sched_barrier(0)
    Unit cur, nxt; int ui = 0;
    if (!S.next(0, cur)) return;
    f32x4 acc[2][2][4][2];
#pragma unroll
    for (int a = 0; a < 2; ++a)
#pragma unroll
        for (int b = 0; b < 2; ++b)
#pragma unroll
            for (int m = 0; m < 4; ++m)
#pragma unroll
                for (int n = 0; n < 2; ++n) acc[a][b][m][n] = (f32x4){0.f, 0.f, 0.f, 0.f};
    bf16x8 At[4][2], B0[2][2], B1[2][2];
    const char* cA = PG8_UA(cur); const char* cB = PG8_UB(cur);
    PG8_STAGE(PG8_SB(0, 0), cB, voffB); PG8_STAGE(PG8_SB(0, 1), cB + hstepB, voffB); PG8_STAGE(PG8_SA(0, 0), cA, voffA); PG8_STAGE(PG8_SA(0, 1), cA + hstepA, voffA);
    if (wr == 1) PG8_BAR;
    PG8_WAIT_V(2); PG8_BAR;
    PG8_STAGE(PG8_SB(1, 0), cB + kstep, voffB); PG8_STAGE(PG8_SA(1, 0), cA + kstep, voffA); PG8_STAGE(PG8_SB(1, 1), cB + hstepB + kstep, voffB);
    PG8_WAIT_V(6); PG8_BAR;
    for (;;) {
        const bool has_next = S.next(ui + 1, nxt);
        const char* nA = has_next ? PG8_UA(nxt) : cA; const char* nB = has_next ? PG8_UB(nxt) : cB;
#pragma unroll 1
        for (int t = 0; t < nt; t += 2) {
            const bool last = (t == nt - 2);
            const char* a1 = cA + (size_t)(t + 1) * kstep;
            const char* a2 = last ? nA : cA + (size_t)(t + 2) * kstep; const char* b2 = last ? nB : cB + (size_t)(t + 2) * kstep;
            const char* a3 = a2 + kstep; const char* b3 = b2 + kstep;
            PG8_LDB(B0, 0, 0); PG8_LDB(B1, 0, 1); PG8_SCHED; PG8_LDA(At, 0, 0); PG8_STAGE(PG8_SA(1, 1), a1 + hstepA, voffA);
            PG8_WAIT_V(8); PG8_WAIT_L(0); PG8_BAR; PG8_MMA(0, 0, At, B0); PG8_MMA(0, 1, At, B1); PG8_BAR; PG8_SCHED;
            PG8_LDA(At, 0, 1); PG8_STAGE(PG8_SB(0, 0), b2, voffB); PG8_STAGE(PG8_SB(0, 1), b2 + hstepB, voffB); PG8_STAGE(PG8_SA(0, 0), a2, voffA);
            PG8_WAIT_V(8); PG8_WAIT_L(0); PG8_BAR; PG8_MMA(1, 0, At, B0); PG8_MMA(1, 1, At, B1); PG8_BAR; PG8_SCHED;
            PG8_LDB(B0, 1, 0); PG8_LDB(B1, 1, 1); PG8_SCHED; PG8_LDA(At, 1, 0); PG8_STAGE(PG8_SA(0, 1), a2 + hstepA, voffA);
            PG8_WAIT_V(8); PG8_WAIT_L(0); PG8_BAR; PG8_MMA(0, 0, At, B0); PG8_MMA(0, 1, At, B1); PG8_BAR; PG8_SCHED;
            PG8_LDA(At, 1, 1); PG8_STAGE(PG8_SB(1, 0), b3, voffB); PG8_STAGE(PG8_SB(1, 1), b3 + hstepB, voffB); PG8_STAGE(PG8_SA(1, 0), a3, voffA);
            PG8_WAIT_V(8); PG8_WAIT_L(0); PG8_BAR; PG8_MMA(1, 0, At, B0); PG8_MMA(1, 1, At, B1); PG8_BAR; PG8_SCHED;
        }
        if (wr == 0) PG8_BAR;
        { const Unit& u = cur; EPI_LOOP( E.apply(row, col, u.z, v0, v1); ) }
        if (!has_next) break;
#pragma unroll
        for (int a = 0; a < 2; ++a)
#pragma unroll
            for (int b = 0; b < 2; ++b)
#pragma unroll
                for (int m = 0; m < 4; ++m)
#pragma unroll
                    for (int n = 0; n < 2; ++n) acc[a][b][m][n] = (f32x4){0.f, 0.f, 0.f, 0.f};
        cur = nxt; cA = nA; cB = nB; ++ui;
        if (wr == 1) PG8_BAR;
    }
    PG8_WAIT_V(0);
    PG8_BAR;
#undef PG8_UA
#undef PG8_UB
#undef PG8_SA
#undef PG8_SB
#undef PG8_STAGE
#undef PG8_LDA
#undef PG8_LDB
#undef PG8_MMA
#undef PG8_WAIT_V
#undef PG8_WAIT_L
#undef PG8_BAR
#undef PG8_SCHED
}

struct EpiIn {
    float* QA; float* KVA; float* KRRAW; bf16_t* SBQ; bf16_t* GATE; float* k_p; float* k_s; float* v_p; float* v_s; const float* bgate;
    __device__ __forceinline__ void apply(int row, int col, int z, f32x4 v0, f32x4 v1) const {
        const int pn = col >> 8;
        if (pn < 2) st_f32x8(QA + (unsigned)(row * 512 + col), v0, v1);
        else if (pn < 4) st_f32x8(KVA + (unsigned)(row * 512 + col - 512), v0, v1);
        else if (pn < 8) st_bf16x8(SBQ + (unsigned)(row * 1024 + col - 1024), v0, v1);
        else if (pn < 12) { float* d = row < TP ? k_p : k_s - (size_t)TP * 1024; st_f32x8(d + (unsigned)(row * 1024 + col - 2048), v0, v1); }
        else if (pn < 16) { float* d = row < TP ? v_p : v_s - (size_t)TP * 1024; st_f32x8(d + (unsigned)(row * 1024 + col - 3072), v0, v1); }
        else if (pn < 32) { const unsigned c = (unsigned)(col - 4096); const f32x4 b0 = *(const f32x4*)(bgate + c), b1 = *(const f32x4*)(bgate + c + 4); f32x4 g0, g1;
#pragma unroll
            for (int j = 0; j < 4; ++j) { g0[j] = sigmoidf_(v0[j] + b0[j]); g1[j] = sigmoidf_(v1[j] + b1[j]); }
            st_bf16x8(GATE + ((unsigned)(row * 4096) + c), g0, g1); }
        else { const int c = col - 8192; if (c < 64) st_f32x8(KRRAW + (unsigned)(row * 64 + c), v0, v1); }
    }
};
struct EpiQ {
    bf16_t* Q; const float* ROPE;
    __device__ __forceinline__ void apply(int row, int col, int z, f32x4 v0, f32x4 v1) const {
        const int h = col / 192, w = col - h * 192;
        if (w >= 128) { const int pos = tok_pos(row), i0 = (w - 128) >> 1; const f32x4 c = *(const f32x4*)(ROPE + pos * 32 + i0), s = *(const f32x4*)(ROPE + SEQ * 32 + pos * 32 + i0);
            { const float a = v0[0], b = v0[1]; v0[0] = a * c[0] - b * s[0]; v0[1] = b * c[0] + a * s[0]; }
            { const float a = v0[2], b = v0[3]; v0[2] = a * c[1] - b * s[1]; v0[3] = b * c[1] + a * s[1]; }
            { const float a = v1[0], b = v1[1]; v1[0] = a * c[2] - b * s[2]; v1[1] = b * c[2] + a * s[2]; }
            { const float a = v1[2], b = v1[3]; v1[2] = a * c[3] - b * s[3]; v1[3] = b * c[3] + a * s[3]; } }
        st_bf16x8(Q + (unsigned)(row * 3072 + col), v0, v1);
    }
};
struct EpiBf16 {
    bf16_t* O; int ldc; int zoff;
    __device__ __forceinline__ void apply(int row, int col, int z, f32x4 v0, f32x4 v1) const { st_bf16x8(O + (unsigned)(row * ldc + z * zoff + col), v0, v1); }
};
struct EpiF32 {
    float* O; int ldc;
    __device__ __forceinline__ void apply(int row, int col, int z, f32x4 v0, f32x4 v1) const { st_f32x8(O + (unsigned)(row * ldc + col), v0, v1); }
};
struct EpiBrB {
    float* T1; const bf16_t* GATE;
    __device__ __forceinline__ void apply(int row, int col, int z, f32x4 v0, f32x4 v1) const {
        f32x4 g0, g1; ld_bf16x8(GATE + (unsigned)(row * 4096 + 2048 + col), g0, g1); st_f32x8(T1 + (unsigned)(row * DM + col), v0 * g0, v1 * g1); }
};
struct EpiBrA {
    bf16_t* MRG; const float* T1; const bf16_t* GATE;
    __device__ __forceinline__ void apply(int row, int col, int z, f32x4 v0, f32x4 v1) const {
        f32x4 g0, g1; ld_bf16x8(GATE + (unsigned)(row * 4096 + col), g0, g1); const float* t = T1 + (unsigned)(row * DM + col);
        const f32x4 t0 = *(const f32x4*)t, t1 = *(const f32x4*)(t + 4); st_bf16x8(MRG + (unsigned)(row * DM + col), t0 + v0 * g0, t1 + v1 * g1); }
};
struct EpiRes {
    float* Y; const float* X;
    __device__ __forceinline__ void apply(int row, int col, int z, f32x4 v0, f32x4 v1) const {
        const float* x = X + (unsigned)(row * DM + col); const f32x4 x0 = *(const f32x4*)x, x1 = *(const f32x4*)(x + 4);
        st_f32x8(Y + (unsigned)(row * DM + col), x0 * ALPHA + v0, x1 * ALPHA + v1); }
};
struct EpiGU {
    bf16_t* FFB;
    __device__ __forceinline__ void apply(int row, int col, int z, f32x4 v0, f32x4 v1) const {
        f32x4 r;
#pragma unroll
        for (int j = 0; j < 4; ++j) r[j] = v0[j] * sigmoidf_(v0[j]) * v1[j];
        u32x2 w; w.x = cvt_pk(r[0], r[1]); w.y = cvt_pk(r[2], r[3]); *(u32x2*)(FFB + (unsigned)(row * FF + (col >> 1))) = w; }
};
struct EpiPle {
    float* Y; const float* X; const float* PP; const float* bias;
    __device__ __forceinline__ void apply(int row, int col, int z, f32x4 v0, f32x4 v1) const {
        const unsigned o = (unsigned)(row * DM + col); const f32x4 x0 = *(const f32x4*)(X + o), x1 = *(const f32x4*)(X + o + 4), p0 = *(const f32x4*)(PP + o), p1 = *(const f32x4*)(PP + o + 4);
        const f32x4 b0 = *(const f32x4*)(bias + (unsigned)col), b1 = *(const f32x4*)(bias + (unsigned)col + 4); f32x4 r0, r1;
#pragma unroll
        for (int j = 0; j < 4; ++j) { r0[j] = x0[j] * ALPHA + sigmoidf_(v0[j] + b0[j]) * p0[j]; r1[j] = x1[j] * ALPHA + sigmoidf_(v1[j] + b1[j]) * p1[j]; }
        st_f32x8(Y + o, r0, r1); }
};

template <int K, int LDA, int LDB, int APN, class Epi>
__device__ __forceinline__ void gemm_small(LAS unsigned char* lds, int wave_k, const bf16_t* gA, const bf16_t* gBt, int row0, int n_rt, int n_ct, int G, int c, const Epi& E) {
    const int tid = phase_tid(wave_k);
    const int wid = __builtin_amdgcn_readfirstlane(tid >> 6), lane = tid & 63, wc = wid & 1, wm = wid >> 1, fr = lane & 15, fq = lane >> 4;
    constexpr int nt = K / 64;
    int R, C; stage_rc(tid * 16, R, C);
    const int Rb = (R & ~31) + perm32(R & 31);
    const unsigned voffA = (unsigned)(R * LDA + C) * 2u, voffB = (unsigned)(Rb * LDB + C) * 2u;
    const unsigned ldsw = (unsigned)wid * 1024u;
    const int aoff = lds_byte(wm * 16 + fr, fq * 8), boff = lds_byte(wc * 32 + fr, fq * 8);
#define SM_STAGE(slot, pa, pb) do { \
        __builtin_amdgcn_global_load_lds((const unsigned*)((pa) + voffA), (LAS unsigned*)(lds + (slot) * 16384 + ldsw), 16, 0, 0); \
        __builtin_amdgcn_global_load_lds((const unsigned*)((pb) + voffB), (LAS unsigned*)(lds + (slot) * 16384 + 8192 + ldsw), 16, 0, 0); } while (0)
    for (int u = c; u < n_rt * n_ct; u += G) {
        const int xcd = u & 7, idx = u >> 3, rt = idx % n_rt, ct = xcd * (n_ct >> 3) + idx / n_rt;
        const char* pa = (const char*)gA + ((size_t)(row0 + rt * 64) * LDA + (size_t)(ct >> 2) * APN) * 2;
        const char* pb = (const char*)gBt + (size_t)(ct * 64) * LDB * 2;
        f32x4 acc0 = (f32x4){0.f, 0.f, 0.f, 0.f}, acc1 = acc0;
        SM_STAGE(0, pa, pb); SM_STAGE(1, pa + 128, pb + 128); SM_STAGE(2, pa + 256, pb + 256);
#pragma unroll 1
        for (int t = 0; t < nt; ++t) {
            asm volatile("s_waitcnt vmcnt(4)" ::: "memory");
            __builtin_amdgcn_s_barrier();
            { const int tn = (t + 3 < nt) ? t + 3 : nt - 1;
              SM_STAGE((t + 3) & 3, pa + (size_t)tn * 128, pb + (size_t)tn * 128); }
            const LAS unsigned char* sl = lds + (t & 3) * 16384;
            const bf16x8 a0 = *(const LAS bf16x8*)(sl + aoff), a1 = *(const LAS bf16x8*)(sl + aoff + 1024);
            const bf16x8 b00 = *(const LAS bf16x8*)(sl + 8192 + boff), b01 = *(const LAS bf16x8*)(sl + 8192 + boff + 1024);
            const bf16x8 b10 = *(const LAS bf16x8*)(sl + 8192 + boff + 2048), b11 = *(const LAS bf16x8*)(sl + 8192 + boff + 2048 + 1024);
            acc0 = __builtin_amdgcn_mfma_f32_16x16x32_bf16(b00, a0, acc0, 0, 0, 0); acc1 = __builtin_amdgcn_mfma_f32_16x16x32_bf16(b10, a0, acc1, 0, 0, 0);
            acc0 = __builtin_amdgcn_mfma_f32_16x16x32_bf16(b01, a1, acc0, 0, 0, 0); acc1 = __builtin_amdgcn_mfma_f32_16x16x32_bf16(b11, a1, acc1, 0, 0, 0);
        }
        asm volatile("s_waitcnt vmcnt(0)" ::: "memory");
        __builtin_amdgcn_s_barrier();
        E.apply(row0 + rt * 64 + wm * 16 + fr, ct * 64 + wc * 32 + fq * 8, 0, acc0, acc1);
    }
#undef SM_STAGE
}
}

template <int OFF> __device__ __forceinline__ s16x4 tr_read(unsigned addr) {
    s16x4 r; asm volatile("ds_read_b64_tr_b16 %0, %1 offset:%2" : "=&v"(r) : "v"(addr), "i"(OFF) : "memory"); return r;
}
#define PKTR(L, H) ((bf16x8){L[0], L[1], L[2], L[3], H[0], H[1], H[2], H[3]})
__device__ __forceinline__ bf16x8 pack8(float a0, float a1, float a2, float a3, float a4, float a5, float a6, float a7) {
    u32x4 w; w.x = cvt_pk(a0, a1); w.y = cvt_pk(a2, a3); w.z = cvt_pk(a4, a5); w.w = cvt_pk(a6, a7); return __builtin_bit_cast(bf16x8, w);
}
constexpr int AV_ROW = 320;
template <int DBLK> __device__ __forceinline__ void pv_block(f32x16& od, unsigned vaddr, const bf16x8 (&pb)[4]) {
    const s16x4 l0 = tr_read<(0 * 16 + 0) * AV_ROW + DBLK * 64>(vaddr), h0 = tr_read<(0 * 16 + 8) * AV_ROW + DBLK * 64>(vaddr);
    const s16x4 l1 = tr_read<(1 * 16 + 0) * AV_ROW + DBLK * 64>(vaddr), h1 = tr_read<(1 * 16 + 8) * AV_ROW + DBLK * 64>(vaddr);
    const s16x4 l2 = tr_read<(2 * 16 + 0) * AV_ROW + DBLK * 64>(vaddr), h2 = tr_read<(2 * 16 + 8) * AV_ROW + DBLK * 64>(vaddr);
    const s16x4 l3 = tr_read<(3 * 16 + 0) * AV_ROW + DBLK * 64>(vaddr), h3 = tr_read<(3 * 16 + 8) * AV_ROW + DBLK * 64>(vaddr);
    asm volatile("s_waitcnt lgkmcnt(0)" ::: "memory"); __builtin_amdgcn_sched_barrier(0);
    od = __builtin_amdgcn_mfma_f32_32x32x16_bf16(PKTR(l0, h0), pb[0], od, 0, 0, 0);
    od = __builtin_amdgcn_mfma_f32_32x32x16_bf16(PKTR(l1, h1), pb[1], od, 0, 0, 0);
    od = __builtin_amdgcn_mfma_f32_32x32x16_bf16(PKTR(l2, h2), pb[2], od, 0, 0, 0);
    od = __builtin_amdgcn_mfma_f32_32x32x16_bf16(PKTR(l3, h3), pb[3], od, 0, 0, 0);
}

constexpr int AK_ROW = 400, AK_TILE = 64 * AK_ROW, AV_TILE = 64 * AV_ROW;
__device__ __forceinline__ void attn_mla_prompt(LAS unsigned char* lds, int wave_k, const bf16_t* __restrict__ Q, const bf16_t* __restrict__ KVX, const bf16_t* __restrict__ KRB,
                                                bf16_t* __restrict__ OA, int b, int h, int qb) {
    const int tid = phase_tid(wave_k);
    const int wid = __builtin_amdgcn_readfirstlane(tid >> 6), lane = tid & 63, r32 = lane & 31, hi = lane >> 5;
    const int NT = 4 * qb + 4, my_last = 4 * qb + (wid >> 1);
    const int tok = b * SEQ + qb * 256 + wid * 32 + r32;
    bf16x8 qr[12];
    { const bf16_t* qp = Q + (size_t)tok * 3072 + h * 192 + hi * 8;
#pragma unroll
      for (int s = 0; s < 12; ++s) qr[s] = *(const bf16x8*)(qp + 16 * s); }
    f32x16 o[4];
#pragma unroll
    for (int d = 0; d < 4; ++d)
#pragma unroll
        for (int r = 0; r < 16; ++r) o[d][r] = 0.f;
    float m_run = -INFINITY, l_run = 0.f;
    const bf16_t* kbase = KVX + (size_t)(b * SEQ) * 4096 + h * 256;
    const bf16_t* rbase = KRB + (size_t)(b * SEQ) * 64;
    const int r0 = tid >> 4, c0 = tid & 15, rr = tid >> 3, rc = tid & 7;
    u32x4 sk0, sk1, sr, sv0, sv1;
#define A_LOAD(kt) do { const bf16_t* kp = kbase + (size_t)((kt) * 64 + r0) * 4096 + c0 * 8; \
        sk0 = *(const u32x4*)kp; sk1 = *(const u32x4*)(kp + (size_t)32 * 4096); sv0 = *(const u32x4*)(kp + 128); sv1 = *(const u32x4*)(kp + (size_t)32 * 4096 + 128); \
        sr = *(const u32x4*)(rbase + (size_t)((kt) * 64 + rr) * 64 + rc * 8); } while (0)
#define A_WRITE(buf) do { LAS unsigned char* Kb = lds + (buf) * AK_TILE; LAS unsigned char* Vb = lds + 2 * AK_TILE + (buf) * AV_TILE; \
        *(LAS u32x4*)(Kb + r0 * AK_ROW + c0 * 16) = sk0; *(LAS u32x4*)(Kb + (r0 + 32) * AK_ROW + c0 * 16) = sk1; *(LAS u32x4*)(Kb + rr * AK_ROW + 256 + rc * 16) = sr; \
        *(LAS u32x4*)(Vb + r0 * AV_ROW + c0 * 16) = sv0; *(LAS u32x4*)(Vb + (r0 + 32) * AV_ROW + c0 * 16) = sv1; } while (0)
    const unsigned ldsb = (unsigned)(uintptr_t)lds;
    const unsigned vaddr0 = ldsb + 2 * AK_TILE + (4 * hi + ((lane & 15) >> 2)) * AV_ROW + (16 * ((lane >> 4) & 1) + 4 * (lane & 3)) * 2;
    __syncthreads();
    A_LOAD(0); A_WRITE(0);
    for (int kt = 0; kt < NT; ++kt) {
        __syncthreads();
        if (kt + 1 < NT) A_LOAD(kt + 1);
        if (kt <= my_last) {
            const int buf = kt & 1;
            const LAS unsigned char* Kl = lds + buf * AK_TILE + r32 * AK_ROW + hi * 16;
            f32x16 p0, p1;
#ifdef PROBE_A_QK
            int qreps = 2; asm volatile("" : "+s"(qreps));
            for (int qq = 0; qq < qreps; ++qq) {
#else
            {
#endif
#pragma unroll
            for (int r = 0; r < 16; ++r) { p0[r] = 0.f; p1[r] = 0.f; }
#pragma unroll
            for (int s = 0; s < 12; s += 2) {
                const bf16x8 a0 = *(const LAS bf16x8*)(Kl + s * 32), a1 = *(const LAS bf16x8*)(Kl + 32 * AK_ROW + s * 32);
                const bf16x8 c0 = *(const LAS bf16x8*)(Kl + s * 32 + 32), c1 = *(const LAS bf16x8*)(Kl + 32 * AK_ROW + s * 32 + 32);
                p0 = __builtin_amdgcn_mfma_f32_32x32x16_bf16(a0, qr[s], p0, 0, 0, 0);
                p1 = __builtin_amdgcn_mfma_f32_32x32x16_bf16(a1, qr[s], p1, 0, 0, 0);
                p0 = __builtin_amdgcn_mfma_f32_32x32x16_bf16(c0, qr[s + 1], p0, 0, 0, 0);
                p1 = __builtin_amdgcn_mfma_f32_32x32x16_bf16(c1, qr[s + 1], p1, 0, 0, 0);
                if ((s % 4) == 2) asm volatile("" ::: "memory");
            }
            }
            float tmax = p0[0];
#pragma unroll
            for (int r = 1; r < 16; ++r) tmax = fmaxf(tmax, p0[r]);
#pragma unroll
            for (int r = 0; r < 16; ++r) tmax = fmaxf(tmax, p1[r]);
            tmax = fmaxf(tmax, __shfl_xor(tmax, 32));
            const float mn = fmaxf(m_run, tmax), alpha = __builtin_amdgcn_exp2f((m_run - mn) * MLA_C), mc = mn * MLA_C;
            m_run = mn;
            float ls = 0.f;
#pragma unroll
            for (int r = 0; r < 16; ++r) { p0[r] = __builtin_amdgcn_exp2f(p0[r] * MLA_C - mc); p1[r] = __builtin_amdgcn_exp2f(p1[r] * MLA_C - mc); ls += p0[r] + p1[r]; }
            l_run = l_run * alpha + ls;
#pragma unroll
            for (int d = 0; d < 4; ++d)
#pragma unroll
                for (int r = 0; r < 16; ++r) o[d][r] *= alpha;
            bf16x8 pb[4];
            pb[0] = pack8(p0[0], p0[1], p0[2], p0[3], p0[4], p0[5], p0[6], p0[7]);
            pb[1] = pack8(p0[8], p0[9], p0[10], p0[11], p0[12], p0[13], p0[14], p0[15]);
            pb[2] = pack8(p1[0], p1[1], p1[2], p1[3], p1[4], p1[5], p1[6], p1[7]);
            pb[3] = pack8(p1[8], p1[9], p1[10], p1[11], p1[12], p1[13], p1[14], p1[15]);
            const unsigned va = vaddr0 + buf * AV_TILE;
            pv_block<0>(o[0], va, pb); pv_block<1>(o[1], va, pb); pv_block<2>(o[2], va, pb); pv_block<3>(o[3], va, pb);
#ifdef PROBE_A_PV
            { bf16x8 pz[4]; int zz = 0; asm volatile("" : "+v"(zz));
              _Pragma("unroll") for (int i = 0; i < 4; ++i) pz[i] = (bf16x8){(short)zz, (short)zz, (short)zz, (short)zz, (short)zz, (short)zz, (short)zz, (short)zz};
              pv_block<0>(o[0], va, pz); pv_block<1>(o[1], va, pz); pv_block<2>(o[2], va, pz); pv_block<3>(o[3], va, pz); }
#endif
        }
        if (kt + 1 < NT) A_WRITE((kt + 1) & 1);
    }
#undef A_LOAD
#undef A_WRITE
    const float inv = 1.f / (l_run + __shfl_xor(l_run, 32));
    bf16_t* op = OA + (size_t)tok * DM + h * 128 + 4 * hi;
#pragma unroll
    for (int d = 0; d < 4; ++d)
#pragma unroll
        for (int g = 0; g < 4; ++g) { u32x2 w; w.x = cvt_pk(o[d][4 * g] * inv, o[d][4 * g + 1] * inv); w.y = cvt_pk(o[d][4 * g + 2] * inv, o[d][4 * g + 3] * inv);
            *(u32x2*)(op + 32 * d + 8 * g) = w; }
}

constexpr int BK_ROW = 272, BK_TILE = 64 * BK_ROW;
constexpr int SB_FLAG_OFF = 2 * BK_TILE + 2 * AV_TILE;
__device__ __forceinline__ void sb_half(f32x16& p, int kbase, int qpos, float& run, int hi) {
    f32x16 L;
#pragma unroll
    for (int r = 0; r < 16; ++r) {
        const int kk = kbase + (r & 3) + 8 * (r >> 2);
        const float z = p[r] * SB_SCALE; const float e = __builtin_amdgcn_exp2f(-fabsf(z) * LOG2E); const float sp = __builtin_amdgcn_logf(1.f + e) * LN2;
        const bool bef = kk < qpos; const float madd = bef ? 0.f : -1e30f, mmul = bef ? 1.f : 0.f;
        p[r] = (fminf(z, 0.f) - sp) + madd; L[r] = (fminf(-z, 0.f) - sp) * mmul;
    }
    float qs[4], pq[4];
#pragma unroll
    for (int g = 0; g < 4; ++g) { qs[g] = (L[4 * g] + L[4 * g + 1]) + (L[4 * g + 2] + L[4 * g + 3]); pq[g] = __shfl_xor(qs[g], 32); }
#pragma unroll
    for (int g = 3; g >= 0; --g) {
        const float t3 = run + (hi == 0 ? pq[g] : 0.f), t2 = t3 + L[4 * g + 3], t1 = t2 + L[4 * g + 2], t0 = t1 + L[4 * g + 1];
        p[4 * g + 3] = __builtin_amdgcn_exp2f((p[4 * g + 3] + t3) * LOG2E); p[4 * g + 2] = __builtin_amdgcn_exp2f((p[4 * g + 2] + t2) * LOG2E);
        p[4 * g + 1] = __builtin_amdgcn_exp2f((p[4 * g + 1] + t1) * LOG2E); p[4 * g + 0] = __builtin_amdgcn_exp2f((p[4 * g + 0] + t0) * LOG2E);
        run += qs[g] + pq[g];
    }
}
struct SbSrc { const float* k_main; const float* v_main; const float* k_new; const float* v_new; int new_tile; };
__device__ __forceinline__ void attn_sb(LAS unsigned char* lds, int wave_k, const bf16_t* __restrict__ Qrow0  , const SbSrc src, bf16_t* __restrict__ Orow0  ,
                                        int kt_top, int nwact  , int qpos0  , int top_shift  ) {
    const int tid = phase_tid(wave_k);
    const int wid = __builtin_amdgcn_readfirstlane(tid >> 6), lane = tid & 63, r32 = lane & 31, hi = lane >> 5;
    const bool wact = wid < nwact;
    const int my_top = top_shift ? kt_top - ((7 - wid) >> 1) : kt_top;
    const int qpos = qpos0 + wid * 32 + r32;
    bf16x8 qr[8];
    if (wact) { const bf16_t* qp = Qrow0 + (size_t)(wid * 32 + r32) * 1024 + hi * 8;
#pragma unroll
        for (int s = 0; s < 8; ++s) qr[s] = *(const bf16x8*)(qp + 16 * s); }
    else {
#pragma unroll
        for (int s = 0; s < 8; ++s) qr[s] = (bf16x8){0, 0, 0, 0, 0, 0, 0, 0}; }
    f32x16 o[4];
#pragma unroll
    for (int d = 0; d < 4; ++d)
#pragma unroll
        for (int r = 0; r < 16; ++r) o[d][r] = 0.f;
    float carry = 0.f;
    const int srow = tid >> 3, scol = (tid & 7) * 16;
    f32x4 fk[4], fv[4];
#define B_LOADK(kt) do { const bool isnew = ((kt) == src.new_tile); const bool valid = !isnew || srow < 32; \
        const float* kp = (isnew ? src.k_new : src.k_main + (size_t)(kt) * 64 * 1024) + (size_t)srow * 1024 + scol; \
        if (valid) { _Pragma("unroll") for (int j = 0; j < 4; ++j) fk[j] = *(const f32x4*)(kp + 4 * j); } \
        else { _Pragma("unroll") for (int j = 0; j < 4; ++j) fk[j] = (f32x4){0.f, 0.f, 0.f, 0.f}; } } while (0)
#define B_LOADV(kt) do { const bool isnew = ((kt) == src.new_tile); const bool valid = !isnew || srow < 32; \
        const float* vp = (isnew ? src.v_new : src.v_main + (size_t)(kt) * 64 * 1024) + (size_t)srow * 1024 + scol; \
        if (valid) { _Pragma("unroll") for (int j = 0; j < 4; ++j) fv[j] = *(const f32x4*)(vp + 4 * j); } \
        else { _Pragma("unroll") for (int j = 0; j < 4; ++j) fv[j] = (f32x4){0.f, 0.f, 0.f, 0.f}; } } while (0)
#define B_WRITE(buf) do { LAS unsigned char* Kb = lds + (buf) * BK_TILE + srow * BK_ROW + scol * 2; LAS unsigned char* Vb = lds + 2 * BK_TILE + (buf) * AV_TILE + srow * AV_ROW + scol * 2; \
        u32x4 w; w.x = cvt_pk(fk[0][0], fk[0][1]); w.y = cvt_pk(fk[0][2], fk[0][3]); w.z = cvt_pk(fk[1][0], fk[1][1]); w.w = cvt_pk(fk[1][2], fk[1][3]); *(LAS u32x4*)Kb = w; \
        w.x = cvt_pk(fk[2][0], fk[2][1]); w.y = cvt_pk(fk[2][2], fk[2][3]); w.z = cvt_pk(fk[3][0], fk[3][1]); w.w = cvt_pk(fk[3][2], fk[3][3]); *(LAS u32x4*)(Kb + 16) = w; \
        w.x = cvt_pk(fv[0][0], fv[0][1]); w.y = cvt_pk(fv[0][2], fv[0][3]); w.z = cvt_pk(fv[1][0], fv[1][1]); w.w = cvt_pk(fv[1][2], fv[1][3]); *(LAS u32x4*)Vb = w; \
        w.x = cvt_pk(fv[2][0], fv[2][1]); w.y = cvt_pk(fv[2][2], fv[2][3]); w.z = cvt_pk(fv[3][0], fv[3][1]); w.w = cvt_pk(fv[3][2], fv[3][3]); *(LAS u32x4*)(Vb + 16) = w; } while (0)
    const unsigned ldsb = (unsigned)(uintptr_t)lds;
    const unsigned vaddr0 = ldsb + 2 * BK_TILE + (4 * hi + ((lane & 15) >> 2)) * AV_ROW + (16 * ((lane >> 4) & 1) + 4 * (lane & 3)) * 2;
    volatile LAS unsigned* flags = (volatile LAS unsigned*)(lds + SB_FLAG_OFF);
    __syncthreads();
    if (tid < 16) flags[tid] = 0u;
    B_LOADK(kt_top); B_LOADV(kt_top); B_WRITE(kt_top & 1);
    for (int kt = kt_top; kt >= 0; --kt) {
        __syncthreads();
        if (kt != kt_top) {
            unsigned alld = 1u;
#pragma unroll
            for (int w = 0; w < 8; ++w) alld &= flags[((kt + 1) & 1) * 8 + w];
#ifndef DBG_NO_EXIT
            if (alld) break;
        }
        unsigned mydone = wact ? 0u : 1u;
        const bool act = wact && kt <= my_top;
        const int buf = kt & 1;
        f32x16 p0, p1;
#pragma unroll
        for (int r = 0; r < 16; ++r) { p0[r] = 0.f; p1[r] = 0.f; }
        if (act) {
            const LAS unsigned char* Kl = lds + buf * BK_TILE + r32 * BK_ROW + hi * 16;
#pragma unroll
            for (int s = 0; s < 8; s += 2) {
                const bf16x8 a0 = *(const LAS bf16x8*)(Kl + s * 32), a1 = *(const LAS bf16x8*)(Kl + 32 * BK_ROW + s * 32);
                const bf16x8 c0 = *(const LAS bf16x8*)(Kl + s * 32 + 32), c1 = *(const LAS bf16x8*)(Kl + 32 * BK_ROW + s * 32 + 32);
                p0 = __builtin_amdgcn_mfma_f32_32x32x16_bf16(a0, qr[s], p0, 0, 0, 0);
                p1 = __builtin_amdgcn_mfma_f32_32x32x16_bf16(a1, qr[s], p1, 0, 0, 0);
                p0 = __builtin_amdgcn_mfma_f32_32x32x16_bf16(c0, qr[s + 1], p0, 0, 0, 0);
                p1 = __builtin_amdgcn_mfma_f32_32x32x16_bf16(c1, qr[s + 1], p1, 0, 0, 0);
                if ((s & 3) == 2) asm volatile("" ::: "memory");
            }
            float run = carry;
            sb_half(p1, kt * 64 + 32 + 4 * hi, qpos, run, hi);
            __builtin_amdgcn_sched_barrier(0);
            sb_half(p0, kt * 64 + 4 * hi, qpos, run, hi);
            carry = run;
        }
        asm volatile("" ::: "memory");
        if (kt > 0) { B_LOADK(kt - 1); B_LOADV(kt - 1); }
        if (act) {
            bf16x8 pb[4];
            pb[0] = pack8(p0[0], p0[1], p0[2], p0[3], p0[4], p0[5], p0[6], p0[7]);
            pb[1] = pack8(p0[8], p0[9], p0[10], p0[11], p0[12], p0[13], p0[14], p0[15]);
            pb[2] = pack8(p1[0], p1[1], p1[2], p1[3], p1[4], p1[5], p1[6], p1[7]);
            pb[3] = pack8(p1[8], p1[9], p1[10], p1[11], p1[12], p1[13], p1[14], p1[15]);
            const unsigned va = vaddr0 + buf * AV_TILE;
            pv_block<0>(o[0], va, pb); pv_block<1>(o[1], va, pb); pv_block<2>(o[2], va, pb); pv_block<3>(o[3], va, pb);
            mydone = __all(carry < -110.f) ? 1u : 0u;
        }
        if (lane == 0) flags[(kt & 1) * 8 + wid] = mydone;
        if (kt > 0) B_WRITE((kt - 1) & 1);
    }
#endif
#undef B_LOADK
#undef B_LOADV
#undef B_WRITE
    if (wact) {
        bf16_t* op = Orow0 + (size_t)(wid * 32 + r32) * 1024 + 4 * hi;
#pragma unroll
        for (int d = 0; d < 4; ++d)
#pragma unroll
            for (int g = 0; g < 4; ++g) { u32x2 w; w.x = cvt_pk(o[d][4 * g], o[d][4 * g + 1]); w.y = cvt_pk(o[d][4 * g + 2], o[d][4 * g + 3]); *(u32x2*)(op + 32 * d + 8 * g) = w; }
    }
}

constexpr int C_ROW = 1184, C_TILE = 32 * C_ROW, C_XOFF = 3 * C_TILE, C_XPB = 0, C_XAL = 8 * 1024;
template <int DT0> __device__ __forceinline__ void pvc8(f32x4 (&o)[32], unsigned vaddr, bf16x8 pb) {
#define PVC1(j) { const s16x4 lo = tr_read<(DT0 + j) * 32>(vaddr), hi_ = tr_read<16 * C_ROW + (DT0 + j) * 32>(vaddr); asm volatile("s_waitcnt lgkmcnt(0)" ::: "memory"); __builtin_amdgcn_sched_barrier(0); \
        o[DT0 + j] = __builtin_amdgcn_mfma_f32_16x16x32_bf16(PKTR(lo, hi_), pb, o[DT0 + j], 0, 0, 0); }
    PVC1(0) PVC1(1) PVC1(2) PVC1(3) PVC1(4) PVC1(5) PVC1(6) PVC1(7)
#undef PVC1
}
__device__ __forceinline__ void attn_mla_sample(LAS unsigned char* lds, int wave_k, const bf16_t* __restrict__ QLAT, const bf16_t* __restrict__ Q, const bf16_t* __restrict__ LATS  ,
                                                const bf16_t* __restrict__ KRS  , bf16_t* __restrict__ CTX, int b, int rg) {
    const int tid = phase_tid(wave_k);
    const int wid = __builtin_amdgcn_readfirstlane(tid >> 6), lane = tid & 63, c16 = lane & 15, g = lane >> 4;
    const bool pvw = wid >= 4; const int j4 = wid & 3;
    const int R = rg * 4 + j4, h = R >> 1, q = (R & 1) * 16 + c16;
    const int srow = b * DSEQ + q;
    f32x4 o[32];
#pragma unroll
    for (int d = 0; d < 32; ++d) o[d] = (f32x4){0.f, 0.f, 0.f, 0.f};
    if (!pvw) { const bf16_t* qp = QLAT + (size_t)srow * 8192 + h * 512 + g * 8;
#pragma unroll
      for (int s = 0; s < 16; ++s) o[s] = *(const f32x4*)(qp + 32 * s);
      const bf16_t* qr_ = Q + (size_t)(TP + srow) * 3072 + h * 192 + 128 + g * 8;
      o[16] = *(const f32x4*)qr_; o[17] = *(const f32x4*)(qr_ + 32); }
    float m_run = -INFINITY, l_run = 0.f;
    u32x4 st[5];
#define C_LOAD(kt) do { _Pragma("unroll") for (int j = 0; j < 4; ++j) { const int ch = tid + 512 * j, r = ch >> 6, c = ch & 63; st[j] = *(const u32x4*)(LATS + (size_t)((kt) * 32 + r) * 512 + c * 8); } \
        if (tid < 256) st[4] = *(const u32x4*)(KRS + (size_t)((kt) * 32 + (tid >> 3)) * 64 + (tid & 7) * 8); } while (0)
#define C_WRITE(buf) do { LAS unsigned char* Tb = lds + (buf) * C_TILE; _Pragma("unroll") for (int j = 0; j < 4; ++j) { const int ch = tid + 512 * j, r = ch >> 6, c = ch & 63; *(LAS u32x4*)(Tb + r * C_ROW + c * 16) = st[j]; } \
        if (tid < 256) *(LAS u32x4*)(Tb + (tid >> 3) * C_ROW + 1024 + (tid & 7) * 16) = st[4]; } while (0)
    const unsigned ldsb = (unsigned)(uintptr_t)lds;
    const unsigned vaddr0 = ldsb + (4 * g + (c16 >> 2)) * C_ROW + (c16 & 3) * 8;
    LAS unsigned char* xpb = lds + C_XOFF + C_XPB + j4 * 1024 + lane * 16;
    LAS unsigned char* xal = lds + C_XOFF + C_XAL + j4 * 256 + lane * 4;
    constexpr int NT = SKEYS / 32;
    __syncthreads();
    C_LOAD(0); C_WRITE(0);
    int tcur = 0, tprev = 2;
    for (int kt = 0; kt <= NT; ++kt) {
        __syncthreads();
        if (kt + 1 < NT) C_LOAD(kt + 1);
        if (!pvw) {
            if (kt < NT) {
                const LAS unsigned char* Kl = lds + tcur * C_TILE + c16 * C_ROW + g * 16;
                f32x4 s0 = (f32x4){0.f, 0.f, 0.f, 0.f}, s1 = s0;
#pragma unroll
                for (int s = 0; s < 18; s += 2) {
                    const bf16x8 a0 = *(const LAS bf16x8*)(Kl + s * 64), a1 = *(const LAS bf16x8*)(Kl + 16 * C_ROW + s * 64);
                    const bf16x8 e0 = *(const LAS bf16x8*)(Kl + s * 64 + 64), e1 = *(const LAS bf16x8*)(Kl + 16 * C_ROW + s * 64 + 64);
                    const bf16x8 qa = __builtin_bit_cast(bf16x8, o[s]), qb = __builtin_bit_cast(bf16x8, o[s + 1]);
                    s0 = __builtin_amdgcn_mfma_f32_16x16x32_bf16(a0, qa, s0, 0, 0, 0);
                    s1 = __builtin_amdgcn_mfma_f32_16x16x32_bf16(a1, qa, s1, 0, 0, 0);
                    s0 = __builtin_amdgcn_mfma_f32_16x16x32_bf16(e0, qb, s0, 0, 0, 0);
                    s1 = __builtin_amdgcn_mfma_f32_16x16x32_bf16(e1, qb, s1, 0, 0, 0);
                    if ((s % 6) == 4) asm volatile("" ::: "memory");
                }
                float tmax = fmaxf(fmaxf(fmaxf(s0[0], s0[1]), fmaxf(s0[2], s0[3])), fmaxf(fmaxf(s1[0], s1[1]), fmaxf(s1[2], s1[3])));
                tmax = fmaxf(tmax, __shfl_xor(tmax, 16)); tmax = fmaxf(tmax, __shfl_xor(tmax, 32));
                const float mn = fmaxf(m_run, tmax), alpha = __builtin_amdgcn_exp2f((m_run - mn) * MLA_C), mc = mn * MLA_C;
                m_run = mn;
                float ls = 0.f;
#pragma unroll
                for (int j = 0; j < 4; ++j) { s0[j] = __builtin_amdgcn_exp2f(s0[j] * MLA_C - mc); s1[j] = __builtin_amdgcn_exp2f(s1[j] * MLA_C - mc); ls += s0[j] + s1[j]; }
                l_run = l_run * alpha + ls;
                const bf16x8 pb = pack8(s0[0], s0[1], s0[2], s0[3], s1[0], s1[1], s1[2], s1[3]);
                *(LAS bf16x8*)(xpb + (kt & 1) * 4096) = pb; *(LAS float*)(xal + (kt & 1) * 1024) = alpha;
            }
        } else if (kt >= 1) {
            const bf16x8 pb = *(const LAS bf16x8*)(xpb + ((kt - 1) & 1) * 4096); const float alpha = *(const LAS float*)(xal + ((kt - 1) & 1) * 1024);
            if (__any(alpha != 1.f)) {
#pragma unroll
                for (int d = 0; d < 32; ++d) o[d] *= alpha;
            }
            const unsigned va = vaddr0 + tprev * C_TILE;
            pvc8<0>(o, va, pb); pvc8<8>(o, va, pb); pvc8<16>(o, va, pb); pvc8<24>(o, va, pb);
        }
        const int tnext = (tcur == 2) ? 0 : tcur + 1;
        if (kt + 1 < NT) C_WRITE(tnext);
        tprev = tcur; tcur = tnext;
    }
#undef C_LOAD
#undef C_WRITE
    if (!pvw) { float lt = l_run; lt += __shfl_xor(lt, 16); lt += __shfl_xor(lt, 32); *(LAS float*)(xal + 1024) = 1.f / lt; }
    __syncthreads();
    if (pvw) {
        const float inv = *(const LAS float*)(xal + 1024);
        bf16_t* op = CTX + (size_t)srow * 8192 + h * 512 + 4 * g;
#pragma unroll
        for (int d = 0; d < 32; ++d) { u32x2 w; w.x = cvt_pk(o[d][0] * inv, o[d][1] * inv); w.y = cvt_pk(o[d][2] * inv, o[d][3] * inv); *(u32x2*)(op + 16 * d) = w; }
    }
}

struct Args { const float* in[30]; float* out; unsigned char* ws; int ph_lo, ph_hi; };
constexpr int NWAVES = 8, NPH_LAYER = 14, NPHASES = 1 + NLAYER * NPH_LAYER;

template <class Map>
__device__ __forceinline__ void transpose_item(const float* W, int K, int Nsrc, bf16_t* WT, int ldt, LAS float* scr, int item, int lane, const Map& map) {
    const int nblk = Nsrc / 32, kb = item / nblk, nb = item % nblk, k0 = 64 * kb, n0 = 32 * nb;
#pragma unroll 8
    for (int i = 0; i < 32; ++i) { const int kk = 2 * i + (lane >> 5); scr[kk * 33 + (lane & 31)] = W[(size_t)(k0 + kk) * Nsrc + n0 + (lane & 31)]; }
    asm volatile("s_waitcnt lgkmcnt(0)" ::: "memory");
    const int c = lane & 7;
#pragma unroll
    for (int j = 0; j < 4; ++j) { const int n = (lane >> 3) + 8 * j; const LAS float* s = scr + (8 * c) * 33 + n;
        u32x4 o; o.x = cvt_pk(s[0 * 33], s[1 * 33]); o.y = cvt_pk(s[2 * 33], s[3 * 33]); o.z = cvt_pk(s[4 * 33], s[5 * 33]); o.w = cvt_pk(s[6 * 33], s[7 * 33]);
        *(u32x4*)(WT + (size_t)map(n0 + n) * ldt + k0 + 8 * c) = o; }
    asm volatile("s_waitcnt lgkmcnt(0)" ::: "memory");
}
struct MapId { __device__ __forceinline__ int operator()(int n) const { return n; } };
struct MapIn { __device__ __forceinline__ int operator()(int c) const { return c < 1024 ? c : (c < 1088 ? 8192 + (c - 1024) : c - 64); } };
struct MapQ { __device__ __forceinline__ int operator()(int c) const { const int h = c / 192, w = c - h * 192; if (w < 128) return c; const int j = w - 128; return h * 192 + 128 + 2 * (j & 31) + (j >> 5); } };
struct MapGU { __device__ __forceinline__ int operator()(int c) const { return c < FF ? (c >> 2) * 8 + (c & 3) : ((c - FF) >> 2) * 8 + 4 + ((c - FF) & 3); } };

__device__ __forceinline__ void ln_row(const float* __restrict__ xin, const float* __restrict__ gam, const float* __restrict__ bet, float* __restrict__ xo, bf16_t* __restrict__ xb, int lane) {
    const f32x4* xr = (const f32x4*)xin + lane;
    f32x4 v[8]; float s = 0.f;
#pragma unroll
    for (int j = 0; j < 8; ++j) { v[j] = xr[64 * j]; s += (v[j][0] + v[j][1]) + (v[j][2] + v[j][3]); }
    const float mean = wave_sum(s) * (1.f / DM); float s2 = 0.f;
#pragma unroll
    for (int j = 0; j < 8; ++j) { v[j] = v[j] - mean; s2 += (v[j][0] * v[j][0] + v[j][1] * v[j][1]) + (v[j][2] * v[j][2] + v[j][3] * v[j][3]); }
    const float rstd = 1.f / sqrtf(wave_sum(s2) * (1.f / DM) + LN_EPS);
#pragma unroll
    for (int j = 0; j < 8; ++j) { const f32x4 gg = ((const f32x4*)gam)[64 * j + lane], bb = ((const f32x4*)bet)[64 * j + lane]; const f32x4 y = v[j] * rstd * gg + bb;
        if (xo) ((f32x4*)xo)[64 * j + lane] = y;
        if (xb) { u32x2 w; w.x = cvt_pk(y[0], y[1]); w.y = cvt_pk(y[2], y[3]); ((u32x2*)xb)[64 * j + lane] = w; } }
}

#define P_X     ((float*)(ws + WS_X))
#define P_Y     ((float*)(ws + WS_Y))
#define P_XB    ((bf16_t*)(ws + WS_XB))
#define P_QA    ((float*)(ws + WS_QA))
#define P_KVA   ((float*)(ws + WS_KVA))
#define P_KRRAW ((float*)(ws + WS_KRRAW))
#define P_SBQ   ((bf16_t*)(ws + WS_SBQ))
#define P_GATE  ((bf16_t*)(ws + WS_GATE))
#define P_QN    ((bf16_t*)(ws + WS_QN))
#define P_LATB  ((bf16_t*)(ws + WS_LATB))
#define P_KRB   ((bf16_t*)(ws + WS_KRB))
#define P_Q     ((bf16_t*)(ws + WS_Q))
#define P_KVX   ((bf16_t*)(ws + WS_KVX))
#define P_QLAT  ((bf16_t*)(ws + WS_QLAT))
#define P_CTX   ((bf16_t*)(ws + WS_CTX))
#define P_OA    ((bf16_t*)(ws + WS_OA))
#define P_OB    ((bf16_t*)(ws + WS_OB))
#define P_T1    ((float*)(ws + WS_T1))
#define P_MRG   ((bf16_t*)(ws + WS_MRG))
#define P_FFB   ((bf16_t*)(ws + WS_FFB))
#define P_PP    ((float*)(ws + WS_PP))
#define P_LATS  ((bf16_t*)(ws + WS_LATS))
#define P_KRS   ((bf16_t*)(ws + WS_KRS))
#define P_PB    ((bf16_t*)(ws + WS_PB))
#define P_ROPE  ((float*)(ws + WS_ROPE))
#define P_WL(off) ((const bf16_t*)(ws + WS_W + (size_t)l * W_LAYER + (off)))

#ifndef PROBE_MASK
#define PROBE_MASK 0
#endif
#define REP0 (1 + (PROBE_MASK & 1))
#define REP(j) (1 + ((PROBE_MASK >> (1 + (j))) & 1))
#ifndef PHMASK
#define PHMASK 0xffff
#endif

__global__ void __launch_bounds__(512, 2) fwd_kernel(Args args) {
    extern __shared__ __attribute__((aligned(16))) unsigned char lds_raw[];
    LAS unsigned char* lds = (LAS unsigned char*)lds_raw;
    volatile LAS unsigned* MISC = (volatile LAS unsigned*)(lds + LDS_MISC);
    const int G_k = gridDim.x, bx_k = blockIdx.x, wave_k = __builtin_amdgcn_readfirstlane(threadIdx.x >> 6);
    unsigned char* const ws_k = args.ws;
    float* const out_k = args.out;
    for (int u = threadIdx.x; u < (LDS_BYTES - LDS_MISC) / 4; u += 512) MISC[u] = 0u;
    __syncthreads();
#if !MK_PER_PHASE
    const XcdBarrier bar = xcd_barrier_post((unsigned*)(ws_k + WS_CTL) + CW_BAR, MISC + 8);
#define GRID_BAR() xcd_barrier(bar, wave_k)
#else
#define GRID_BAR() do {} while (0)
#endif
    const int lo = args.ph_lo, hi = args.ph_hi;
#define IN(k) (lo <= (k) && (k) < hi)
#define LIN(j) (((PHMASK >> (1 + (j))) & 1) && IN(P0 + (j)))
#define SEAM(k) do { if (IN(k) && IN((k) + 1)) GRID_BAR(); } while (0)
#define PHASE_PTRS() unsigned zoff_ = 0u; int G = G_k, bx = bx_k; asm volatile("" : "+s"(zoff_), "+s"(G), "+s"(bx)); unsigned char* ws = ws_k + zoff_; float* out = out_k + zoff_; (void)out; (void)G; (void)bx
#define PHASE_IDS() PHASE_PTRS(); const int tid = phase_tid(wave_k); const int lane = tid & 63, wave = wave_k, gw = bx * NWAVES + wave, NGW = G * NWAVES; (void)lane; (void)gw; (void)NGW

    if ((PHMASK & 1) && IN(0)) for (int rep = 0; rep < REP0; ++rep) {
        PHASE_IDS();
        const size_t gtid = (size_t)bx * 512 + tid, gthreads = (size_t)G * 512;
        LAS float* scr = (LAS float*)(lds + wave * 16384);
        {
            constexpr int I_IN = (DM / 64) * (8256 / 32), I_QB = (512 / 64) * (3072 / 32), I_KV = (512 / 64) * (4096 / 32), I_BA = (DM / 64) * (DM / 32), I_BB = (1024 / 64) * (DM / 32),
                          I_OUT = I_BA, I_GU = (DM / 64) * (2 * FF / 32), I_DN = (FF / 64) * (DM / 32), I_PG = I_BA, I_PP = (PLE / 64) * (DM / 32);
            constexpr int I_LAYER = I_IN + I_QB + I_KV + I_BA + I_BB + I_OUT + I_GU + I_DN + I_PG + I_PP;
            for (int g = gw; g < NLAYER * I_LAYER; g += NGW) {
                const int l = g / I_LAYER; int r = g - l * I_LAYER;
                unsigned char* wl = ws + WS_W + (size_t)l * W_LAYER;
                if (r < I_IN) { transpose_item(args.in[10] + (size_t)l * DM * 8256, DM, 8256, (bf16_t*)(wl + W_IN), DM, scr, r, lane, MapIn()); continue; } r -= I_IN;
                if (r < I_QB) { transpose_item(args.in[13] + (size_t)l * 512 * 3072, 512, 3072, (bf16_t*)(wl + W_QB), 512, scr, r, lane, MapQ()); continue; } r -= I_QB;
                if (r < I_KV) { transpose_item(args.in[15] + (size_t)l * 512 * 4096, 512, 4096, (bf16_t*)(wl + W_KVBT), 512, scr, r, lane, MapId()); continue; } r -= I_KV;
                if (r < I_BA) { transpose_item(args.in[16] + (size_t)l * DM * DM, DM, DM, (bf16_t*)(wl + W_BA), DM, scr, r, lane, MapId()); continue; } r -= I_BA;
                if (r < I_BB) { transpose_item(args.in[17] + (size_t)l * 1024 * DM, 1024, DM, (bf16_t*)(wl + W_BB), 1024, scr, r, lane, MapId()); continue; } r -= I_BB;
                if (r < I_OUT) { transpose_item(args.in[18] + (size_t)l * DM * DM, DM, DM, (bf16_t*)(wl + W_OUT), DM, scr, r, lane, MapId()); continue; } r -= I_OUT;
                if (r < I_GU) { transpose_item(args.in[21] + (size_t)l * DM * 2 * FF, DM, 2 * FF, (bf16_t*)(wl + W_GU), DM, scr, r, lane, MapGU()); continue; } r -= I_GU;
                if (r < I_DN) { transpose_item(args.in[22] + (size_t)l * FF * DM, FF, DM, (bf16_t*)(wl + W_DN), FF, scr, r, lane, MapId()); continue; } r -= I_DN;
                if (r < I_PG) { transpose_item(args.in[25] + (size_t)l * DM * DM, DM, DM, (bf16_t*)(wl + W_PG), DM, scr, r, lane, MapId()); continue; } r -= I_PG;
                transpose_item(args.in[27] + (size_t)l * PLE * DM, PLE, DM, (bf16_t*)(wl + W_PP), PLE, scr, r, lane, MapId());
            }
        }
        for (int l = 0; l < NLAYER; ++l) {
            unsigned char* wl = ws + WS_W + (size_t)l * W_LAYER;
            { bf16_t* WT = (bf16_t*)(wl + W_IN);
              for (size_t i = gtid; i < (size_t)192 * DM / 8; i += gthreads) ((u32x4*)(WT + (size_t)8256 * DM))[i] = (u32x4){0u, 0u, 0u, 0u}; }
            { const float* W = args.in[15] + (size_t)l * 512 * 4096;
              bf16_t* WN = (bf16_t*)(wl + W_KVBN);
              for (size_t i = gtid; i < (size_t)16 * 512 * 256 / 8; i += gthreads) { const int k8 = (int)(i & 31) * 8, c = (int)(i >> 5) & 511, hh = (int)(i >> 14);
                  f32x4 a = (f32x4){0.f, 0.f, 0.f, 0.f}, b = a;
                  if (k8 < 128) { const float* src = W + (size_t)c * 4096 + hh * 256 + k8; a = *(const f32x4*)src; b = *(const f32x4*)(src + 4); }
                  st_bf16x8(WN + 8 * i, a, b); }
              bf16_t* BD = (bf16_t*)(wl + W_UVBD);
              for (size_t i = gtid; i < (size_t)2048 * 1024 / 2; i += gthreads) { const int n = (int)(i / 512), k2 = (int)(i % 512) * 2, hh = n >> 7, v = n & 127; unsigned w = 0u;
                  if ((k2 >> 9) == (hh & 1)) { const int c = k2 & 511; w = cvt_pk(W[(size_t)c * 4096 + hh * 256 + 128 + v], W[(size_t)(c + 1) * 4096 + hh * 256 + 128 + v]); }
                  ((unsigned*)BD)[i] = w; } }
        }
        for (size_t i = gtid; i < (size_t)SEQ * 32; i += gthreads) { float c, s; rope_cs_slow((int)(i >> 5), (int)(i & 31), c, s); P_ROPE[i] = c; P_ROPE[(size_t)SEQ * 32 + i] = s; }
        { const float* cl = args.in[2];
          for (size_t i = gtid; i < (size_t)NLAYER * NDB * PAST * 512 / 8; i += gthreads) { const size_t e = i * 8, lb_ = e / ((size_t)PAST * 512), rem = e % ((size_t)PAST * 512);
              const f32x4 a = *(const f32x4*)(cl + e), b = *(const f32x4*)(cl + e + 4); st_bf16x8(P_LATS + lb_ * (size_t)SKEYS * 512 + rem, a, b); }
          const float* ck = args.in[3];
          for (size_t i = gtid; i < (size_t)NLAYER * NDB * PAST * 32; i += gthreads) { const size_t rowi = i / 32; const int p = (int)(i % 32); const size_t lb_ = rowi / PAST, rr = rowi % PAST;
              ((unsigned*)(P_KRS + (lb_ * SKEYS + rr) * 64))[p] = cvt_pk(ck[rowi * 64 + p], ck[rowi * 64 + 32 + p]); } }
        { const float* pp = args.in[6]; const float* ps = args.in[7];
          for (size_t i = gtid; i < (size_t)NLAYER * TT * PLE / 8; i += gthreads) { const size_t e = i * 8, l = e / ((size_t)TT * PLE), rem = e % ((size_t)TT * PLE);
              const float* src = rem < (size_t)TP * PLE ? pp + l * (size_t)TP * PLE + rem : ps + l * (size_t)TS * PLE + (rem - (size_t)TP * PLE);
              st_bf16x8(P_PB + e, *(const f32x4*)src, *(const f32x4*)(src + 4)); } }
        for (int m = gw; m < TT; m += NGW) { const float* xin = m < TP ? args.in[0] + (size_t)m * DM : args.in[1] + (size_t)(m - TP) * DM;
            ln_row(xin, args.in[8], args.in[9], P_X + (size_t)m * DM, P_XB + (size_t)m * DM, lane); }
    }
    SEAM(0);

    for (int l = 0; l < NLAYER; ++l) {
        const int P0 = 1 + l * NPH_LAYER;
        if (LIN(0)) for (int rep = 0; rep < REP(0); ++rep) {
            PHASE_PTRS();
            pg8::Order S; S.init(TT, 30 * 256, 1, G, bx, 1);
            pg8::EpiIn E{P_QA, P_KVA, P_KRRAW, P_SBQ, P_GATE, out + O_K_P + (size_t)l * TP * 1024, out + O_K_S + (size_t)l * TS * 1024,
                         out + O_V_P + (size_t)l * TP * 1024, out + O_V_S + (size_t)l * TS * 1024, args.in[11] + (size_t)l * 4096};
            pg8::gemm_phase<pg8::Shape<DM, DM, DM>>(lds, wave_k, P_XB, P_WL(W_IN), S, E);
        }
        SEAM(P0 + 0);
        if (LIN(1)) for (int rep = 0; rep < REP(1); ++rep) {
            PHASE_IDS();
            const float* gq = args.in[12] + (size_t)l * 512; const float* gkv = args.in[14] + (size_t)l * 512;
            bf16_t* LATS_l = P_LATS + (size_t)l * NDB * SKEYS * 512; bf16_t* KRS_l = P_KRS + (size_t)l * NDB * SKEYS * 64;
            for (int m = gw; m < TT; m += NGW) {
                { const f32x4 a = ((const f32x4*)(P_QA + (size_t)m * 512))[2 * lane], b = ((const f32x4*)(P_QA + (size_t)m * 512))[2 * lane + 1];
                  const float ss = wave_sum((a[0] * a[0] + a[1] * a[1]) + (a[2] * a[2] + a[3] * a[3]) + (b[0] * b[0] + b[1] * b[1]) + (b[2] * b[2] + b[3] * b[3]));
                  const float r = 1.f / sqrtf(ss * (1.f / 512.f) + RMS_EPS); const f32x4 g0 = ((const f32x4*)gq)[2 * lane], g1 = ((const f32x4*)gq)[2 * lane + 1];
                  st_bf16x8(P_QN + (size_t)m * 512 + 8 * lane, a * r * g0, b * r * g1); }
                { const f32x4 a = ((const f32x4*)(P_KVA + (size_t)m * 512))[2 * lane], b = ((const f32x4*)(P_KVA + (size_t)m * 512))[2 * lane + 1];
                  const float ss = wave_sum((a[0] * a[0] + a[1] * a[1]) + (a[2] * a[2] + a[3] * a[3]) + (b[0] * b[0] + b[1] * b[1]) + (b[2] * b[2] + b[3] * b[3]));
                  const float r = 1.f / sqrtf(ss * (1.f / 512.f) + RMS_EPS); const f32x4 g0 = ((const f32x4*)gkv)[2 * lane], g1 = ((const f32x4*)gkv)[2 * lane + 1];
                  const f32x4 y0 = a * r * g0, y1 = b * r * g1;
                  float* od; bf16_t* ob;
                  if (m < TP) { od = out + O_LAT_P + ((size_t)l * TP + m) * 512; ob = P_LATB + (size_t)m * 512; }
                  else { const int sm = m - TP, bb = sm >> 5, qq = sm & 31; od = out + O_LAT_S + ((size_t)l * TS + sm) * 512; ob = LATS_l + ((size_t)bb * SKEYS + PAST + qq) * 512; }
                  st_f32x8(od + 8 * lane, y0, y1); st_bf16x8(ob + 8 * lane, y0, y1); }
                if (lane < 32) { const float x1 = P_KRRAW[(size_t)m * 64 + lane], x2 = P_KRRAW[(size_t)m * 64 + 32 + lane];
                  const int pos = tok_pos(m); const float c = P_ROPE[pos * 32 + lane], s = P_ROPE[SEQ * 32 + pos * 32 + lane];
                  const float y1 = x1 * c - x2 * s, y2 = x2 * c + x1 * s;
                  float* od; bf16_t* ob;
                  if (m < TP) { od = out + O_KR_P + ((size_t)l * TP + m) * 64; ob = P_KRB + (size_t)m * 64; }
                  else { const int sm = m - TP, bb = sm >> 5, qq = sm & 31; od = out + O_KR_S + ((size_t)l * TS + sm) * 64; ob = KRS_l + ((size_t)bb * SKEYS + PAST + qq) * 64; }
                  od[lane] = y1; od[32 + lane] = y2; ((unsigned*)ob)[lane] = cvt_pk(y1, y2); }
            }
        }
        SEAM(P0 + 1);
        if (LIN(2)) for (int rep = 0; rep < REP(2); ++rep) {
            PHASE_PTRS();
            { pg8::Order S; S.init(TT, 3 * 256, 1, G, bx, 2);
              pg8::EpiIn E{P_QA, P_KVA, P_KRRAW, P_SBQ, P_GATE, out + O_K_P + (size_t)l * TP * 1024, out + O_K_S + (size_t)l * TS * 1024,
                           out + O_V_P + (size_t)l * TP * 1024, out + O_V_S + (size_t)l * TS * 1024, args.in[11] + (size_t)l * 4096};
              pg8::gemm_phase<pg8::Shape<DM, DM, DM>>(lds, wave_k, P_XB, P_WL(W_IN), S, E); }
            const bool g256 = (G == 256);
            { pg8::Order S; S.init(TT, 3072, 1, G, g256 ? ((bx + 154) & 255) : bx); pg8::EpiQ E{P_Q, P_ROPE}; pg8::gemm_phase<pg8::Shape<512, 512, 512>>(lds, wave_k, P_QN, P_WL(W_QB), S, E); }
            { pg8::Order S; S.init(TP, 4096, 1, g256 ? 154 : G, g256 ? (bx >= 102 ? bx - 102 : (1 << 28)) : bx); pg8::EpiBf16 E{P_KVX, 4096, 0}; pg8::gemm_phase<pg8::Shape<512, 512, 512>>(lds, wave_k, P_LATB, P_WL(W_KVBT), S, E); }
            { pg8::Order S; S.init(TP, DM, 1, G, bx); pg8::EpiF32 E{P_PP, DM}; pg8::gemm_phase<pg8::Shape<PLE, PLE, PLE>>(lds, wave_k, P_PB + (size_t)l * TT * PLE, P_WL(W_PP), S, E);
              pg8::gemm_small<PLE, PLE, PLE, 0>(lds, wave_k, P_PB + (size_t)l * TT * PLE, P_WL(W_PP), TP, 8, 32, G, bx, E); }
        }
        SEAM(P0 + 2);
        if (LIN(3)) for (int rep = 0; rep < REP(3); ++rep) {
            PHASE_PTRS();
            pg8::Order S; S.init(TS, 512, 16, G, bx); pg8::EpiBf16 E{P_QLAT, 8192, 512};
            pg8::gemm_phase<pg8::Shape<256, 3072, 256, 192, 512 * 256, 0>>(lds, wave_k, P_Q + (size_t)TP * 3072, P_WL(W_KVBN), S, E);
        }
        SEAM(P0 + 3);
        if (LIN(4)) for (int rep = 0; rep < REP(4); ++rep) {
            PHASE_IDS();
            volatile LAS int* qslot = (volatile LAS int*)(MISC + 16);
            unsigned* qc = (unsigned*)(ws + WS_CTL) + CW_Q + (size_t)(l * 2 + rep) * 4 * 64;
#ifndef PROBE_ATT
#define PROBE_ATT 0
#endif
#ifndef NO_C
            for (int r2 = 0; r2 < 1 + (PROBE_ATT & 1); ++r2)
            for (;;) {
                __syncthreads(); if (tid == 0) qslot[0] = (int)atomicAdd(qc + (r2 ? 3 : 0) * 64, 1u); __syncthreads();
                const int it = qslot[0]; if (it >= 128) break;
                const int b = it >> 3, rg = it & 7;
                attn_mla_sample(lds, wave_k, P_QLAT, P_Q, P_LATS + ((size_t)l * NDB + b) * SKEYS * 512, P_KRS + ((size_t)l * NDB + b) * SKEYS * 64, P_CTX, b, rg);
            }
#endif
#ifndef NO_A
            for (int r2 = 0; r2 < 1 + ((PROBE_ATT >> 1) & 1); ++r2)
            for (;;) {
                __syncthreads(); if (tid == 0) qslot[0] = (int)atomicAdd(qc + (r2 ? 3 : 1) * 64, 1u); __syncthreads();
                const int it = qslot[0]; if (it >= 512) break;
                const int qb = 15 - (it >> 5), bh = it & 31, b = bh >> 4, h = bh & 15;
                attn_mla_prompt(lds, wave_k, P_Q, P_KVX, P_KRB, P_OA, b, h, qb);
            }
#endif
#ifndef NO_B
            for (int r2 = 0; r2 < 1 + ((PROBE_ATT >> 2) & 1); ++r2)
            for (;;) {
                __syncthreads(); if (tid == 0) qslot[0] = (int)atomicAdd(qc + (r2 ? 3 : 2) * 64, 1u); __syncthreads();
                const int it = qslot[0]; if (it >= 256 + 128) break;
#ifdef DBG_ONLY_D
                if (it < 256) continue;
#endif
#ifdef DBG_ONLY_B
                if (it >= 256) continue;
#endif
                SbSrc src; size_t row0; int kt_top, nwact, qpos0, top_shift, h;
                if (it < 256) {
                    const int qb = 15 - (it >> 4), bh = it & 15, b = bh >> 3; h = bh & 7;
                    src.k_main = out + O_K_P + ((size_t)l * TP + (size_t)b * SEQ) * 1024 + h * 128; src.v_main = out + O_V_P + ((size_t)l * TP + (size_t)b * SEQ) * 1024 + h * 128;
                    src.k_new = src.k_main; src.v_new = src.v_main; src.new_tile = -1;
                    row0 = (size_t)b * SEQ + qb * 256; kt_top = 4 * qb + 3; nwact = 8; qpos0 = qb * 256; top_shift = 1;
                } else {
                    const int u = it - 256, b = u >> 3; h = u & 7;
                    src.k_main = args.in[4] + ((size_t)(l * NDB + b) * PAST) * 1024 + h * 128; src.v_main = args.in[5] + ((size_t)(l * NDB + b) * PAST) * 1024 + h * 128;
                    src.k_new = out + O_K_S + ((size_t)l * TS + (size_t)b * DSEQ) * 1024 + h * 128; src.v_new = out + O_V_S + ((size_t)l * TS + (size_t)b * DSEQ) * 1024 + h * 128; src.new_tile = 32;
                    row0 = (size_t)TP + b * DSEQ; kt_top = 32; nwact = 1; qpos0 = PAST; top_shift = 0;
                }
                attn_sb(lds, wave_k, P_SBQ + row0 * 1024 + h * 128, src, P_OB + row0 * 1024 + h * 128, kt_top, nwact, qpos0, top_shift);
            }
#endif
            __syncthreads();
        }
        SEAM(P0 + 4);
        if (LIN(5)) for (int rep = 0; rep < REP(5); ++rep) {
            PHASE_PTRS();
            { pg8::EpiBf16 E{P_OA + (size_t)TP * DM, DM, 0}; pg8::gemm_small<1024, 8192, 1024, 1024>(lds, wave_k, P_CTX, P_WL(W_UVBD), 0, 8, 32, G, bx, E); }
            { pg8::Order S; S.init(TP, DM, 1, G, bx); pg8::EpiBrB E{P_T1, P_GATE}; pg8::gemm_phase<pg8::Shape<1024, 1024, 1024>>(lds, wave_k, P_OB, P_WL(W_BB), S, E);
              pg8::gemm_small<1024, 1024, 1024, 0>(lds, wave_k, P_OB, P_WL(W_BB), TP, 8, 32, G, bx, E); }
        }
        SEAM(P0 + 5);
        if (LIN(6)) for (int rep = 0; rep < REP(6); ++rep) { PHASE_PTRS(); pg8::Order S; S.init(TP, DM, 1, G, bx); pg8::EpiBrA E{P_MRG, P_T1, P_GATE}; pg8::gemm_phase<pg8::Shape<DM, DM, DM>>(lds, wave_k, P_OA, P_WL(W_BA), S, E);
            pg8::gemm_small<DM, DM, DM, 0>(lds, wave_k, P_OA, P_WL(W_BA), TP, 8, 32, G, bx, E); }
        SEAM(P0 + 6);
        if (LIN(7)) for (int rep = 0; rep < REP(7); ++rep) { PHASE_PTRS(); pg8::Order S; S.init(TP, DM, 1, G, bx); pg8::EpiRes E{P_Y, P_X}; pg8::gemm_phase<pg8::Shape<DM, DM, DM>>(lds, wave_k, P_MRG, P_WL(W_OUT), S, E);
            pg8::gemm_small<DM, DM, DM, 0>(lds, wave_k, P_MRG, P_WL(W_OUT), TP, 8, 32, G, bx, E); }
        SEAM(P0 + 7);
        if (LIN(8)) for (int rep = 0; rep < REP(8); ++rep) { PHASE_IDS(); for (int m = gw; m < TT; m += NGW) ln_row(P_Y + (size_t)m * DM, args.in[19] + (size_t)l * DM, args.in[20] + (size_t)l * DM, P_X + (size_t)m * DM, P_XB + (size_t)m * DM, lane); }
        SEAM(P0 + 8);
        if (LIN(9)) for (int rep = 0; rep < REP(9); ++rep) { PHASE_PTRS(); pg8::Order S; S.init(TT, 2 * FF, 1, G, bx); pg8::EpiGU E{P_FFB}; pg8::gemm_phase<pg8::Shape<DM, DM, DM>>(lds, wave_k, P_XB, P_WL(W_GU), S, E); }
        SEAM(P0 + 9);
        if (LIN(10)) for (int rep = 0; rep < REP(10); ++rep) { PHASE_PTRS(); pg8::Order S; S.init(TP, DM, 1, G, bx); pg8::EpiRes E{P_Y, P_X}; pg8::gemm_phase<pg8::Shape<FF, FF, FF>>(lds, wave_k, P_FFB, P_WL(W_DN), S, E);
            pg8::gemm_small<FF, FF, FF, 0>(lds, wave_k, P_FFB, P_WL(W_DN), TP, 8, 32, G, bx, E); }
        SEAM(P0 + 10);
        if (LIN(11)) for (int rep = 0; rep < REP(11); ++rep) { PHASE_IDS(); for (int m = gw; m < TT; m += NGW) ln_row(P_Y + (size_t)m * DM, args.in[23] + (size_t)l * DM, args.in[24] + (size_t)l * DM, P_X + (size_t)m * DM, P_XB + (size_t)m * DM, lane); }
        SEAM(P0 + 11);
        if (LIN(12)) for (int rep = 0; rep < REP(12); ++rep) { PHASE_PTRS(); pg8::Order S; S.init(TP, DM, 1, G, bx); pg8::EpiPle E{P_Y, P_X, P_PP, args.in[26] + (size_t)l * DM}; pg8::gemm_phase<pg8::Shape<DM, DM, DM>>(lds, wave_k, P_XB, P_WL(W_PG), S, E);
            pg8::gemm_small<DM, DM, DM, 0>(lds, wave_k, P_XB, P_WL(W_PG), TP, 8, 32, G, bx, E); }
        SEAM(P0 + 12);
        if (LIN(13)) for (int rep = 0; rep < REP(13); ++rep) {
            PHASE_IDS();
            const float* gam = args.in[28] + (size_t)l * DM; const float* bet = args.in[29] + (size_t)l * DM;
            if (l + 1 < NLAYER) { for (int m = gw; m < TT; m += NGW) ln_row(P_Y + (size_t)m * DM, gam, bet, P_X + (size_t)m * DM, P_XB + (size_t)m * DM, lane); }
            else { for (int m = gw; m < TT; m += NGW) ln_row(P_Y + (size_t)m * DM, gam, bet, out + O_Y_P + (size_t)m * DM, nullptr, lane); }
        }
        SEAM(P0 + 13);
    }
#undef IN
#undef LIN
#undef SEAM
}

extern "C" void kernel_launch(void* const* d_in, const int* in_sizes, int n_in, void* d_out, int out_size, void* d_ws, size_t ws_size, hipStream_t stream) {
    static int grid = 0;
    if (grid == 0) {
        if (n_in != 30 || out_size != (int)O_END || ws_size < WS_END) {
            fprintf(stderr, "kernel_launch: shape mismatch n_in %d out %d ws %zu (need %zu)\n", n_in, out_size, ws_size, (size_t)WS_END); grid = -1; return; }
        int dev = 0, cus = 0, per_cu = 0;
        if (hipGetDevice(&dev) != hipSuccess || hipDeviceGetAttribute(&cus, hipDeviceAttributeMultiprocessorCount, dev) != hipSuccess) { grid = -1; return; }
        if (hipFuncSetAttribute((const void*)fwd_kernel, hipFuncAttributeMaxDynamicSharedMemorySize, LDS_BYTES) != hipSuccess) { fprintf(stderr, "kernel_launch: hipFuncSetAttribute failed\n"); grid = -1; return; }
        if (hipOccupancyMaxActiveBlocksPerMultiprocessor(&per_cu, (const void*)fwd_kernel, 512, LDS_BYTES) != hipSuccess || per_cu < 1)
            fprintf(stderr, "kernel_launch: occupancy query reports %d blocks per CU\n", per_cu);
        (void)hipGetLastError();
        grid = cus;
    }
    if (grid <= 0) return;
#ifdef DBG_ZERO_ALL
    (void)hipMemsetAsync(d_ws, 0, WS_END, stream); (void)hipMemsetAsync(d_out, 0, (size_t)O_END * 4, stream);
#else
    (void)hipMemsetAsync(d_ws, 0, CTL_BYTES, stream);
#endif
    Args a;
    memset(&a, 0, sizeof(a));
    for (int i = 0; i < 30; ++i) a.in[i] = (const float*)d_in[i];
    a.out = (float*)d_out; a.ws = (unsigned char*)d_ws;
#if MK_PER_PHASE
#ifndef DBG_PH_MAX
#define DBG_PH_MAX NPHASES
#endif
    for (int p = 0; p < DBG_PH_MAX; ++p) { a.ph_lo = p; a.ph_hi = p + 1; hipLaunchKernelGGL(fwd_kernel, dim3(grid), dim3(512), LDS_BYTES, stream, a); }
#else
    a.ph_lo = 0; a.ph_hi = NPHASES;
    hipLaunchKernelGGL(fwd_kernel, dim3(grid), dim3(512), LDS_BYTES, stream, a);
#endif
#ifdef DBG_COPY_OFF
    (void)hipMemcpyAsync(d_out, (const char*)d_ws + DBG_COPY_OFF, DBG_COPY_BYTES, hipMemcpyDeviceToDevice, stream);
#endif
    const hipError_t le = hipPeekAtLastError();
    if (le != hipSuccess) fprintf(stderr, "kernel_launch: launch failed: %s\n", hipGetErrorName(le));
}
```

```cpp
#include <hip/hip_runtime.h>
#include <cstdio>
#include <cstdint>
#include <cstring>

#ifndef MK_PER_PHASE
#define MK_PER_PHASE 0
#endif

#define LAS __attribute__((address_space(3)))
#define GAS __attribute__((address_space(1)))
typedef unsigned short bf16_t;
typedef short bf16x8 __attribute__((ext_vector_type(8)));
typedef short s16x4 __attribute__((ext_vector_type(4)));
typedef float f32x4 __attribute__((ext_vector_type(4)));
typedef float f32x16 __attribute__((ext_vector_type(16)));
typedef unsigned u32x4 __attribute__((ext_vector_type(4)));
typedef unsigned u32x2 __attribute__((ext_vector_type(2)));

constexpr int DM = 2048, TP = 8192, TS = 512, TT = 8704, SEQ = 4096, PAST = 2048, DSEQ = 32, NDB = 16, NLAYER = 2;
constexpr int NIN = 8448;
constexpr int FF = 5632, PLE = 256, SKEYS = PAST + DSEQ;
constexpr float ALPHA = 1.41421356237309515f;
constexpr float LN_EPS = 1e-5f, RMS_EPS = 1e-6f;
constexpr float LOG2E = 1.4426950408889634f, LN2 = 0.6931471805599453f;
constexpr float MLA_C = 0.07216878364870322f * LOG2E;
constexpr float SB_SCALE = 0.08838834764831845f;

constexpr size_t O_Y_P = 0, O_Y_S = 16777216, O_LAT_P = 17825792, O_KR_P = 26214400, O_K_P = 27262976, O_V_P = 44040192,
                 O_LAT_S = 60817408, O_KR_S = 61341696, O_K_S = 61407232, O_V_S = 62455808, O_END = 63504384;

constexpr size_t al256(size_t x) { return (x + 255) & ~(size_t)255; }
constexpr size_t WS_CTL = 0, CTL_BYTES = 1u << 20;
constexpr size_t W_IN = 0, W_QB = W_IN + (size_t)NIN * DM * 2, W_KVBT = W_QB + (size_t)3072 * 512 * 2, W_KVBN = W_KVBT + (size_t)4096 * 512 * 2,
                 W_UVBD = W_KVBN + (size_t)512 * 4096 * 2, W_BA = W_UVBD + (size_t)2048 * 1024 * 2, W_BB = W_BA + (size_t)DM * DM * 2,
                 W_OUT = W_BB + (size_t)DM * 1024 * 2, W_GU = W_OUT + (size_t)DM * DM * 2, W_DN = W_GU + (size_t)2 * FF * DM * 2,
                 W_PG = W_DN + (size_t)DM * FF * 2, W_PP = W_PG + (size_t)DM * DM * 2, W_LAYER = W_PP + (size_t)DM * PLE * 2;
constexpr size_t WS_W = CTL_BYTES;
constexpr size_t WS_LATS = WS_W + NLAYER * W_LAYER;
constexpr size_t WS_KRS = WS_LATS + (size_t)NLAYER * NDB * SKEYS * 512 * 2;
constexpr size_t WS_PB = WS_KRS + (size_t)NLAYER * NDB * SKEYS * 64 * 2;
constexpr size_t WS_X = WS_PB + (size_t)NLAYER * TT * PLE * 2;
constexpr size_t WS_Y = WS_X + (size_t)TT * DM * 4;
constexpr size_t WS_XB = WS_Y + (size_t)TT * DM * 4;
constexpr size_t WS_QA = WS_XB + (size_t)TT * DM * 2;
constexpr size_t WS_KVA = WS_QA + (size_t)TT * 512 * 4;
constexpr size_t WS_KRRAW = WS_KVA + (size_t)TT * 512 * 4;
constexpr size_t WS_SBQ = WS_KRRAW + (size_t)TT * 64 * 4;
constexpr size_t WS_GATE = WS_SBQ + (size_t)TT * 1024 * 2;
constexpr size_t WS_QN = WS_GATE + (size_t)TT * 4096 * 2;
constexpr size_t WS_LATB = WS_QN + (size_t)TT * 512 * 2;
constexpr size_t WS_KRB = WS_LATB + (size_t)TP * 512 * 2;
constexpr size_t WS_Q = WS_KRB + (size_t)TP * 64 * 2;
constexpr size_t WS_KVX = WS_Q + (size_t)TT * 3072 * 2 + 4096;
constexpr size_t WS_QLAT = WS_KVX + (size_t)TP * 4096 * 2;
constexpr size_t WS_CTX = WS_QLAT + (size_t)TS * 8192 * 2;
constexpr size_t WS_OA = WS_CTX + (size_t)TS * 8192 * 2;
constexpr size_t WS_OB = WS_OA + (size_t)TT * DM * 2;
constexpr size_t WS_T1 = WS_OB + (size_t)TT * 1024 * 2;
constexpr size_t WS_MRG = WS_T1 + (size_t)TT * DM * 4;
constexpr size_t WS_FFB = WS_MRG + (size_t)TT * DM * 2;
constexpr size_t WS_PP = WS_FFB + (size_t)TT * FF * 2;
constexpr size_t WS_ROPE = WS_PP + (size_t)TT * DM * 4;
constexpr size_t WS_END = WS_ROPE + (size_t)2 * SEQ * 32 * 4;

constexpr int CW_BAR = 4096, CW_Q = 16384;

constexpr int LDS_STAGE = 131072, LDS_MISC = LDS_STAGE, LDS_BYTES = 147456;

typedef __bf16 bf16x2_t __attribute__((ext_vector_type(2)));
typedef float f32x2_t __attribute__((ext_vector_type(2)));
__device__ __forceinline__ unsigned cvt_pk(float lo, float hi) { const f32x2_t v = {lo, hi}; const bf16x2_t b = __builtin_convertvector(v, bf16x2_t); return __builtin_bit_cast(unsigned, b); }
__device__ __forceinline__ float bflo(unsigned w) { return __uint_as_float(w << 16); }
__device__ __forceinline__ float bfhi(unsigned w) { return __uint_as_float(w & 0xffff0000u); }
__device__ __forceinline__ void st_bf16x8(bf16_t* p, f32x4 a, f32x4 b) { u32x4 w; w.x = cvt_pk(a[0], a[1]); w.y = cvt_pk(a[2], a[3]); w.z = cvt_pk(b[0], b[1]); w.w = cvt_pk(b[2], b[3]); *(u32x4*)p = w; }
__device__ __forceinline__ void st_f32x8(float* p, f32x4 a, f32x4 b) { *(f32x4*)p = a; *(f32x4*)(p + 4) = b; }
__device__ __forceinline__ void ld_bf16x8(const bf16_t* p, f32x4& a, f32x4& b) { const u32x4 w = *(const u32x4*)p; a = (f32x4){bflo(w.x), bfhi(w.x), bflo(w.y), bfhi(w.y)}; b = (f32x4){bflo(w.z), bfhi(w.z), bflo(w.w), bfhi(w.w)}; }
__device__ __forceinline__ float sigmoidf_(float x) { return __builtin_amdgcn_rcpf(1.f + __builtin_amdgcn_exp2f(-x * LOG2E)); }
__device__ __forceinline__ float wave_sum(float v) {
#pragma unroll
    for (int o = 1; o < 64; o <<= 1) v += __shfl_xor(v, o);
    return v;
}
__device__ __forceinline__ int tok_pos(int row) { return row < TP ? (row & (SEQ - 1)) : PAST + ((row - TP) & (DSEQ - 1)); }
__device__ __forceinline__ void rope_cs_slow(int pos, int i, float& c, float& s) {
    const float invf = __builtin_amdgcn_exp2f(-(float)i * 0.41524101186092029f);
    const float ang = (float)pos * invf;
    double a = (double)ang * 0.15915494309189535; a -= __builtin_floor(a);
    const float f = (float)a;
    c = __builtin_amdgcn_cosf(f); s = __builtin_amdgcn_sinf(f);
}

__device__ __forceinline__ int phase_tid(int wave_k) { int ln; asm volatile("v_mbcnt_lo_u32_b32 %0, -1, 0\n\tv_mbcnt_hi_u32_b32 %0, -1, %0" : "=v"(ln)); return (wave_k << 6) | ln; }
#define XB_TMO      128
#define XB_XCNT(j)  (256  + 64 * (j))
#define XB_XSUB(j)  (1280 + 64 * (j))
#define XB_XGEN(j)  (2304 + 64 * (j))
#define XB_TOP      3328
#define XB_TOPGEN   3392
#define XCD_BAR_WORDS 3456
#define XB_SPIN_CAP (1u << 22)
__device__ __forceinline__ unsigned xb_ld(unsigned* p)              { return __hip_atomic_load(p, __ATOMIC_RELAXED, __HIP_MEMORY_SCOPE_AGENT); }
__device__ __forceinline__ unsigned xb_add(unsigned* p, unsigned v) { return __hip_atomic_fetch_add(p, v, __ATOMIC_RELAXED, __HIP_MEMORY_SCOPE_AGENT); }
__device__ __forceinline__ unsigned xb_xcc_id() { return (unsigned)__builtin_amdgcn_s_getreg((3 << 11) | 20) & 0xFu; }
#define XB_SPIN(cond, bar) do { unsigned _sp = 0; while (cond) { __builtin_amdgcn_s_sleep(1); \
    if ((++_sp & 255u) == 0u) { if (xb_ld(&(bar)[XB_TMO])) break; if (_sp > XB_SPIN_CAP) { atomicAdd(&(bar)[XB_TMO], 1u); break; } } } } while (0)
struct XcdBarrier { unsigned* bar; unsigned x; volatile LAS unsigned* st; };
__device__ __forceinline__ XcdBarrier xcd_barrier_post(unsigned* bar, volatile LAS unsigned* st) {
    XcdBarrier b; b.bar = bar; b.x = xb_xcc_id(); b.st = st;
    if (threadIdx.x == 0) (void)xb_add(&bar[XB_XCNT(b.x)], 1u);
    return b;
}
__device__ __forceinline__ void xcd_barrier_complete(unsigned* bar, unsigned x, unsigned& nloc, unsigned& nx) {
    const unsigned G = gridDim.x * gridDim.y * gridDim.z;
    unsigned sum, cnt, mine, sp = 0u;
    for (;;) {
        sum = 0u; cnt = 0u; mine = 0u;
#pragma unroll
        for (unsigned j = 0; j < 16; ++j) { const unsigned c = xb_ld(&bar[XB_XCNT(j)]); sum += c; cnt += (c > 0u) ? 1u : 0u; mine = (j == x) ? c : mine; }
        if (sum == G) break;
        __builtin_amdgcn_s_sleep(1);
        if ((++sp & 255u) == 0u) { if (xb_ld(&bar[XB_TMO])) break; if (sp > XB_SPIN_CAP) { atomicAdd(&bar[XB_TMO], 1u); break; } }
    }
    nloc = mine > 0u ? mine : 1u; nx = cnt > 0u ? cnt : 1u;
}
__device__ __forceinline__ void xcd_barrier(const XcdBarrier& b, int wave_k) {
    asm volatile("s_waitcnt vmcnt(0)" ::: "memory");
    __syncthreads();
    if (phase_tid(wave_k) == 0) {
        unsigned* bar = b.bar;
        __builtin_amdgcn_s_waitcnt(0);
        unsigned nloc = b.st[0], nx = b.st[1];
        if (nloc == 0u) { xcd_barrier_complete(bar, b.x, nloc, nx); b.st[0] = nloc; b.st[1] = nx; }
        const unsigned old = xb_add(&bar[XB_XSUB(b.x)], 1u);
        const unsigned gen = old / nloc;
        if (old + 1u == (gen + 1u) * nloc) {
            __builtin_amdgcn_fence(__ATOMIC_RELEASE, "agent");
            asm volatile("s_waitcnt vmcnt(0)" ::: "memory");
            const unsigned og = xb_add(&bar[XB_TOP], 1u);
            const unsigned tg = og / nx;
            if (og + 1u == (tg + 1u) * nx) xb_add(&bar[XB_TOPGEN], 1u);
            else XB_SPIN(xb_ld(&bar[XB_TOPGEN]) == tg, bar);
            __builtin_amdgcn_fence(__ATOMIC_ACQUIRE, "agent");
            xb_add(&bar[XB_XGEN(b.x)], 1u);
            asm volatile("s_waitcnt vmcnt(0)" ::: "memory");
        } else {
            XB_SPIN(xb_ld(&bar[XB_XGEN(b.x)]) == gen, bar);
            __builtin_amdgcn_fence(__ATOMIC_ACQUIRE, "agent");
            asm volatile("s_waitcnt vmcnt(0)" ::: "memory");
        }
    }
    __syncthreads();
}

namespace pg8 {
constexpr int BM = 256, BK = 64, HALF = 128, HTB = HALF * BK * 2, NXCD = 8, WGM = 8;
__host__ __device__ __forceinline__ int lds_byte(int r, int c) { const int st = (r >> 4) * 2 + (c >> 5), rr = r & 15, cc = c & 31, ob = rr * 64 + cc * 2; return st * 1024 + (ob ^ (((ob >> 9) & 1) << 5)); }
__host__ __device__ __forceinline__ void stage_rc(int b, int& R, int& C) { const int st = b / 1024, sb = b % 1024, swz = sb ^ (((sb >> 9) & 1) << 5); R = (st >> 1) * 16 + swz / 64; C = (st & 1) * 32 + (swz % 64) / 2; }
__host__ __device__ __forceinline__ int perm32(int rho) { const int n = rho >> 4, i = rho & 15; return 8 * (i >> 2) + 4 * n + (i & 3); }

struct Unit { int pm, pn, z; };
template <int K_, int LDA_, int LDB_, int SAZ_ = 0, int SBZ_ = 0, int APN_ = 0> struct Shape { static constexpr int K = K_, lda = LDA_, ldb = LDB_, sAz = SAZ_, sBz = SBZ_, a_pn = APN_; };

struct Order {
    int nM, nN, per, total, G, c, mode;
    __device__ void init(int M, int N, int nz, int G_, int c_, int mode_ = 0) { nM = M / BM; nN = N / BM; per = nM * nN; total = per * nz; G = G_; c = c_; mode = mode_; }
    __device__ bool next(int i, Unit& u) const {
        const long L = (long)i * G + c; if (L >= total) return false;
        const int z = (int)(L / per); int wgid = (int)(L % per);
        { const int q = per / NXCD, r = per % NXCD, xcd = wgid % NXCD, off = wgid / NXCD; wgid = (xcd < r ? xcd * (q + 1) : r * (q + 1) + (xcd - r) * q) + off; }
        const int nig = WGM * nN, gid = wgid / nig, fm = gid * WGM, gsz = (nM - fm) < WGM ? (nM - fm) : WGM;
        u.pm = fm + ((wgid % nig) % gsz); int pn = (wgid % nig) / gsz;
        if (mode == 1) pn = pn < 4 ? pn : (pn == 4 ? 32 : pn - 1); else if (mode == 2) pn += 29;
        u.pn = pn; u.z = z; return true;
    }
};

#define EPI_LOOP(...) \
    _Pragma("unroll") for (int ai = 0; ai < 2; ++ai) _Pragma("unroll") for (int m = 0; m < 4; ++m) { const int row = u.pm * 256 + ai * 128 + wr * 64 + m * 16 + fr; \
    _Pragma("unroll") for (int bj = 0; bj < 2; ++bj) { const int col = u.pn * 256 + bj * 128 + wc * 32 + fq * 8; f32x4 v0 = acc[ai][bj][m][0], v1 = acc[ai][bj][m][1]; __VA_ARGS__ } asm volatile("" ::: "memory"); }

template <class g, class Epi>
__device__ __forceinline__ void gemm_phase(LAS unsigned char* lds, int wave_k, const bf16_t* gA, const bf16_t* gBt, const Order& S, const Epi& E) {
    const int tid = phase_tid(wave_k);
    const int wid = __builtin_amdgcn_readfirstlane(tid >> 6), lane = tid & 63, wr = wid >> 2, wc = wid & 3, fr = lane & 15, fq = lane >> 4;
    constexpr int K = g::K, nt = K / BK;
    unsigned voffA[2], voffB[2];
#pragma unroll
    for (int i = 0; i < 2; ++i) { int R, C; stage_rc(tid * 16 + i * 8192, R, C); const int Rb = (R & ~31) + perm32(R & 31);
        voffA[i] = (unsigned)(R * g::lda + C) * 2u; voffB[i] = (unsigned)(Rb * g::ldb + C) * 2u; }
    const size_t kstep = (size_t)(BK * 2);
    constexpr size_t hstepA = (size_t)HALF * g::lda * 2, hstepB = (size_t)HALF * g::ldb * 2;
    constexpr size_t tstepA = 2 * hstepA, tstepB = 2 * hstepB;
    const unsigned ldsw = (unsigned)wid * 1024u;
    const int aoff = lds_byte(wr * 64 + fr, fq * 8), boff = lds_byte(wc * 32 + fr, fq * 8);
#define PG8_UA(u_) ((const char*)gA + ((size_t)(u_).z * g::sAz + (size_t)(u_).pn * (size_t)g::a_pn) * 2 + (size_t)(u_).pm * tstepA)
#define PG8_UB(u_) ((const char*)gBt + (size_t)(u_).z * g::sBz * 2 + (size_t)(u_).pn * tstepB)
#define PG8_SA(b, h) (((b) * 2 + (h)) * HTB)
#define PG8_SB(b, h) ((4 + (b) * 2 + (h)) * HTB)
#define PG8_STAGE(bufoff, gbase, voff) do { _Pragma("unroll") for (int _i = 0; _i < 2; ++_i) \
        __builtin_amdgcn_global_load_lds((const unsigned*)((const char*)(gbase) + (voff)[_i]), (LAS unsigned*)(lds + (bufoff) + ldsw + _i * 8192), 16, 0, 0); } while (0)
#define PG8_LDA(dst, b, h) do { _Pragma("unroll") for (int m = 0; m < 4; ++m) _Pragma("unroll") for (int k = 0; k < 2; ++k) dst[m][k] = *(const LAS bf16x8*)(lds + PG8_SA(b, h) + aoff + m * 2048 + k * 1024); } while (0)
#define PG8_LDB(dst, b, h) do { _Pragma("unroll") for (int n = 0; n < 2; ++n) _Pragma("unroll") for (int k = 0; k < 2; ++k) dst[n][k] = *(const LAS bf16x8*)(lds + PG8_SB(b, h) + boff + n * 2048 + k * 1024); } while (0)
#define PG8_MMA(ai, bj, At, Bt) do { __builtin_amdgcn_s_setprio(1); _Pragma("unroll") for (int m = 0; m < 4; ++m) _Pragma("unroll") for (int n = 0; n < 2; ++n) _Pragma("unroll") for (int k = 0; k < 2; ++k) \
        acc[ai][bj][m][n] = __builtin_amdgcn_mfma_f32_16x16x32_bf16(Bt[n][k], At[m][k], acc[ai][bj][m][n], 0, 0, 0); __builtin_amdgcn_s_setprio(0); } while (0)
#define PG8_WAIT_V(n) asm volatile("s_waitcnt vmcnt(" #n ")" ::: "memory")
#define PG8_WAIT_L(n) asm volatile("s_waitcnt lgkmcnt(" #n ")" ::: "memory")
#define PG8_BAR __builtin_amdgcn_s_barrier()
#define PG8_SCHED __builtin_amdgcn_sched_barrier(0)
    Unit cur, nxt; int ui = 0;
    if (!S.next(0, cur)) return;
    f32x4 acc[2][2][4][2];
#pragma unroll
    for (int a = 0; a < 2; ++a)
#pragma unroll
        for (int b = 0; b < 2; ++b)
#pragma unroll
            for (int m = 0; m < 4; ++m)
#pragma unroll
                for (int n = 0; n < 2; ++n) acc[a][b][m][n] = (f32x4){0.f, 0.f, 0.f, 0.f};
    bf16x8 At[4][2], B0[2][2], B1[2][2];
    const char* cA = PG8_UA(cur); const char* cB = PG8_UB(cur);
    PG8_STAGE(PG8_SB(0, 0), cB, voffB); PG8_STAGE(PG8_SB(0, 1), cB + hstepB, voffB); PG8_STAGE(PG8_SA(0, 0), cA, voffA); PG8_STAGE(PG8_SA(0, 1), cA + hstepA, voffA);
    if (wr == 1) PG8_BAR;
    PG8_WAIT_V(2); PG8_BAR;
    PG8_STAGE(PG8_SB(1, 0), cB + kstep, voffB); PG8_STAGE(PG8_SA(1, 0), cA + kstep, voffA); PG8_STAGE(PG8_SB(1, 1), cB + hstepB + kstep, voffB);
    PG8_WAIT_V(6); PG8_BAR;
    for (;;) {
        const bool has_next = S.next(ui + 1, nxt);
        const char* nA = has_next ? PG8_UA(nxt) : cA; const char* nB = has_next ? PG8_UB(nxt) : cB;
#pragma unroll 1
        for (int t = 0; t < nt; t += 2) {
            const bool last = (t == nt - 2);
            const char* a1 = cA + (size_t)(t + 1) * kstep;
            const char* a2 = last ? nA : cA + (size_t)(t + 2) * kstep; const char* b2 = last ? nB : cB + (size_t)(t + 2) * kstep;
            const char* a3 = a2 + kstep; const char* b3 = b2 + kstep;
            PG8_LDB(B0, 0, 0); PG8_LDB(B1, 0, 1); PG8_SCHED; PG8_LDA(At, 0, 0); PG8_STAGE(PG8_SA(1, 1), a1 + hstepA, voffA);
            PG8_WAIT_V(8); PG8_WAIT_L(0); PG8_BAR; PG8_MMA(0, 0, At, B0); PG8_MMA(0, 1, At, B1); PG8_BAR; PG8_SCHED;
            PG8_LDA(At, 0, 1); PG8_STAGE(PG8_SB(0, 0), b2, voffB); PG8_STAGE(PG8_SB(0, 1), b2 + hstepB, voffB); PG8_STAGE(PG8_SA(0, 0), a2, voffA);
            PG8_WAIT_V(8); PG8_WAIT_L(0); PG8_BAR; PG8_MMA(1, 0, At, B0); PG8_MMA(1, 1, At, B1); PG8_BAR; PG8_SCHED;
            PG8_LDB(B0, 1, 0); PG8_LDB(B1, 1, 1); PG8_SCHED; PG8_LDA(At, 1, 0); PG8_STAGE(PG8_SA(0, 1), a2 + hstepA, voffA);
            PG8_WAIT_V(8); PG8_WAIT_L(0); PG8_BAR; PG8_MMA(0, 0, At, B0); PG8_MMA(0, 1, At, B1); PG8_BAR; PG8_SCHED;
            PG8_LDA(At, 1, 1); PG8_STAGE(PG8_SB(1, 0), b3, voffB); PG8_STAGE(PG8_SB(1, 1), b3 + hstepB, voffB); PG8_STAGE(PG8_SA(1, 0), a3, voffA);
            PG8_WAIT_V(8); PG8_WAIT_L(0); PG8_BAR; PG8_MMA(1, 0, At, B0); PG8_MMA(1, 1, At, B1); PG8_BAR; PG8_SCHED;
        }
        if (wr == 0) PG8_BAR;
        { const Unit& u = cur; EPI_LOOP( E.apply(row, col, u.z, v0, v1); ) }
        if (!has_next) break;
#pragma unroll
        for (int a = 0; a < 2; ++a)
#pragma unroll
            for (int b = 0; b < 2; ++b)
#pragma unroll
                for (int m = 0; m < 4; ++m)
#pragma unroll
                    for (int n = 0; n < 2; ++n) acc[a][b][m][n] = (f32x4){0.f, 0.f, 0.f, 0.f};
        cur = nxt; cA = nA; cB = nB; ++ui;
        if (wr == 1) PG8_BAR;
    }
    PG8_WAIT_V(0);
    PG8_BAR;
#undef PG8_UA
#undef PG8_UB
#undef PG8_SA
#undef PG8_SB
#undef PG8_STAGE
#undef PG8_LDA
#undef PG8_LDB
#undef PG8_MMA
#undef PG8_WAIT_V
#undef PG8_WAIT_L
#undef PG8_BAR
#undef PG8_SCHED
}

struct EpiIn {
    float* QA; float* KVA; float* KRRAW; bf16_t* SBQ; bf16_t* GATE; float* k_p; float* k_s; float* v_p; float* v_s; const float* bgate;
    __device__ __forceinline__ void apply(int row, int col, int z, f32x4 v0, f32x4 v1) const {
        const int pn = col >> 8;
        if (pn < 2) st_f32x8(QA + (unsigned)(row * 512 + col), v0, v1);
        else if (pn < 4) st_f32x8(KVA + (unsigned)(row * 512 + col - 512), v0, v1);
        else if (pn < 8) st_bf16x8(SBQ + (unsigned)(row * 1024 + col - 1024), v0, v1);
        else if (pn < 12) { float* d = row < TP ? k_p : k_s - (size_t)TP * 1024; st_f32x8(d + (unsigned)(row * 1024 + col - 2048), v0, v1); }
        else if (pn < 16) { float* d = row < TP ? v_p : v_s - (size_t)TP * 1024; st_f32x8(d + (unsigned)(row * 1024 + col - 3072), v0, v1); }
        else if (pn < 32) { const unsigned c = (unsigned)(col - 4096); const f32x4 b0 = *(const f32x4*)(bgate + c), b1 = *(const f32x4*)(bgate + c + 4); f32x4 g0, g1;
#pragma unroll
            for (int j = 0; j < 4; ++j) { g0[j] = sigmoidf_(v0[j] + b0[j]); g1[j] = sigmoidf_(v1[j] + b1[j]); }
            st_bf16x8(GATE + ((unsigned)(row * 4096) + c), g0, g1); }
        else { const int c = col - 8192; if (c < 64) st_f32x8(KRRAW + (unsigned)(row * 64 + c), v0, v1); }
    }
};
struct EpiQ {
    bf16_t* Q; const float* ROPE;
    __device__ __forceinline__ void apply(int row, int col, int z, f32x4 v0, f32x4 v1) const {
        const int h = col / 192, w = col - h * 192;
        if (w >= 128) { const int pos = tok_pos(row), i0 = (w - 128) >> 1; const f32x4 c = *(const f32x4*)(ROPE + pos * 32 + i0), s = *(const f32x4*)(ROPE + SEQ * 32 + pos * 32 + i0);
            { const float a = v0[0], b = v0[1]; v0[0] = a * c[0] - b * s[0]; v0[1] = b * c[0] + a * s[0]; }
            { const float a = v0[2], b = v0[3]; v0[2] = a * c[1] - b * s[1]; v0[3] = b * c[1] + a * s[1]; }
            { const float a = v1[0], b = v1[1]; v1[0] = a * c[2] - b * s[2]; v1[1] = b * c[2] + a * s[2]; }
            { const float a = v1[2], b = v1[3]; v1[2] = a * c[3] - b * s[3]; v1[3] = b * c[3] + a * s[3]; } }
        st_bf16x8(Q + (unsigned)(row * 3072 + col), v0, v1);
    }
};
struct EpiBf16 {
    bf16_t* O; int ldc; int zoff;
    __device__ __forceinline__ void apply(int row, int col, int z, f32x4 v0, f32x4 v1) const { st_bf16x8(O + (unsigned)(row * ldc + z * zoff + col), v0, v1); }
};
struct EpiF32 {
    float* O; int ldc;
    __device__ __forceinline__ void apply(int row, int col, int z, f32x4 v0, f32x4 v1) const { st_f32x8(O + (unsigned)(row * ldc + col), v0, v1); }
};
struct EpiBrB {
    float* T1; const bf16_t* GATE;
    __device__ __forceinline__ void apply(int row, int col, int z, f32x4 v0, f32x4 v1) const {
        f32x4 g0, g1; ld_bf16x8(GATE + (unsigned)(row * 4096 + 2048 + col), g0, g1); st_f32x8(T1 + (unsigned)(row * DM + col), v0 * g0, v1 * g1); }
};
struct EpiBrA {
    bf16_t* MRG; const float* T1; const bf16_t* GATE;
    __device__ __forceinline__ void apply(int row, int col, int z, f32x4 v0, f32x4 v1) const {
        f32x4 g0, g1; ld_bf16x8(GATE + (unsigned)(row * 4096 + col), g0, g1); const float* t = T1 + (unsigned)(row * DM + col);
        const f32x4 t0 = *(const f32x4*)t, t1 = *(const f32x4*)(t + 4); st_bf16x8(MRG + (unsigned)(row * DM + col), t0 + v0 * g0, t1 + v1 * g1); }
};
struct EpiRes {
    float* Y; const float* X;
    __device__ __forceinline__ void apply(int row, int col, int z, f32x4 v0, f32x4 v1) const {
        const float* x = X + (unsigned)(row * DM + col); const f32x4 x0 = *(const f32x4*)x, x1 = *(const f32x4*)(x + 4);
        st_f32x8(Y + (unsigned)(row * DM + col), x0 * ALPHA + v0, x1 * ALPHA + v1); }
};
struct EpiGU {
    bf16_t* FFB;
    __device__ __forceinline__ void apply(int row, int col, int z, f32x4 v0, f32x4 v1) const {
        f32x4 r;
#pragma unroll
        for (int j = 0; j < 4; ++j) r[j] = v0[j] * sigmoidf_(v0[j]) * v1[j];
        u32x2 w; w.x = cvt_pk(r[0], r[1]); w.y = cvt_pk(r[2], r[3]); *(u32x2*)(FFB + (unsigned)(row * FF + (col >> 1))) = w; }
};
struct EpiPle {
    float* Y; const float* X; const float* PP; const float* bias;
    __device__ __forceinline__ void apply(int row, int col, int z, f32x4 v0, f32x4 v1) const {
        const unsigned o = (unsigned)(row * DM + col); const f32x4 x0 = *(const f32x4*)(X + o), x1 = *(const f32x4*)(X + o + 4), p0 = *(const f32x4*)(PP + o), p1 = *(const f32x4*)(PP + o + 4);
        const f32x4 b0 = *(const f32x4*)(bias + (unsigned)col), b1 = *(const f32x4*)(bias + (unsigned)col + 4); f32x4 r0, r1;
#pragma unroll
        for (int j = 0; j < 4; ++j) { r0[j] = x0[j] * ALPHA + sigmoidf_(v0[j] + b0[j]) * p0[j]; r1[j] = x1[j] * ALPHA + sigmoidf_(v1[j] + b1[j]) * p1[j]; }
        st_f32x8(Y + o, r0, r1); }
};

template <int K, int LDA, int LDB, int APN, class Epi>
__device__ __forceinline__ void gemm_small(LAS unsigned char* lds, int wave_k, const bf16_t* gA, const bf16_t* gBt, int row0, int n_rt, int n_ct, int G, int c, const Epi& E) {
    const int tid = phase_tid(wave_k);
    const int wid = __builtin_amdgcn_readfirstlane(tid >> 6), lane = tid & 63, wc = wid & 1, wm = wid >> 1, fr = lane & 15, fq = lane >> 4;
    constexpr int nt = K / 64;
    int R, C; stage_rc(tid * 16, R, C);
    const int Rb = (R & ~31) + perm32(R & 31);
    const unsigned voffA = (unsigned)(R * LDA + C) * 2u, voffB = (unsigned)(Rb * LDB + C) * 2u;
    const unsigned ldsw = (unsigned)wid * 1024u;
    const int aoff = lds_byte(wm * 16 + fr, fq * 8), boff = lds_byte(wc * 32 + fr, fq * 8);
#define SM_STAGE(slot, pa, pb) do { \
        __builtin_amdgcn_global_load_lds((const unsigned*)((pa) + voffA), (LAS unsigned*)(lds + (slot) * 16384 + ldsw), 16, 0, 0); \
        __builtin_amdgcn_global_load_lds((const unsigned*)((pb) + voffB), (LAS unsigned*)(lds + (slot) * 16384 + 8192 + ldsw), 16, 0, 0); } while (0)
    for (int u = c; u < n_rt * n_ct; u += G) {
        const int xcd = u & 7, idx = u >> 3, rt = idx % n_rt, ct = xcd * (n_ct >> 3) + idx / n_rt;
        const char* pa = (const char*)gA + ((size_t)(row0 + rt * 64) * LDA + (size_t)(ct >> 2) * APN) * 2;
        const char* pb = (const char*)gBt + (size_t)(ct * 64) * LDB * 2;
        f32x4 acc0 = (f32x4){0.f, 0.f, 0.f, 0.f}, acc1 = acc0;
        SM_STAGE(0, pa, pb); SM_STAGE(1, pa + 128, pb + 128); SM_STAGE(2, pa + 256, pb + 256);
#pragma unroll 1
        for (int t = 0; t < nt; ++t) {
            asm volatile("s_waitcnt vmcnt(4)" ::: "memory");
            __builtin_amdgcn_s_barrier();
            { const int tn = (t + 3 < nt) ? t + 3 : nt - 1;
              SM_STAGE((t + 3) & 3, pa + (size_t)tn * 128, pb + (size_t)tn * 128); }
            const LAS unsigned char* sl = lds + (t & 3) * 16384;
            const bf16x8 a0 = *(const LAS bf16x8*)(sl + aoff), a1 = *(const LAS bf16x8*)(sl + aoff + 1024);
            const bf16x8 b00 = *(const LAS bf16x8*)(sl + 8192 + boff), b01 = *(const LAS bf16x8*)(sl + 8192 + boff + 1024);
            const bf16x8 b10 = *(const LAS bf16x8*)(sl + 8192 + boff + 2048), b11 = *(const LAS bf16x8*)(sl + 8192 + boff + 2048 + 1024);
            acc0 = __builtin_amdgcn_mfma_f32_16x16x32_bf16(b00, a0, acc0, 0, 0, 0); acc1 = __builtin_amdgcn_mfma_f32_16x16x32_bf16(b10, a0, acc1, 0, 0, 0);
            acc0 = __builtin_amdgcn_mfma_f32_16x16x32_bf16(b01, a1, acc0, 0, 0, 0); acc1 = __builtin_amdgcn_mfma_f32_16x16x32_bf16(b11, a1, acc1, 0, 0, 0);
        }
        asm volatile("s_waitcnt vmcnt(0)" ::: "memory");
        __builtin_amdgcn_s_barrier();
        E.apply(row0 + rt * 64 + wm * 16 + fr, ct * 64 + wc * 32 + fq * 8, 0, acc0, acc1);
    }
#undef SM_STAGE
}
}

template <int OFF> __device__ __forceinline__ s16x4 tr_read(unsigned addr) {
    s16x4 r; asm volatile("ds_read_b64_tr_b16 %0, %1 offset:%2" : "=&v"(r) : "v"(addr), "i"(OFF) : "memory"); return r;
}
#define PKTR(L, H) ((bf16x8){L[0], L[1], L[2], L[3], H[0], H[1], H[2], H[3]})
__device__ __forceinline__ bf16x8 pack8(float a0, float a1, float a2, float a3, float a4, float a5, float a6, float a7) {
    u32x4 w; w.x = cvt_pk(a0, a1); w.y = cvt_pk(a2, a3); w.z = cvt_pk(a4, a5); w.w = cvt_pk(a6, a7); return __builtin_bit_cast(bf16x8, w);
}
constexpr int AV_ROW = 320;
template <int DBLK> __device__ __forceinline__ void pv_block(f32x16& od, unsigned vaddr, const bf16x8 (&pb)[4]) {
    const s16x4 l0 = tr_read<(0 * 16 + 0) * AV_ROW + DBLK * 64>(vaddr), h0 = tr_read<(0 * 16 + 8) * AV_ROW + DBLK * 64>(vaddr);
    const s16x4 l1 = tr_read<(1 * 16 + 0) * AV_ROW + DBLK * 64>(vaddr), h1 = tr_read<(1 * 16 + 8) * AV_ROW + DBLK * 64>(vaddr);
    const s16x4 l2 = tr_read<(2 * 16 + 0) * AV_ROW + DBLK * 64>(vaddr), h2 = tr_read<(2 * 16 + 8) * AV_ROW + DBLK * 64>(vaddr);
    const s16x4 l3 = tr_read<(3 * 16 + 0) * AV_ROW + DBLK * 64>(vaddr), h3 = tr_read<(3 * 16 + 8) * AV_ROW + DBLK * 64>(vaddr);
    asm volatile("s_waitcnt lgkmcnt(0)" ::: "memory"); __builtin_amdgcn_sched_barrier(0);
    od = __builtin_amdgcn_mfma_f32_32x32x16_bf16(PKTR(l0, h0), pb[0], od, 0, 0, 0);
    od = __builtin_amdgcn_mfma_f32_32x32x16_bf16(PKTR(l1, h1), pb[1], od, 0, 0, 0);
    od = __builtin_amdgcn_mfma_f32_32x32x16_bf16(PKTR(l2, h2), pb[2], od, 0, 0, 0);
    od = __builtin_amdgcn_mfma_f32_32x32x16_bf16(PKTR(l3, h3), pb[3], od, 0, 0, 0);
}

constexpr int AK_ROW = 400, AK_TILE = 64 * AK_ROW, AV_TILE = 64 * AV_ROW;
__device__ __forceinline__ void attn_mla_prompt(LAS unsigned char* lds, int wave_k, const bf16_t* __restrict__ Q, const bf16_t* __restrict__ KVX, const bf16_t* __restrict__ KRB,
                                                bf16_t* __restrict__ OA, int b, int h, int qb) {
    const int tid = phase_tid(wave_k);
    const int wid = __builtin_amdgcn_readfirstlane(tid >> 6), lane = tid & 63, r32 = lane & 31, hi = lane >> 5;
    const int NT = 4 * qb + 4, my_last = 4 * qb + (wid >> 1);
    const int tok = b * SEQ + qb * 256 + wid * 32 + r32;
    bf16x8 qr[12];
    { const bf16_t* qp = Q + (size_t)tok * 3072 + h * 192 + hi * 8;
#pragma unroll
      for (int s = 0; s < 12; ++s) qr[s] = *(const bf16x8*)(qp + 16 * s); }
    f32x16 o[4];
#pragma unroll
    for (int d = 0; d < 4; ++d)
#pragma unroll
        for (int r = 0; r < 16; ++r) o[d][r] = 0.f;
    float m_run = -INFINITY, l_run = 0.f;
    const bf16_t* kbase = KVX + (size_t)(b * SEQ) * 4096 + h * 256;
    const bf16_t* rbase = KRB + (size_t)(b * SEQ) * 64;
    const int r0 = tid >> 4, c0 = tid & 15, rr = tid >> 3, rc = tid & 7;
    u32x4 sk0, sk1, sr, sv0, sv1;
#define A_LOAD(kt) do { const bf16_t* kp = kbase + (size_t)((kt) * 64 + r0) * 4096 + c0 * 8; \
        sk0 = *(const u32x4*)kp; sk1 = *(const u32x4*)(kp + (size_t)32 * 4096); sv0 = *(const u32x4*)(kp + 128); sv1 = *(const u32x4*)(kp + (size_t)32 * 4096 + 128); \
        sr = *(const u32x4*)(rbase + (size_t)((kt) * 64 + rr) * 64 + rc * 8); } while (0)
#define A_WRITE(buf) do { LAS unsigned char* Kb = lds + (buf) * AK_TILE; LAS unsigned char* Vb = lds + 2 * AK_TILE + (buf) * AV_TILE; \
        *(LAS u32x4*)(Kb + r0 * AK_ROW + c0 * 16) = sk0; *(LAS u32x4*)(Kb + (r0 + 32) * AK_ROW + c0 * 16) = sk1; *(LAS u32x4*)(Kb + rr * AK_ROW + 256 + rc * 16) = sr; \
        *(LAS u32x4*)(Vb + r0 * AV_ROW + c0 * 16) = sv0; *(LAS u32x4*)(Vb + (r0 + 32) * AV_ROW + c0 * 16) = sv1; } while (0)
    const unsigned ldsb = (unsigned)(uintptr_t)lds;
    const unsigned vaddr0 = ldsb + 2 * AK_TILE + (4 * hi + ((lane & 15) >> 2)) * AV_ROW + (16 * ((lane >> 4) & 1) + 4 * (lane & 3)) * 2;
    __syncthreads();
    A_LOAD(0); A_WRITE(0);
    for (int kt = 0; kt < NT; ++kt) {
        __syncthreads();
        if (kt + 1 < NT) A_LOAD(kt + 1);
        if (kt <= my_last) {
            const int buf = kt & 1;
            const LAS unsigned char* Kl = lds + buf * AK_TILE + r32 * AK_ROW + hi * 16;
            f32x16 p0, p1;
#ifdef PROBE_A_QK
            int qreps = 2; asm volatile("" : "+s"(qreps));
            for (int qq = 0; qq < qreps; ++qq) {
#else
            {
#endif
#pragma unroll
            for (int r = 0; r < 16; ++r) { p0[r] = 0.f; p1[r] = 0.f; }
#pragma unroll
            for (int s = 0; s < 12; s += 2) {
                const bf16x8 a0 = *(const LAS bf16x8*)(Kl + s * 32), a1 = *(const LAS bf16x8*)(Kl + 32 * AK_ROW + s * 32);
                const bf16x8 c0 = *(const LAS bf16x8*)(Kl + s * 32 + 32), c1 = *(const LAS bf16x8*)(Kl + 32 * AK_ROW + s * 32 + 32);
                p0 = __builtin_amdgcn_mfma_f32_32x32x16_bf16(a0, qr[s], p0, 0, 0, 0);
                p1 = __builtin_amdgcn_mfma_f32_32x32x16_bf16(a1, qr[s], p1, 0, 0, 0);
                p0 = __builtin_amdgcn_mfma_f32_32x32x16_bf16(c0, qr[s + 1], p0, 0, 0, 0);
                p1 = __builtin_amdgcn_mfma_f32_32x32x16_bf16(c1, qr[s + 1], p1, 0, 0, 0);
                if ((s % 4) == 2) asm volatile("" ::: "memory");
            }
            }
            float tmax = p0[0];
#pragma unroll
            for (int r = 1; r < 16; ++r) tmax = fmaxf(tmax, p0[r]);
#pragma unroll
            for (int r = 0; r < 16; ++r) tmax = fmaxf(tmax, p1[r]);
            tmax = fmaxf(tmax, __shfl_xor(tmax, 32));
            const float mn = fmaxf(m_run, tmax), alpha = __builtin_amdgcn_exp2f((m_run - mn) * MLA_C), mc = mn * MLA_C;
            m_run = mn;
            float ls = 0.f;
#pragma unroll
            for (int r = 0; r < 16; ++r) { p0[r] = __builtin_amdgcn_exp2f(p0[r] * MLA_C - mc); p1[r] = __builtin_amdgcn_exp2f(p1[r] * MLA_C - mc); ls += p0[r] + p1[r]; }
            l_run = l_run * alpha + ls;
#pragma unroll
            for (int d = 0; d < 4; ++d)
#pragma unroll
                for (int r = 0; r < 16; ++r) o[d][r] *= alpha;
            bf16x8 pb[4];
            pb[0] = pack8(p0[0], p0[1], p0[2], p0[3], p0[4], p0[5], p0[6], p0[7]);
            pb[1] = pack8(p0[8], p0[9], p0[10], p0[11], p0[12], p0[13], p0[14], p0[15]);
            pb[2] = pack8(p1[0], p1[1], p1[2], p1[3], p1[4], p1[5], p1[6], p1[7]);
            pb[3] = pack8(p1[8], p1[9], p1[10], p1[11], p1[12], p1[13], p1[14], p1[15]);
            const unsigned va = vaddr0 + buf * AV_TILE;
            pv_block<0>(o[0], va, pb); pv_block<1>(o[1], va, pb); pv_block<2>(o[2], va, pb); pv_block<3>(o[3], va, pb);
#ifdef PROBE_A_PV
            { bf16x8 pz[4]; int zz = 0; asm volatile("" : "+v"(zz));
              _Pragma("unroll") for (int i = 0; i < 4; ++i) pz[i] = (bf16x8){(short)zz, (short)zz, (short)zz, (short)zz, (short)zz, (short)zz, (short)zz, (short)zz};
              pv_block<0>(o[0], va, pz); pv_block<1>(o[1], va, pz); pv_block<2>(o[2], va, pz); pv_block<3>(o[3], va, pz); }
#endif
        }
        if (kt + 1 < NT) A_WRITE((kt + 1) & 1);
    }
#undef A_LOAD
#undef A_WRITE
    const float inv = 1.f / (l_run + __shfl_xor(l_run, 32));
    bf16_t* op = OA + (size_t)tok * DM + h * 128 + 4 * hi;
#pragma unroll
    for (int d = 0; d < 4; ++d)
#pragma unroll
        for (int g = 0; g < 4; ++g) { u32x2 w; w.x = cvt_pk(o[d][4 * g] * inv, o[d][4 * g + 1] * inv); w.y = cvt_pk(o[d][4 * g + 2] * inv, o[d][4 * g + 3] * inv);
            *(u32x2*)(op + 32 * d + 8 * g) = w; }
}

constexpr int BK_ROW = 272, BK_TILE = 64 * BK_ROW;
constexpr int SB_FLAG_OFF = 2 * BK_TILE + 2 * AV_TILE;
__device__ __forceinline__ void sb_half(f32x16& p, int kbase, int qpos, float& run, int hi) {
    f32x16 L;
#pragma unroll
    for (int r = 0; r < 16; ++r) {
        const int kk = kbase + (r & 3) + 8 * (r >> 2);
        const float z = p[r] * SB_SCALE; const float e = __builtin_amdgcn_exp2f(-fabsf(z) * LOG2E); const float sp = __builtin_amdgcn_logf(1.f + e) * LN2;
        const bool bef = kk < qpos; const float madd = bef ? 0.f : -1e30f, mmul = bef ? 1.f : 0.f;
        p[r] = (fminf(z, 0.f) - sp) + madd; L[r] = (fminf(-z, 0.f) - sp) * mmul;
    }
    float qs[4], pq[4];
#pragma unroll
    for (int g = 0; g < 4; ++g) { qs[g] = (L[4 * g] + L[4 * g + 1]) + (L[4 * g + 2] + L[4 * g + 3]); pq[g] = __shfl_xor(qs[g], 32); }
#pragma unroll
    for (int g = 3; g >= 0; --g) {
        const float t3 = run + (hi == 0 ? pq[g] : 0.f), t2 = t3 + L[4 * g + 3], t1 = t2 + L[4 * g + 2], t0 = t1 + L[4 * g + 1];
        p[4 * g + 3] = __builtin_amdgcn_exp2f((p[4 * g + 3] + t3) * LOG2E); p[4 * g + 2] = __builtin_amdgcn_exp2f((p[4 * g + 2] + t2) * LOG2E);
        p[4 * g + 1] = __builtin_amdgcn_exp2f((p[4 * g + 1] + t1) * LOG2E); p[4 * g + 0] = __builtin_amdgcn_exp2f((p[4 * g + 0] + t0) * LOG2E);
        run += qs[g] + pq[g];
    }
}
struct SbSrc { const float* k_main; const float* v_main; const float* k_new; const float* v_new; int new_tile; };
__device__ __forceinline__ void attn_sb(LAS unsigned char* lds, int wave_k, const bf16_t* __restrict__ Qrow0  , const SbSrc src, bf16_t* __restrict__ Orow0  ,
                                        int kt_top, int nwact  , int qpos0  , int top_shift  ) {
    const int tid = phase_tid(wave_k);
    const int wid = __builtin_amdgcn_readfirstlane(tid >> 6), lane = tid & 63, r32 = lane & 31, hi = lane >> 5;
    const bool wact = wid < nwact;
    const int my_top = top_shift ? kt_top - ((7 - wid) >> 1) : kt_top;
    const int qpos = qpos0 + wid * 32 + r32;
    bf16x8 qr[8];
    if (wact) { const bf16_t* qp = Qrow0 + (size_t)(wid * 32 + r32) * 1024 + hi * 8;
#pragma unroll
        for (int s = 0; s < 8; ++s) qr[s] = *(const bf16x8*)(qp + 16 * s); }
    else {
#pragma unroll
        for (int s = 0; s < 8; ++s) qr[s] = (bf16x8){0, 0, 0, 0, 0, 0, 0, 0}; }
    f32x16 o[4];
#pragma unroll
    for (int d = 0; d < 4; ++d)
#pragma unroll
        for (int r = 0; r < 16; ++r) o[d][r] = 0.f;
    float carry = 0.f;
    const int srow = tid >> 3, scol = (tid & 7) * 16;
    f32x4 fk[4], fv[4];
#define B_LOADK(kt) do { const bool isnew = ((kt) == src.new_tile); const bool valid = !isnew || srow < 32; \
        const float* kp = (isnew ? src.k_new : src.k_main + (size_t)(kt) * 64 * 1024) + (size_t)srow * 1024 + scol; \
        if (valid) { _Pragma("unroll") for (int j = 0; j < 4; ++j) fk[j] = *(const f32x4*)(kp + 4 * j); } \
        else { _Pragma("unroll") for (int j = 0; j < 4; ++j) fk[j] = (f32x4){0.f, 0.f, 0.f, 0.f}; } } while (0)
#define B_LOADV(kt) do { const bool isnew = ((kt) == src.new_tile); const bool valid = !isnew || srow < 32; \
        const float* vp = (isnew ? src.v_new : src.v_main + (size_t)(kt) * 64 * 1024) + (size_t)srow * 1024 + scol; \
        if (valid) { _Pragma("unroll") for (int j = 0; j < 4; ++j) fv[j] = *(const f32x4*)(vp + 4 * j); } \
        else { _Pragma("unroll") for (int j = 0; j < 4; ++j) fv[j] = (f32x4){0.f, 0.f, 0.f, 0.f}; } } while (0)
#define B_WRITE(buf) do { LAS unsigned char* Kb = lds + (buf) * BK_TILE + srow * BK_ROW + scol * 2; LAS unsigned char* Vb = lds + 2 * BK_TILE + (buf) * AV_TILE + srow * AV_ROW + scol * 2; \
        u32x4 w; w.x = cvt_pk(fk[0][0], fk[0][1]); w.y = cvt_pk(fk[0][2], fk[0][3]); w.z = cvt_pk(fk[1][0], fk[1][1]); w.w = cvt_pk(fk[1][2], fk[1][3]); *(LAS u32x4*)Kb = w; \
        w.x = cvt_pk(fk[2][0], fk[2][1]); w.y = cvt_pk(fk[2][2], fk[2][3]); w.z = cvt_pk(fk[3][0], fk[3][1]); w.w = cvt_pk(fk[3][2], fk[3][3]); *(LAS u32x4*)(Kb + 16) = w; \
        w.x = cvt_pk(fv[0][0], fv[0][1]); w.y = cvt_pk(fv[0][2], fv[0][3]); w.z = cvt_pk(fv[1][0], fv[1][1]); w.w = cvt_pk(fv[1][2], fv[1][3]); *(LAS u32x4*)Vb = w; \
        w.x = cvt_pk(fv[2][0], fv[2][1]); w.y = cvt_pk(fv[2][2], fv[2][3]); w.z = cvt_pk(fv[3][0], fv[3][1]); w.w = cvt_pk(fv[3][2], fv[3][3]); *(LAS u32x4*)(Vb + 16) = w; } while (0)
    const unsigned ldsb = (unsigned)(uintptr_t)lds;
    const unsigned vaddr0 = ldsb + 2 * BK_TILE + (4 * hi + ((lane & 15) >> 2)) * AV_ROW + (16 * ((lane >> 4) & 1) + 4 * (lane & 3)) * 2;
    volatile LAS unsigned* flags = (volatile LAS unsigned*)(lds + SB_FLAG_OFF);
    __syncthreads();
    if (tid < 16) flags[tid] = 0u;
    B_LOADK(kt_top); B_LOADV(kt_top); B_WRITE(kt_top & 1);
    for (int kt = kt_top; kt >= 0; --kt) {
        __syncthreads();
        if (kt != kt_top) {
            unsigned alld = 1u;
#pragma unroll
            for (int w = 0; w < 8; ++w) alld &= flags[((kt + 1) & 1) * 8 + w];
#ifndef DBG_NO_EXIT
            if (alld) break;
        }
        unsigned mydone = wact ? 0u : 1u;
        const bool act = wact && kt <= my_top;
        const int buf = kt & 1;
        f32x16 p0, p1;
#pragma unroll
        for (int r = 0; r < 16; ++r) { p0[r] = 0.f; p1[r] = 0.f; }
        if (act) {
            const LAS unsigned char* Kl = lds + buf * BK_TILE + r32 * BK_ROW + hi * 16;
#pragma unroll
            for (int s = 0; s < 8; s += 2) {
                const bf16x8 a0 = *(const LAS bf16x8*)(Kl + s * 32), a1 = *(const LAS bf16x8*)(Kl + 32 * BK_ROW + s * 32);
                const bf16x8 c0 = *(const LAS bf16x8*)(Kl + s * 32 + 32), c1 = *(const LAS bf16x8*)(Kl + 32 * BK_ROW + s * 32 + 32);
                p0 = __builtin_amdgcn_mfma_f32_32x32x16_bf16(a0, qr[s], p0, 0, 0, 0);
                p1 = __builtin_amdgcn_mfma_f32_32x32x16_bf16(a1, qr[s], p1, 0, 0, 0);
                p0 = __builtin_amdgcn_mfma_f32_32x32x16_bf16(c0, qr[s + 1], p0, 0, 0, 0);
                p1 = __builtin_amdgcn_mfma_f32_32x32x16_bf16(c1, qr[s + 1], p1, 0, 0, 0);
                if ((s & 3) == 2) asm volatile("" ::: "memory");
            }
            float run = carry;
            sb_half(p1, kt * 64 + 32 + 4 * hi, qpos, run, hi);
            __builtin_amdgcn_sched_barrier(0);
            sb_half(p0, kt * 64 + 4 * hi, qpos, run, hi);
            carry = run;
        }
        asm volatile("" ::: "memory");
        if (kt > 0) { B_LOADK(kt - 1); B_LOADV(kt - 1); }
        if (act) {
            bf16x8 pb[4];
            pb[0] = pack8(p0[0], p0[1], p0[2], p0[3], p0[4], p0[5], p0[6], p0[7]);
            pb[1] = pack8(p0[8], p0[9], p0[10], p0[11], p0[12], p0[13], p0[14], p0[15]);
            pb[2] = pack8(p1[0], p1[1], p1[2], p1[3], p1[4], p1[5], p1[6], p1[7]);
            pb[3] = pack8(p1[8], p1[9], p1[10], p1[11], p1[12], p1[13], p1[14], p1[15]);
            const unsigned va = vaddr0 + buf * AV_TILE;
            pv_block<0>(o[0], va, pb); pv_block<1>(o[1], va, pb); pv_block<2>(o[2], va, pb); pv_block<3>(o[3], va, pb);
            mydone = __all(carry < -110.f) ? 1u : 0u;
        }
        if (lane == 0) flags[(kt & 1) * 8 + wid] = mydone;
        if (kt > 0) B_WRITE((kt - 1) & 1);
    }
#endif
#undef B_LOADK
#undef B_LOADV
#undef B_WRITE
    if (wact) {
        bf16_t* op = Orow0 + (size_t)(wid * 32 + r32) * 1024 + 4 * hi;
#pragma unroll
        for (int d = 0; d < 4; ++d)
#pragma unroll
            for (int g = 0; g < 4; ++g) { u32x2 w; w.x = cvt_pk(o[d][4 * g], o[d][4 * g + 1]); w.y = cvt_pk(o[d][4 * g + 2], o[d][4 * g + 3]); *(u32x2*)(op + 32 * d + 8 * g) = w; }
    }
}

constexpr int C_ROW = 1184, C_TILE = 32 * C_ROW, C_XOFF = 3 * C_TILE, C_XPB = 0, C_XAL = 8 * 1024;
template <int DT0> __device__ __forceinline__ void pvc8(f32x4 (&o)[32], unsigned vaddr, bf16x8 pb) {
#define PVC1(j) { const s16x4 lo = tr_read<(DT0 + j) * 32>(vaddr), hi_ = tr_read<16 * C_ROW + (DT0 + j) * 32>(vaddr); asm volatile("s_waitcnt lgkmcnt(0)" ::: "memory"); __builtin_amdgcn_sched_barrier(0); \
        o[DT0 + j] = __builtin_amdgcn_mfma_f32_16x16x32_bf16(PKTR(lo, hi_), pb, o[DT0 + j], 0, 0, 0); }
    PVC1(0) PVC1(1) PVC1(2) PVC1(3) PVC1(4) PVC1(5) PVC1(6) PVC1(7)
#undef PVC1
}
__device__ __forceinline__ void attn_mla_sample(LAS unsigned char* lds, int wave_k, const bf16_t* __restrict__ QLAT, const bf16_t* __restrict__ Q, const bf16_t* __restrict__ LATS  ,
                                                const bf16_t* __restrict__ KRS  , bf16_t* __restrict__ CTX, int b, int rg) {
    const int tid = phase_tid(wave_k);
    const int wid = __builtin_amdgcn_readfirstlane(tid >> 6), lane = tid & 63, c16 = lane & 15, g = lane >> 4;
    const bool pvw = wid >= 4; const int j4 = wid & 3;
    const int R = rg * 4 + j4, h = R >> 1, q = (R & 1) * 16 + c16;
    const int srow = b * DSEQ + q;
    f32x4 o[32];
#pragma unroll
    for (int d = 0; d < 32; ++d) o[d] = (f32x4){0.f, 0.f, 0.f, 0.f};
    if (!pvw) { const bf16_t* qp = QLAT + (size_t)srow * 8192 + h * 512 + g * 8;
#pragma unroll
      for (int s = 0; s < 16; ++s) o[s] = *(const f32x4*)(qp + 32 * s);
      const bf16_t* qr_ = Q + (size_t)(TP + srow) * 3072 + h * 192 + 128 + g * 8;
      o[16] = *(const f32x4*)qr_; o[17] = *(const f32x4*)(qr_ + 32); }
    float m_run = -INFINITY, l_run = 0.f;
    u32x4 st[5];
#define C_LOAD(kt) do { _Pragma("unroll") for (int j = 0; j < 4; ++j) { const int ch = tid + 512 * j, r = ch >> 6, c = ch & 63; st[j] = *(const u32x4*)(LATS + (size_t)((kt) * 32 + r) * 512 + c * 8); } \
        if (tid < 256) st[4] = *(const u32x4*)(KRS + (size_t)((kt) * 32 + (tid >> 3)) * 64 + (tid & 7) * 8); } while (0)
#define C_WRITE(buf) do { LAS unsigned char* Tb = lds + (buf) * C_TILE; _Pragma("unroll") for (int j = 0; j < 4; ++j) { const int ch = tid + 512 * j, r = ch >> 6, c = ch & 63; *(LAS u32x4*)(Tb + r * C_ROW + c * 16) = st[j]; } \
        if (tid < 256) *(LAS u32x4*)(Tb + (tid >> 3) * C_ROW + 1024 + (tid & 7) * 16) = st[4]; } while (0)
    const unsigned ldsb = (unsigned)(uintptr_t)lds;
    const unsigned vaddr0 = ldsb + (4 * g + (c16 >> 2)) * C_ROW + (c16 & 3) * 8;
    LAS unsigned char* xpb = lds + C_XOFF + C_XPB + j4 * 1024 + lane * 16;
    LAS unsigned char* xal = lds + C_XOFF + C_XAL + j4 * 256 + lane * 4;
    constexpr int NT = SKEYS / 32;
    __syncthreads();
    C_LOAD(0); C_WRITE(0);
    int tcur = 0, tprev = 2;
    for (int kt = 0; kt <= NT; ++kt) {
        __syncthreads();
        if (kt + 1 < NT) C_LOAD(kt + 1);
        if (!pvw) {
            if (kt < NT) {
                const LAS unsigned char* Kl = lds + tcur * C_TILE + c16 * C_ROW + g * 16;
                f32x4 s0 = (f32x4){0.f, 0.f, 0.f, 0.f}, s1 = s0;
#pragma unroll
                for (int s = 0; s < 18; s += 2) {
                    const bf16x8 a0 = *(const LAS bf16x8*)(Kl + s * 64), a1 = *(const LAS bf16x8*)(Kl + 16 * C_ROW + s * 64);
                    const bf16x8 e0 = *(const LAS bf16x8*)(Kl + s * 64 + 64), e1 = *(const LAS bf16x8*)(Kl + 16 * C_ROW + s * 64 + 64);
                    const bf16x8 qa = __builtin_bit_cast(bf16x8, o[s]), qb = __builtin_bit_cast(bf16x8, o[s + 1]);
                    s0 = __builtin_amdgcn_mfma_f32_16x16x32_bf16(a0, qa, s0, 0, 0, 0);
                    s1 = __builtin_amdgcn_mfma_f32_16x16x32_bf16(a1, qa, s1, 0, 0, 0);
                    s0 = __builtin_amdgcn_mfma_f32_16x16x32_bf16(e0, qb, s0, 0, 0, 0);
                    s1 = __builtin_amdgcn_mfma_f32_16x16x32_bf16(e1, qb, s1, 0, 0, 0);
                    if ((s % 6) == 4) asm volatile("" ::: "memory");
                }
                float tmax = fmaxf(fmaxf(fmaxf(s0[0], s0[1]), fmaxf(s0[2], s0[3])), fmaxf(fmaxf(s1[0], s1[1]), fmaxf(s1[2], s1[3])));
                tmax = fmaxf(tmax, __shfl_xor(tmax, 16)); tmax = fmaxf(tmax, __shfl_xor(tmax, 32));
                const float mn = fmaxf(m_run, tmax), alpha = __builtin_amdgcn_exp2f((m_run - mn) * MLA_C), mc = mn * MLA_C;
                m_run = mn;
                float ls = 0.f;
#pragma unroll
                for (int j = 0; j < 4; ++j) { s0[j] = __builtin_amdgcn_exp2f(s0[j] * MLA_C - mc); s1[j] = __builtin_amdgcn_exp2f(s1[j] * MLA_C - mc); ls += s0[j] + s1[j]; }
                l_run = l_run * alpha + ls;
                const bf16x8 pb = pack8(s0[0], s0[1], s0[2], s0[3], s1[0], s1[1], s1[2], s1[3]);
                *(LAS bf16x8*)(xpb + (kt & 1) * 4096) = pb; *(LAS float*)(xal + (kt & 1) * 1024) = alpha;
            }
        } else if (kt >= 1) {
            const bf16x8 pb = *(const LAS bf16x8*)(xpb + ((kt - 1) & 1) * 4096); const float alpha = *(const LAS float*)(xal + ((kt - 1) & 1) * 1024);
            if (__any(alpha != 1.f)) {
#pragma unroll
                for (int d = 0; d < 32; ++d) o[d] *= alpha;
            }
            const unsigned va = vaddr0 + tprev * C_TILE;
            pvc8<0>(o, va, pb); pvc8<8>(o, va, pb); pvc8<16>(o, va, pb); pvc8<24>(o, va, pb);
        }
        const int tnext = (tcur == 2) ? 0 : tcur + 1;
        if (kt + 1 < NT) C_WRITE(tnext);
        tprev = tcur; tcur = tnext;
    }
#undef C_LOAD
#undef C_WRITE
    if (!pvw) { float lt = l_run; lt += __shfl_xor(lt, 16); lt += __shfl_xor(lt, 32); *(LAS float*)(xal + 1024) = 1.f / lt; }
    __syncthreads();
    if (pvw) {
        const float inv = *(const LAS float*)(xal + 1024);
        bf16_t* op = CTX + (size_t)srow * 8192 + h * 512 + 4 * g;
#pragma unroll
        for (int d = 0; d < 32; ++d) { u32x2 w; w.x = cvt_pk(o[d][0] * inv, o[d][1] * inv); w.y = cvt_pk(o[d][2] * inv, o[d][3] * inv); *(u32x2*)(op + 16 * d) = w; }
    }
}

struct Args { const float* in[30]; float* out; unsigned char* ws; int ph_lo, ph_hi; };
constexpr int NWAVES = 8, NPH_LAYER = 14, NPHASES = 1 + NLAYER * NPH_LAYER;

template <class Map>
__device__ __forceinline__ void transpose_item(const float* W, int K, int Nsrc, bf16_t* WT, int ldt, LAS float* scr, int item, int lane, const Map& map, bf16_t* BD = nullptr) {
    const int nblk = Nsrc / 32, kb = item / nblk, nb = item % nblk, k0 = 64 * kb, n0 = 32 * nb;
#pragma unroll 8
    for (int i = 0; i < 32; ++i) { const int kk = 2 * i + (lane >> 5); scr[kk * 33 + (lane & 31)] = W[(size_t)(k0 + kk) * Nsrc + n0 + (lane & 31)]; }
    asm volatile("s_waitcnt lgkmcnt(0)" ::: "memory");
    const int c = lane & 7;
#pragma unroll
    for (int j = 0; j < 4; ++j) { const int n = (lane >> 3) + 8 * j; const LAS float* s = scr + (8 * c) * 33 + n;
        u32x4 o; o.x = cvt_pk(s[0 * 33], s[1 * 33]); o.y = cvt_pk(s[2 * 33], s[3 * 33]); o.z = cvt_pk(s[4 * 33], s[5 * 33]); o.w = cvt_pk(s[6 * 33], s[7 * 33]);
        *(u32x4*)(WT + (size_t)map(n0 + n) * ldt + k0 + 8 * c) = o;
        if (BD) { const int nn = n0 + n; if ((nn & 255) >= 128) { const int hh = nn >> 8; *(u32x4*)(BD + (size_t)(hh * 128 + (nn & 127)) * 1024 + (hh & 1) * 512 + k0 + 8 * c) = o; } } }
    asm volatile("s_waitcnt lgkmcnt(0)" ::: "memory");
}
struct MapId { __device__ __forceinline__ int operator()(int n) const { return n; } };
struct MapIn { __device__ __forceinline__ int operator()(int c) const { return c < 1024 ? c : (c < 1088 ? 8192 + (c - 1024) : c - 64); } };
struct MapQ { __device__ __forceinline__ int operator()(int c) const { const int h = c / 192, w = c - h * 192; if (w < 128) return c; const int j = w - 128; return h * 192 + 128 + 2 * (j & 31) + (j >> 5); } };
struct MapGU { __device__ __forceinline__ int operator()(int c) const { return c < FF ? (c >> 2) * 8 + (c & 3) : ((c - FF) >> 2) * 8 + 4 + ((c - FF) & 3); } };

__device__ __forceinline__ void ln_row(const float* __restrict__ xin, const float* __restrict__ gam, const float* __restrict__ bet, float* __restrict__ xo, bf16_t* __restrict__ xb, int lane) {
    const f32x4* xr = (const f32x4*)xin + lane;
    f32x4 v[8]; float s = 0.f;
#pragma unroll
    for (int j = 0; j < 8; ++j) { v[j] = xr[64 * j]; s += (v[j][0] + v[j][1]) + (v[j][2] + v[j][3]); }
    const float mean = wave_sum(s) * (1.f / DM); float s2 = 0.f;
#pragma unroll
    for (int j = 0; j < 8; ++j) { v[j] = v[j] - mean; s2 += (v[j][0] * v[j][0] + v[j][1] * v[j][1]) + (v[j][2] * v[j][2] + v[j][3] * v[j][3]); }
    const float rstd = 1.f / sqrtf(wave_sum(s2) * (1.f / DM) + LN_EPS);
#pragma unroll
    for (int j = 0; j < 8; ++j) { const f32x4 gg = ((const f32x4*)gam)[64 * j + lane], bb = ((const f32x4*)bet)[64 * j + lane]; const f32x4 y = v[j] * rstd * gg + bb;
        if (xo) ((f32x4*)xo)[64 * j + lane] = y;
        if (xb) { u32x2 w; w.x = cvt_pk(y[0], y[1]); w.y = cvt_pk(y[2], y[3]); ((u32x2*)xb)[64 * j + lane] = w; } }
}

#define P_X     ((float*)(ws + WS_X))
#define P_Y     ((float*)(ws + WS_Y))
#define P_XB    ((bf16_t*)(ws + WS_XB))
#define P_QA    ((float*)(ws + WS_QA))
#define P_KVA   ((float*)(ws + WS_KVA))
#define P_KRRAW ((float*)(ws + WS_KRRAW))
#define P_SBQ   ((bf16_t*)(ws + WS_SBQ))
#define P_GATE  ((bf16_t*)(ws + WS_GATE))
#define P_QN    ((bf16_t*)(ws + WS_QN))
#define P_LATB  ((bf16_t*)(ws + WS_LATB))
#define P_KRB   ((bf16_t*)(ws + WS_KRB))
#define P_Q     ((bf16_t*)(ws + WS_Q))
#define P_KVX   ((bf16_t*)(ws + WS_KVX))
#define P_QLAT  ((bf16_t*)(ws + WS_QLAT))
#define P_CTX   ((bf16_t*)(ws + WS_CTX))
#define P_OA    ((bf16_t*)(ws + WS_OA))
#define P_OB    ((bf16_t*)(ws + WS_OB))
#define P_T1    ((float*)(ws + WS_T1))
#define P_MRG   ((bf16_t*)(ws + WS_MRG))
#define P_FFB   ((bf16_t*)(ws + WS_FFB))
#define P_PP    ((float*)(ws + WS_PP))
#define P_LATS  ((bf16_t*)(ws + WS_LATS))
#define P_KRS   ((bf16_t*)(ws + WS_KRS))
#define P_PB    ((bf16_t*)(ws + WS_PB))
#define P_ROPE  ((float*)(ws + WS_ROPE))
#define P_WL(off) ((const bf16_t*)(ws + WS_W + (size_t)l * W_LAYER + (off)))

#ifndef PROBE_MASK
#define PROBE_MASK 0
#endif
#define REP0 (1 + (PROBE_MASK & 1))
#define REP(j) (1 + ((PROBE_MASK >> (1 + (j))) & 1))
#ifndef PHMASK
#define PHMASK 0xffff
#endif

__global__ void __launch_bounds__(512, 2) fwd_kernel(Args args) {
    extern __shared__ __attribute__((aligned(16))) unsigned char lds_raw[];
    LAS unsigned char* lds = (LAS unsigned char*)lds_raw;
    volatile LAS unsigned* MISC = (volatile LAS unsigned*)(lds + LDS_MISC);
    const int G_k = gridDim.x, bx_k = blockIdx.x, wave_k = __builtin_amdgcn_readfirstlane(threadIdx.x >> 6);
    unsigned char* const ws_k = args.ws;
    float* const out_k = args.out;
    for (int u = threadIdx.x; u < (LDS_BYTES - LDS_MISC) / 4; u += 512) MISC[u] = 0u;
    __syncthreads();
#if !MK_PER_PHASE
    const XcdBarrier bar = xcd_barrier_post((unsigned*)(ws_k + WS_CTL) + CW_BAR, MISC + 8);
#define GRID_BAR() xcd_barrier(bar, wave_k)
#else
#define GRID_BAR() do {} while (0)
#endif
    const int lo = args.ph_lo, hi = args.ph_hi;
#define IN(k) (lo <= (k) && (k) < hi)
#define LIN(j) (((PHMASK >> (1 + (j))) & 1) && IN(P0 + (j)))
#define SEAM(k) do { if (IN(k) && IN((k) + 1)) GRID_BAR(); } while (0)
#define PHASE_PTRS() unsigned zoff_ = 0u; int G = G_k, bx = bx_k; asm volatile("" : "+s"(zoff_), "+s"(G), "+s"(bx)); unsigned char* ws = ws_k + zoff_; float* out = out_k + zoff_; (void)out; (void)G; (void)bx
#define PHASE_IDS() PHASE_PTRS(); const int tid = phase_tid(wave_k); const int lane = tid & 63, wave = wave_k, gw = bx * NWAVES + wave, NGW = G * NWAVES; (void)lane; (void)gw; (void)NGW

    if ((PHMASK & 1) && IN(0)) for (int rep = 0; rep < REP0; ++rep) {
        PHASE_IDS();
        const size_t gtid = (size_t)bx * 512 + tid, gthreads = (size_t)G * 512;
        LAS float* scr = (LAS float*)(lds + wave * 16384);
        {
            constexpr int I_IN = (DM / 64) * (8256 / 32), I_QB = (512 / 64) * (3072 / 32), I_KV = (512 / 64) * (4096 / 32), I_BA = (DM / 64) * (DM / 32), I_BB = (1024 / 64) * (DM / 32),
                          I_OUT = I_BA, I_GU = (DM / 64) * (2 * FF / 32), I_DN = (FF / 64) * (DM / 32), I_PG = I_BA, I_PP = (PLE / 64) * (DM / 32);
            constexpr int I_LAYER = I_IN + I_QB + I_KV + I_BA + I_BB + I_OUT + I_GU + I_DN + I_PG + I_PP;
            for (int g = gw; g < NLAYER * I_LAYER; g += NGW) {
                const int l = g / I_LAYER; int r = g - l * I_LAYER;
                unsigned char* wl = ws + WS_W + (size_t)l * W_LAYER;
                if (r < I_IN) { transpose_item(args.in[10] + (size_t)l * DM * 8256, DM, 8256, (bf16_t*)(wl + W_IN), DM, scr, r, lane, MapIn()); continue; } r -= I_IN;
                if (r < I_QB) { transpose_item(args.in[13] + (size_t)l * 512 * 3072, 512, 3072, (bf16_t*)(wl + W_QB), 512, scr, r, lane, MapQ()); continue; } r -= I_QB;
                if (r < I_KV) { transpose_item(args.in[15] + (size_t)l * 512 * 4096, 512, 4096, (bf16_t*)(wl + W_KVBT), 512, scr, r, lane, MapId(), (bf16_t*)(wl + W_UVBD)); continue; } r -= I_KV;
                if (r < I_BA) { transpose_item(args.in[16] + (size_t)l * DM * DM, DM, DM, (bf16_t*)(wl + W_BA), DM, scr, r, lane, MapId()); continue; } r -= I_BA;
                if (r < I_BB) { transpose_item(args.in[17] + (size_t)l * 1024 * DM, 1024, DM, (bf16_t*)(wl + W_BB), 1024, scr, r, lane, MapId()); continue; } r -= I_BB;
                if (r < I_OUT) { transpose_item(args.in[18] + (size_t)l * DM * DM, DM, DM, (bf16_t*)(wl + W_OUT), DM, scr, r, lane, MapId()); continue; } r -= I_OUT;
                if (r < I_GU) { transpose_item(args.in[21] + (size_t)l * DM * 2 * FF, DM, 2 * FF, (bf16_t*)(wl + W_GU), DM, scr, r, lane, MapGU()); continue; } r -= I_GU;
                if (r < I_DN) { transpose_item(args.in[22] + (size_t)l * FF * DM, FF, DM, (bf16_t*)(wl + W_DN), FF, scr, r, lane, MapId()); continue; } r -= I_DN;
                if (r < I_PG) { transpose_item(args.in[25] + (size_t)l * DM * DM, DM, DM, (bf16_t*)(wl + W_PG), DM, scr, r, lane, MapId()); continue; } r -= I_PG;
                transpose_item(args.in[27] + (size_t)l * PLE * DM, PLE, DM, (bf16_t*)(wl + W_PP), PLE, scr, r, lane, MapId());
            }
        }
        for (int l = 0; l < NLAYER; ++l) {
            unsigned char* wl = ws + WS_W + (size_t)l * W_LAYER;
            { bf16_t* WT = (bf16_t*)(wl + W_IN);
              for (size_t i = gtid; i < (size_t)192 * DM / 8; i += gthreads) ((u32x4*)(WT + (size_t)8256 * DM))[i] = (u32x4){0u, 0u, 0u, 0u}; }
            { const float* W = args.in[15] + (size_t)l * 512 * 4096;
              bf16_t* WN = (bf16_t*)(wl + W_KVBN);
              for (size_t i = gtid; i < (size_t)16 * 512 * 256 / 8; i += gthreads) { const int k8 = (int)(i & 31) * 8, c = (int)(i >> 5) & 511, hh = (int)(i >> 14);
                  f32x4 a = (f32x4){0.f, 0.f, 0.f, 0.f}, b = a;
                  if (k8 < 128) { const float* src = W + (size_t)c * 4096 + hh * 256 + k8; a = *(const f32x4*)src; b = *(const f32x4*)(src + 4); }
                  st_bf16x8(WN + 8 * i, a, b); }
              bf16_t* BD = (bf16_t*)(wl + W_UVBD);
              for (size_t i = gtid; i < (size_t)2048 * 64; i += gthreads) { const int n = (int)(i >> 6), ch = (int)(i & 63), hh = n >> 7;
                  *(u32x4*)(BD + (size_t)n * 1024 + ((hh & 1) ^ 1) * 512 + ch * 8) = (u32x4){0u, 0u, 0u, 0u}; } }
        }
        for (size_t i = gtid; i < (size_t)SEQ * 32; i += gthreads) { float c, s; rope_cs_slow((int)(i >> 5), (int)(i & 31), c, s); P_ROPE[i] = c; P_ROPE[(size_t)SEQ * 32 + i] = s; }
        { const float* cl = args.in[2];
          for (size_t i = gtid; i < (size_t)NLAYER * NDB * PAST * 512 / 8; i += gthreads) { const size_t e = i * 8, lb_ = e / ((size_t)PAST * 512), rem = e % ((size_t)PAST * 512);
              const f32x4 a = *(const f32x4*)(cl + e), b = *(const f32x4*)(cl + e + 4); st_bf16x8(P_LATS + lb_ * (size_t)SKEYS * 512 + rem, a, b); }
          const float* ck = args.in[3];
          for (size_t i = gtid; i < (size_t)NLAYER * NDB * PAST * 32; i += gthreads) { const size_t rowi = i / 32; const int p = (int)(i % 32); const size_t lb_ = rowi / PAST, rr = rowi % PAST;
              ((unsigned*)(P_KRS + (lb_ * SKEYS + rr) * 64))[p] = cvt_pk(ck[rowi * 64 + p], ck[rowi * 64 + 32 + p]); } }
        { const float* pp = args.in[6]; const float* ps = args.in[7];
          for (size_t i = gtid; i < (size_t)NLAYER * TT * PLE / 8; i += gthreads) { const size_t e = i * 8, l = e / ((size_t)TT * PLE), rem = e % ((size_t)TT * PLE);
              const float* src = rem < (size_t)TP * PLE ? pp + l * (size_t)TP * PLE + rem : ps + l * (size_t)TS * PLE + (rem - (size_t)TP * PLE);
              st_bf16x8(P_PB + e, *(const f32x4*)src, *(const f32x4*)(src + 4)); } }
        for (int m = gw; m < TT; m += NGW) { const float* xin = m < TP ? args.in[0] + (size_t)m * DM : args.in[1] + (size_t)(m - TP) * DM;
            ln_row(xin, args.in[8], args.in[9], P_X + (size_t)m * DM, P_XB + (size_t)m * DM, lane); }
    }
    SEAM(0);

    for (int l = 0; l < NLAYER; ++l) {
        const int P0 = 1 + l * NPH_LAYER;
        if (LIN(0)) for (int rep = 0; rep < REP(0); ++rep) {
            PHASE_PTRS();
            pg8::Order S; S.init(TT, 30 * 256, 1, G, bx, 1);
            pg8::EpiIn E{P_QA, P_KVA, P_KRRAW, P_SBQ, P_GATE, out + O_K_P + (size_t)l * TP * 1024, out + O_K_S + (size_t)l * TS * 1024,
                         out + O_V_P + (size_t)l * TP * 1024, out + O_V_S + (size_t)l * TS * 1024, args.in[11] + (size_t)l * 4096};
            pg8::gemm_phase<pg8::Shape<DM, DM, DM>>(lds, wave_k, P_XB, P_WL(W_IN), S, E);
        }
        SEAM(P0 + 0);
        if (LIN(1)) for (int rep = 0; rep < REP(1); ++rep) {
            PHASE_IDS();
            const float* gq = args.in[12] + (size_t)l * 512; const float* gkv = args.in[14] + (size_t)l * 512;
            bf16_t* LATS_l = P_LATS + (size_t)l * NDB * SKEYS * 512; bf16_t* KRS_l = P_KRS + (size_t)l * NDB * SKEYS * 64;
            for (int m = gw; m < TT; m += NGW) {
                { const f32x4 a = ((const f32x4*)(P_QA + (size_t)m * 512))[2 * lane], b = ((const f32x4*)(P_QA + (size_t)m * 512))[2 * lane + 1];
                  const float ss = wave_sum((a[0] * a[0] + a[1] * a[1]) + (a[2] * a[2] + a[3] * a[3]) + (b[0] * b[0] + b[1] * b[1]) + (b[2] * b[2] + b[3] * b[3]));
                  const float r = 1.f / sqrtf(ss * (1.f / 512.f) + RMS_EPS); const f32x4 g0 = ((const f32x4*)gq)[2 * lane], g1 = ((const f32x4*)gq)[2 * lane + 1];
                  st_bf16x8(P_QN + (size_t)m * 512 + 8 * lane, a * r * g0, b * r * g1); }
                { const f32x4 a = ((const f32x4*)(P_KVA + (size_t)m * 512))[2 * lane], b = ((const f32x4*)(P_KVA + (size_t)m * 512))[2 * lane + 1];
                  const float ss = wave_sum((a[0] * a[0] + a[1] * a[1]) + (a[2] * a[2] + a[3] * a[3]) + (b[0] * b[0] + b[1] * b[1]) + (b[2] * b[2] + b[3] * b[3]));
                  const float r = 1.f / sqrtf(ss * (1.f / 512.f) + RMS_EPS); const f32x4 g0 = ((const f32x4*)gkv)[2 * lane], g1 = ((const f32x4*)gkv)[2 * lane + 1];
                  const f32x4 y0 = a * r * g0, y1 = b * r * g1;
                  float* od; bf16_t* ob;
                  if (m < TP) { od = out + O_LAT_P + ((size_t)l * TP + m) * 512; ob = P_LATB + (size_t)m * 512; }
                  else { const int sm = m - TP, bb = sm >> 5, qq = sm & 31; od = out + O_LAT_S + ((size_t)l * TS + sm) * 512; ob = LATS_l + ((size_t)bb * SKEYS + PAST + qq) * 512; }
                  st_f32x8(od + 8 * lane, y0, y1); st_bf16x8(ob + 8 * lane, y0, y1); }
                if (lane < 32) { const float x1 = P_KRRAW[(size_t)m * 64 + lane], x2 = P_KRRAW[(size_t)m * 64 + 32 + lane];
                  const int pos = tok_pos(m); const float c = P_ROPE[pos * 32 + lane], s = P_ROPE[SEQ * 32 + pos * 32 + lane];
                  const float y1 = x1 * c - x2 * s, y2 = x2 * c + x1 * s;
                  float* od; bf16_t* ob;
                  if (m < TP) { od = out + O_KR_P + ((size_t)l * TP + m) * 64; ob = P_KRB + (size_t)m * 64; }
                  else { const int sm = m - TP, bb = sm >> 5, qq = sm & 31; od = out + O_KR_S + ((size_t)l * TS + sm) * 64; ob = KRS_l + ((size_t)bb * SKEYS + PAST + qq) * 64; }
                  od[lane] = y1; od[32 + lane] = y2; ((unsigned*)ob)[lane] = cvt_pk(y1, y2); }
            }
        }
        SEAM(P0 + 1);
        if (LIN(2)) for (int rep = 0; rep < REP(2); ++rep) {
            PHASE_PTRS();
            { pg8::Order S; S.init(TT, 3 * 256, 1, G, bx, 2);
              pg8::EpiIn E{P_QA, P_KVA, P_KRRAW, P_SBQ, P_GATE, out + O_K_P + (size_t)l * TP * 1024, out + O_K_S + (size_t)l * TS * 1024,
                           out + O_V_P + (size_t)l * TP * 1024, out + O_V_S + (size_t)l * TS * 1024, args.in[11] + (size_t)l * 4096};
              pg8::gemm_phase<pg8::Shape<DM, DM, DM>>(lds, wave_k, P_XB, P_WL(W_IN), S, E); }
            const bool g256 = (G == 256);
            { pg8::Order S; S.init(TT, 3072, 1, G, g256 ? ((bx + 154) & 255) : bx); pg8::EpiQ E{P_Q, P_ROPE}; pg8::gemm_phase<pg8::Shape<512, 512, 512>>(lds, wave_k, P_QN, P_WL(W_QB), S, E); }
            { pg8::Order S; S.init(TP, 4096, 1, g256 ? 154 : G, g256 ? (bx >= 102 ? bx - 102 : (1 << 28)) : bx); pg8::EpiBf16 E{P_KVX, 4096, 0}; pg8::gemm_phase<pg8::Shape<512, 512, 512>>(lds, wave_k, P_LATB, P_WL(W_KVBT), S, E); }
            { pg8::Order S; S.init(TP, DM, 1, G, bx); pg8::EpiF32 E{P_PP, DM}; pg8::gemm_phase<pg8::Shape<PLE, PLE, PLE>>(lds, wave_k, P_PB + (size_t)l * TT * PLE, P_WL(W_PP), S, E);
              pg8::gemm_small<PLE, PLE, PLE, 0>(lds, wave_k, P_PB + (size_t)l * TT * PLE, P_WL(W_PP), TP, 8, 32, G, bx, E); }
        }
        SEAM(P0 + 2);
        if (LIN(3)) for (int rep = 0; rep < REP(3); ++rep) {
            PHASE_PTRS();
            pg8::Order S; S.init(TS, 512, 16, G, bx); pg8::EpiBf16 E{P_QLAT, 8192, 512};
            pg8::gemm_phase<pg8::Shape<256, 3072, 256, 192, 512 * 256, 0>>(lds, wave_k, P_Q + (size_t)TP * 3072, P_WL(W_KVBN), S, E);
        }
        SEAM(P0 + 3);
        if (LIN(4)) for (int rep = 0; rep < REP(4); ++rep) {
            PHASE_IDS();
            volatile LAS int* qslot = (volatile LAS int*)(MISC + 16);
            unsigned* qc = (unsigned*)(ws + WS_CTL) + CW_Q + (size_t)(l * 2 + rep) * 4 * 64;
#ifndef PROBE_ATT
#define PROBE_ATT 0
#endif
#ifndef NO_C
            for (int r2 = 0; r2 < 1 + (PROBE_ATT & 1); ++r2)
            for (;;) {
                __syncthreads(); if (tid == 0) qslot[0] = (int)atomicAdd(qc + (r2 ? 3 : 0) * 64, 1u); __syncthreads();
                const int it = qslot[0]; if (it >= 128) break;
                const int b = it >> 3, rg = it & 7;
                attn_mla_sample(lds, wave_k, P_QLAT, P_Q, P_LATS + ((size_t)l * NDB + b) * SKEYS * 512, P_KRS + ((size_t)l * NDB + b) * SKEYS * 64, P_CTX, b, rg);
            }
#endif
#ifndef NO_A
            for (int r2 = 0; r2 < 1 + ((PROBE_ATT >> 1) & 1); ++r2)
            for (;;) {
                __syncthreads(); if (tid == 0) qslot[0] = (int)atomicAdd(qc + (r2 ? 3 : 1) * 64, 1u); __syncthreads();
                const int it = qslot[0]; if (it >= 512) break;
                const int qb = 15 - (it >> 5), bh = it & 31, b = bh >> 4, h = bh & 15;
                attn_mla_prompt(lds, wave_k, P_Q, P_KVX, P_KRB, P_OA, b, h, qb);
            }
#endif
#ifndef NO_B
            for (int r2 = 0; r2 < 1 + ((PROBE_ATT >> 2) & 1); ++r2)
            for (;;) {
                __syncthreads(); if (tid == 0) qslot[0] = (int)atomicAdd(qc + (r2 ? 3 : 2) * 64, 1u); __syncthreads();
                const int it = qslot[0]; if (it >= 256 + 128) break;
#ifdef DBG_ONLY_D
                if (it < 256) continue;
#endif
#ifdef DBG_ONLY_B
                if (it >= 256) continue;
#endif
                SbSrc src; size_t row0; int kt_top, nwact, qpos0, top_shift, h;
                if (it < 256) {
                    const int qb = 15 - (it >> 4), bh = it & 15, b = bh >> 3; h = bh & 7;
                    src.k_main = out + O_K_P + ((size_t)l * TP + (size_t)b * SEQ) * 1024 + h * 128; src.v_main = out + O_V_P + ((size_t)l * TP + (size_t)b * SEQ) * 1024 + h * 128;
                    src.k_new = src.k_main; src.v_new = src.v_main; src.new_tile = -1;
                    row0 = (size_t)b * SEQ + qb * 256; kt_top = 4 * qb + 3; nwact = 8; qpos0 = qb * 256; top_shift = 1;
                } else {
                    const int u = it - 256, b = u >> 3; h = u & 7;
                    src.k_main = args.in[4] + ((size_t)(l * NDB + b) * PAST) * 1024 + h * 128; src.v_main = args.in[5] + ((size_t)(l * NDB + b) * PAST) * 1024 + h * 128;
                    src.k_new = out + O_K_S + ((size_t)l * TS + (size_t)b * DSEQ) * 1024 + h * 128; src.v_new = out + O_V_S + ((size_t)l * TS + (size_t)b * DSEQ) * 1024 + h * 128; src.new_tile = 32;
                    row0 = (size_t)TP + b * DSEQ; kt_top = 32; nwact = 1; qpos0 = PAST; top_shift = 0;
                }
                attn_sb(lds, wave_k, P_SBQ + row0 * 1024 + h * 128, src, P_OB + row0 * 1024 + h * 128, kt_top, nwact, qpos0, top_shift);
            }
#endif
            __syncthreads();
        }
        SEAM(P0 + 4);
        if (LIN(5)) for (int rep = 0; rep < REP(5); ++rep) {
            PHASE_PTRS();
            { pg8::EpiBf16 E{P_OA + (size_t)TP * DM, DM, 0}; pg8::gemm_small<1024, 8192, 1024, 1024>(lds, wave_k, P_CTX, P_WL(W_UVBD), 0, 8, 32, G, bx, E); }
            { pg8::Order S; S.init(TP, DM, 1, G, bx); pg8::EpiBrB E{P_T1, P_GATE}; pg8::gemm_phase<pg8::Shape<1024, 1024, 1024>>(lds, wave_k, P_OB, P_WL(W_BB), S, E);
              pg8::gemm_small<1024, 1024, 1024, 0>(lds, wave_k, P_OB, P_WL(W_BB), TP, 8, 32, G, bx, E); }
        }
        SEAM(P0 + 5);
        if (LIN(6)) for (int rep = 0; rep < REP(6); ++rep) { PHASE_PTRS(); pg8::Order S; S.init(TP, DM, 1, G, bx); pg8::EpiBrA E{P_MRG, P_T1, P_GATE}; pg8::gemm_phase<pg8::Shape<DM, DM, DM>>(lds, wave_k, P_OA, P_WL(W_BA), S, E);
            pg8::gemm_small<DM, DM, DM, 0>(lds, wave_k, P_OA, P_WL(W_BA), TP, 8, 32, G, bx, E); }
        SEAM(P0 + 6);
        if (LIN(7)) for (int rep = 0; rep < REP(7); ++rep) { PHASE_PTRS(); pg8::Order S; S.init(TP, DM, 1, G, bx); pg8::EpiRes E{P_Y, P_X}; pg8::gemm_phase<pg8::Shape<DM, DM, DM>>(lds, wave_k, P_MRG, P_WL(W_OUT), S, E);
            pg8::gemm_small<DM, DM, DM, 0>(lds, wave_k, P_MRG, P_WL(W_OUT), TP, 8, 32, G, bx, E); }
        SEAM(P0 + 7);
        if (LIN(8)) for (int rep = 0; rep < REP(8); ++rep) { PHASE_IDS(); for (int m = gw; m < TT; m += NGW) ln_row(P_Y + (size_t)m * DM, args.in[19] + (size_t)l * DM, args.in[20] + (size_t)l * DM, P_X + (size_t)m * DM, P_XB + (size_t)m * DM, lane); }
        SEAM(P0 + 8);
        if (LIN(9)) for (int rep = 0; rep < REP(9); ++rep) { PHASE_PTRS(); pg8::Order S; S.init(TT, 2 * FF, 1, G, bx); pg8::EpiGU E{P_FFB}; pg8::gemm_phase<pg8::Shape<DM, DM, DM>>(lds, wave_k, P_XB, P_WL(W_GU), S, E); }
        SEAM(P0 + 9);
        if (LIN(10)) for (int rep = 0; rep < REP(10); ++rep) { PHASE_PTRS(); pg8::Order S; S.init(TP, DM, 1, G, bx); pg8::EpiRes E{P_Y, P_X}; pg8::gemm_phase<pg8::Shape<FF, FF, FF>>(lds, wave_k, P_FFB, P_WL(W_DN), S, E);
            pg8::gemm_small<FF, FF, FF, 0>(lds, wave_k, P_FFB, P_WL(W_DN), TP, 8, 32, G, bx, E); }
        SEAM(P0 + 10);
        if (LIN(11)) for (int rep = 0; rep < REP(11); ++rep) { PHASE_IDS(); for (int m = gw; m < TT; m += NGW) ln_row(P_Y + (size_t)m * DM, args.in[23] + (size_t)l * DM, args.in[24] + (size_t)l * DM, P_X + (size_t)m * DM, P_XB + (size_t)m * DM, lane); }
        SEAM(P0 + 11);
        if (LIN(12)) for (int rep = 0; rep < REP(12); ++rep) { PHASE_PTRS(); pg8::Order S; S.init(TP, DM, 1, G, bx); pg8::EpiPle E{P_Y, P_X, P_PP, args.in[26] + (size_t)l * DM}; pg8::gemm_phase<pg8::Shape<DM, DM, DM>>(lds, wave_k, P_XB, P_WL(W_PG), S, E);
            pg8::gemm_small<DM, DM, DM, 0>(lds, wave_k, P_XB, P_WL(W_PG), TP, 8, 32, G, bx, E); }
        SEAM(P0 + 12);
        if (LIN(13)) for (int rep = 0; rep < REP(13); ++rep) {
            PHASE_IDS();
            const float* gam = args.in[28] + (size_t)l * DM; const float* bet = args.in[29] + (size_t)l * DM;
            if (l + 1 < NLAYER) { for (int m = gw; m < TT; m += NGW) ln_row(P_Y + (size_t)m * DM, gam, bet, P_X + (size_t)m * DM, P_XB + (size_t)m * DM, lane); }
            else { for (int m = gw; m < TT; m += NGW) ln_row(P_Y + (size_t)m * DM, gam, bet, out + O_Y_P + (size_t)m * DM, nullptr, lane); }
        }
        SEAM(P0 + 13);
    }
#undef IN
#undef LIN
#undef SEAM
}

extern "C" void kernel_launch(void* const* d_in, const int* in_sizes, int n_in, void* d_out, int out_size, void* d_ws, size_t ws_size, hipStream_t stream) {
    static int grid = 0;
    if (grid == 0) {
        if (n_in != 30 || out_size != (int)O_END || ws_size < WS_END) {
            fprintf(stderr, "kernel_launch: shape mismatch n_in %d out %d ws %zu (need %zu)\n", n_in, out_size, ws_size, (size_t)WS_END); grid = -1; return; }
        int dev = 0, cus = 0, per_cu = 0;
        if (hipGetDevice(&dev) != hipSuccess || hipDeviceGetAttribute(&cus, hipDeviceAttributeMultiprocessorCount, dev) != hipSuccess) { grid = -1; return; }
        if (hipFuncSetAttribute((const void*)fwd_kernel, hipFuncAttributeMaxDynamicSharedMemorySize, LDS_BYTES) != hipSuccess) { fprintf(stderr, "kernel_launch: hipFuncSetAttribute failed\n"); grid = -1; return; }
        if (hipOccupancyMaxActiveBlocksPerMultiprocessor(&per_cu, (const void*)fwd_kernel, 512, LDS_BYTES) != hipSuccess || per_cu < 1)
            fprintf(stderr, "kernel_launch: occupancy query reports %d blocks per CU\n", per_cu);
        (void)hipGetLastError();
        grid = cus;
    }
    if (grid <= 0) return;
#ifdef DBG_ZERO_ALL
    (void)hipMemsetAsync(d_ws, 0, WS_END, stream); (void)hipMemsetAsync(d_out, 0, (size_t)O_END * 4, stream);
#else
    (void)hipMemsetAsync(d_ws, 0, CTL_BYTES, stream);
#endif
    Args a;
    memset(&a, 0, sizeof(a));
    for (int i = 0; i < 30; ++i) a.in[i] = (const float*)d_in[i];
    a.out = (float*)d_out; a.ws = (unsigned char*)d_ws;
#if MK_PER_PHASE
#ifndef DBG_PH_MAX
#define DBG_PH_MAX NPHASES
#endif
    for (int p = 0; p < DBG_PH_MAX; ++p) { a.ph_lo = p; a.ph_hi = p + 1; hipLaunchKernelGGL(fwd_kernel, dim3(grid), dim3(512), LDS_BYTES, stream, a); }
#else
    a.ph_lo = 0; a.ph_hi = NPHASES;
    hipLaunchKernelGGL(fwd_kernel, dim3(grid), dim3(512), LDS_BYTES, stream, a);
#endif
#ifdef DBG_COPY_OFF
    (void)hipMemcpyAsync(d_out, (const char*)d_ws + DBG_COPY_OFF, DBG_COPY_BYTES, hipMemcpyDeviceToDevice, stream);
#endif
    const hipError_t le = hipPeekAtLastError();
    if (le != hipSuccess) fprintf(stderr, "kernel_launch: launch failed: %s\n", hipGetErrorName(le));
}
```
